# Optimizing an MI355X kernel written in HIP

```python
import math
import jax
import jax.numpy as jnp
from jax import lax
import numpy as np

D_MODEL = 1024
BATCH = 8
SEQ = 8192
DEPTH = 2

CTX_LEN = 256
GRID_W = 64
HEAD_DIM = 64
GQA_HEADS = 8
GQA_KV_HEADS = 2
GQA_GROUP = GQA_HEADS // GQA_KV_HEADS
DIFF_HEADS = 4
DIFF_DIM = HEAD_DIM
DIFF_VDIM = 2 * DIFF_DIM
GDN_HEADS = 4
GDN_DK = 128
GDN_DV = 128
GDN_CONV = 3
GDN_CHUNK = 64
N_BRANCH = 3
BRANCH_W = 512
N_EXPERTS = 16
EXPERT_FF = 1024
CAPACITY_FACTOR = 2
Q_BLOCK = 128
ROPE_THETA = 10000.0
EPS = 1e-6

A_Q = GQA_HEADS * HEAD_DIM
A_KV = GQA_KV_HEADS * HEAD_DIM
B_QK = DIFF_HEADS * 2 * DIFF_DIM
B_V = DIFF_HEADS * DIFF_VDIM
C_QK = GDN_HEADS * GDN_DK
C_V = GDN_HEADS * GDN_DV
C_GATE = 2 * GDN_HEADS
IN_WIDTHS = (A_Q, A_KV, A_KV, B_QK, B_QK, B_V, C_QK, C_QK, C_V, C_V, C_GATE, C_GATE)
IN_COLS = sum(IN_WIDTHS)
GDN_CONV_CH = 2 * C_QK + C_V

kernel_name = 'hybrid_dit_gqa_diffattn_gdn_ecmoe'


def rms_norm(x, w):
    xf = x.astype(jnp.float32)
    y = xf * lax.rsqrt(jnp.mean(xf * xf, axis=-1, keepdims=True) + EPS)
    return (y * w.astype(jnp.float32)).astype(x.dtype)


def l2_norm(x):
    xf = x.astype(jnp.float32)
    return xf * lax.rsqrt(jnp.sum(xf * xf, axis=-1, keepdims=True) + EPS)


def lambda_init(layer_idx):
    return 0.8 - 0.6 * math.exp(-0.3 * layer_idx)


def axial_rope(n, dim):
    rows = n // GRID_W
    row = jnp.repeat(jnp.arange(rows, dtype=jnp.float32), GRID_W)
    col = jnp.tile(jnp.arange(GRID_W, dtype=jnp.float32), rows)
    axis_dim = dim // 2
    inv_freq = ROPE_THETA ** (-jnp.arange(0, axis_dim, 2, dtype=jnp.float32) / axis_dim)
    ang = jnp.concatenate([row[:, None] * inv_freq, col[:, None] * inv_freq], axis=-1)
    return jnp.cos(ang), jnp.sin(ang)


def apply_rope(x, cos, sin):
    b, n, h, dim = x.shape
    xa = x.reshape(b, n, h, 2, 2, dim // 4)
    x1, x2 = xa[..., 0, :], xa[..., 1, :]
    c = cos.reshape(n, 1, 2, dim // 4).astype(x.dtype)
    s = sin.reshape(n, 1, 2, dim // 4).astype(x.dtype)
    out = jnp.stack([x1 * c - x2 * s, x2 * c + x1 * s], axis=-2)
    return out.reshape(b, n, h, dim)


def qk_heads(t, n_heads, dim, norm_w, rope):
    b, n = t.shape[:2]
    t = rms_norm(t.reshape(b, n, n_heads, dim), norm_w)
    if rope is not None:
        t = apply_rope(t, *rope)
    return t


def _blocks(q):
    b, n = q.shape[:2]
    q = q.reshape((b, n // Q_BLOCK, Q_BLOCK) + q.shape[2:])
    return jnp.moveaxis(q, 1, 0)


def _unblocks(o):
    o = jnp.moveaxis(o, 0, 1)
    return o.reshape((o.shape[0], o.shape[1] * o.shape[2]) + o.shape[3:])


def gqa_attend(q, k, v):
    scale = HEAD_DIM ** -0.5

    def one(qb):
        s = jnp.einsum('bqhgd,bkhd->bhgqk', qb, k, preferred_element_type=jnp.float32) * scale
        p = jax.nn.softmax(s, axis=-1).astype(v.dtype)
        return jnp.einsum('bhgqk,bkhd->bqhgd', p, v)

    return _unblocks(lax.map(one, _blocks(q)))


def diff_attend(q, k, v, lam):
    scale = DIFF_DIM ** -0.5

    def one(qb):
        s = jnp.einsum('bqhcd,bkhcd->bhcqk', qb, k, preferred_element_type=jnp.float32) * scale
        p = jax.nn.softmax(s, axis=-1)
        w = (p[:, :, 0] - lam * p[:, :, 1]).astype(v.dtype)
        return jnp.einsum('bhqk,bkhe->bqhe', w, v)

    return _unblocks(lax.map(one, _blocks(q)))


def gqa_branch(lat, ctx, qn, kn, rope, need_ctx):
    q, k, v = lat
    qc, kc, vc = ctx
    b, n = q.shape[:2]

    def grp(t):
        return t.reshape(t.shape[0], t.shape[1], GQA_KV_HEADS, GQA_GROUP, HEAD_DIM)

    def vh(t):
        return t.reshape(t.shape[0], t.shape[1], GQA_KV_HEADS, HEAD_DIM)

    k_ctx = qk_heads(kc, GQA_KV_HEADS, HEAD_DIM, kn, None)
    v_ctx = vh(vc)
    k_all = jnp.concatenate([qk_heads(k, GQA_KV_HEADS, HEAD_DIM, kn, rope), k_ctx], axis=1)
    v_all = jnp.concatenate([vh(v), v_ctx], axis=1)
    y = gqa_attend(grp(qk_heads(q, GQA_HEADS, HEAD_DIM, qn, rope)), k_all, v_all).reshape(b, n, A_Q)
    yc = None
    if need_ctx:
        yc = gqa_attend(grp(qk_heads(qc, GQA_HEADS, HEAD_DIM, qn, None)), k_ctx, v_ctx)
        yc = yc.reshape(qc.shape[0], qc.shape[1], A_Q)
    return y, yc


def diff_branch(lat, ctx, qn, kn, lam, lam_init, subln_w, rope, need_ctx):
    q, k, v = lat
    qc, kc, vc = ctx

    def heads(t, norm_w, rp):
        t = qk_heads(t, DIFF_HEADS * 2, DIFF_DIM, norm_w, rp)
        return t.reshape(t.shape[0], t.shape[1], DIFF_HEADS, 2, DIFF_DIM)

    def vh(t):
        return t.reshape(t.shape[0], t.shape[1], DIFF_HEADS, DIFF_VDIM)

    def finish(o):
        o = rms_norm(o, subln_w) * (1.0 - lam_init)
        return o.reshape(o.shape[0], o.shape[1], B_V)

    k_ctx = heads(kc, kn, None)
    v_ctx = vh(vc)
    k_all = jnp.concatenate([heads(k, kn, rope), k_ctx], axis=1)
    v_all = jnp.concatenate([vh(v), v_ctx], axis=1)
    y = finish(diff_attend(heads(q, qn, rope), k_all, v_all, lam))
    yc = finish(diff_attend(heads(qc, qn, None), k_ctx, v_ctx, lam)) if need_ctx else None
    return y, yc


def short_conv(x, w):
    ch = x.shape[-1]
    pad = GDN_CONV // 2
    return lax.conv_general_dilated(x, w[:, None, :].astype(x.dtype), window_strides=(1,),
                                    padding=[(pad, pad)], dimension_numbers=('NWC', 'WIO', 'NWC'),
                                    feature_group_count=ch)


def gdn_inputs(q, k, v, bt, a, conv_w, a_log, dt_bias):
    b, n = q.shape[:2]
    qkv = jax.nn.silu(short_conv(jnp.concatenate([q, k, v], axis=-1), conv_w))
    q, k, v = jnp.split(qkv, [C_QK, 2 * C_QK], axis=-1)
    q = l2_norm(q.reshape(b, n, GDN_HEADS, GDN_DK)) * (GDN_DK ** -0.5)
    k = l2_norm(k.reshape(b, n, GDN_HEADS, GDN_DK))
    v = v.reshape(b, n, GDN_HEADS, GDN_DV).astype(jnp.float32)
    beta = jax.nn.sigmoid(bt.astype(jnp.float32).reshape(b, n, 2, GDN_HEADS))
    g = -jnp.exp(a_log.astype(jnp.float32)) * jax.nn.softplus(
        a.astype(jnp.float32).reshape(b, n, 2, GDN_HEADS) + dt_bias.astype(jnp.float32))
    return q, k, v, g, beta


def gdn_chunked(q, k, v, g, beta, s0):
    b, t, h, dk = q.shape
    dv = v.shape[-1]
    nc, L = t // GDN_CHUNK, GDN_CHUNK

    def to_chunks(x):
        x = x.reshape((b, nc, L) + x.shape[2:])
        return jnp.moveaxis(x, 2, 3)

    q, k, v, g, beta = (to_chunks(z) for z in (q, k, v, g, beta))
    gc = jnp.cumsum(g, axis=-1)
    tril = jnp.tril(jnp.ones((L, L), dtype=bool))
    diff = gc[..., :, None] - gc[..., None, :]
    decay = jnp.where(tril, jnp.exp(jnp.where(tril, diff, 0.0)), 0.0)
    kb = k * beta[..., None]
    a_mat = jnp.tril(jnp.einsum('bnhid,bnhjd->bnhij', kb, k) * decay, -1)
    eye = jnp.eye(L, dtype=a_mat.dtype)
    rhs = jnp.concatenate([v * beta[..., None], kb * jnp.exp(gc)[..., None]], axis=-1)
    sol = lax.linalg.triangular_solve(a_mat + eye, rhs, left_side=True, lower=True, unit_diagonal=True)
    u, w = sol[..., :dv], sol[..., dv:]
    qk = jnp.einsum('bnhid,bnhjd->bnhij', q, k) * decay
    q_dec = q * jnp.exp(gc)[..., None]
    k_dec = k * jnp.exp(gc[..., -1:] - gc)[..., None]
    g_last = jnp.exp(gc[..., -1])

    def step(s, xs):
        qd, kd, ui, wi, qki, gl = xs
        v_new = ui - jnp.einsum('bhlk,bhkv->bhlv', wi, s)
        o = jnp.einsum('bhlk,bhkv->bhlv', qd, s) + jnp.einsum('bhij,bhjv->bhiv', qki, v_new)
        s = s * gl[..., None, None] + jnp.einsum('bhlk,bhlv->bhkv', kd, v_new)
        return s, o

    xs = tuple(jnp.moveaxis(z, 1, 0) for z in (q_dec, k_dec, u, w, qk, g_last))
    s_fin, o = lax.scan(step, s0, xs)
    o = jnp.transpose(o, (1, 0, 3, 2, 4)).reshape(b, t, h, dv)
    return o, s_fin


def gdn_branch(lat, ctx, conv_w, a_log, dt_bias, norm_w):
    q, k, v, z, bt, a = lat
    qc, kc, vc, zc, btc, ac = ctx
    b, n = q.shape[:2]
    li = gdn_inputs(q, k, v, bt, a, conv_w, a_log, dt_bias)
    ci = gdn_inputs(qc, kc, vc, btc, ac, conv_w, a_log, dt_bias)
    s0 = jnp.zeros((b, GDN_HEADS, GDN_DK, GDN_DV), jnp.float32)
    o_lat = jnp.zeros((b, n, GDN_HEADS, GDN_DV), jnp.float32)
    o_ctx = jnp.zeros((b, qc.shape[1], GDN_HEADS, GDN_DV), jnp.float32)
    for d in range(2):
        def orient(t):
            return jnp.flip(t, axis=1) if d == 1 else t

        def args(ins):
            qq, kk, vv, gg, bb = ins
            return orient(qq), orient(kk), orient(vv), orient(gg[:, :, d]), orient(bb[:, :, d])

        oc, s_ctx = gdn_chunked(*args(ci), s0)
        ol, _ = gdn_chunked(*args(li), s_ctx)
        o_lat = o_lat + orient(ol)
        o_ctx = o_ctx + orient(oc)

    def finish(o, zz):
        zz = zz.reshape(o.shape).astype(jnp.float32)
        return (rms_norm(o, norm_w) * jax.nn.silu(zz)).reshape(o.shape[0], o.shape[1], C_V).astype(q.dtype)

    return finish(o_lat, z), finish(o_ctx, zc)


def gated_merge(h, ys, w_mgate, w_branch, w_o):
    merged = jnp.zeros(h.shape, h.dtype)
    for i, y in enumerate(ys):
        gate = jax.nn.sigmoid(jnp.einsum('bnd,de->bne', h, w_mgate[i]))
        merged = merged + gate * jnp.einsum('bnw,wd->bnd', y, w_branch[i])
    return jnp.einsum('bnd,de->bne', merged, w_o)


def hybrid_mixer(h, hc, rope, w_in, gqa_qn, gqa_kn, diff_qn, diff_kn, lam, lam_init, diff_subln,
                 conv_w, a_log, dt_bias, gdn_norm_w, w_mgate, w_branch, w_o, need_ctx):
    splits = [int(s) for s in np.cumsum(IN_WIDTHS)[:-1]]
    p = jnp.split(jnp.einsum('bnd,dc->bnc', h, w_in), splits, axis=-1)
    pc = jnp.split(jnp.einsum('bnd,dc->bnc', hc, w_in), splits, axis=-1)
    ya, yac = gqa_branch(p[0:3], pc[0:3], gqa_qn, gqa_kn, rope, need_ctx)
    yb, ybc = diff_branch(p[3:6], pc[3:6], diff_qn, diff_kn, lam, lam_init, diff_subln, rope, need_ctx)
    yg, ygc = gdn_branch(p[6:12], pc[6:12], conv_w, a_log, dt_bias, gdn_norm_w)
    y = gated_merge(h, (ya, yb, yg), w_mgate, w_branch, w_o)
    yc = gated_merge(hc, (yac, ybc, ygc), w_mgate, w_branch, w_o) if need_ctx else None
    return y, yc


def expert_choice_ffn(h, w_router, w_gate, w_up, w_down):
    b, n, d = h.shape
    cap = CAPACITY_FACTOR * n // N_EXPERTS
    logits = jnp.einsum('bnd,de->ben', h, w_router, preferred_element_type=jnp.float32)
    aff = jax.nn.softmax(logits, axis=1)
    top_w, top_i = lax.top_k(aff, cap)
    xin = jax.vmap(lambda hb, ib: hb[ib])(h, top_i)
    hid = jax.nn.silu(jnp.einsum('becd,edf->becf', xin, w_gate)) * jnp.einsum('becd,edf->becf', xin, w_up)
    y = jnp.einsum('becf,efd->becd', hid, w_down) * top_w[..., None].astype(h.dtype)

    def scatter(ib, yb):
        return jnp.zeros((n, d), y.dtype).at[ib.reshape(-1)].add(yb.reshape(-1, d))

    return jax.vmap(scatter)(top_i, y)


def setup_inputs(seed: int = 0) -> dict:
    key = jax.random.key(seed)
    ks = jax.random.split(key, 32)
    D = D_MODEL
    f32 = jnp.float32

    def nrm(i, shape, scale):
        return jax.random.normal(ks[i], shape, f32) * scale

    def gain(i, shape):
        return 1.0 + 0.05 * jax.random.normal(ks[i], shape, f32)

    dt = jnp.exp(jax.random.uniform(ks[20], (DEPTH, 2, GDN_HEADS), f32, math.log(1e-3), math.log(1e-1)))
    return {
        'x': nrm(0, (BATCH, SEQ, D), 1.0),
        'c': nrm(1, (BATCH, D), 1.0),
        'ctx': nrm(2, (BATCH, CTX_LEN, D), 1.0),
        'c_ctx': nrm(3, (D,), 1.0),
        'w_mod': nrm(4, (DEPTH, D, 6 * D), 0.5 * D ** -0.5),
        'b_mod': nrm(5, (DEPTH, 6 * D), 0.01),
        'norm1_w': gain(6, (DEPTH, D)),
        'norm2_w': gain(7, (DEPTH, D)),
        'w_in': nrm(8, (DEPTH, D, IN_COLS), D ** -0.5),
        'gqa_q_norm': gain(9, (DEPTH, HEAD_DIM)),
        'gqa_k_norm': gain(10, (DEPTH, HEAD_DIM)),
        'diff_q_norm': gain(11, (DEPTH, DIFF_DIM)),
        'diff_k_norm': gain(12, (DEPTH, DIFF_DIM)),
        'diff_lambda_q1': nrm(13, (DEPTH, DIFF_DIM), 0.1),
        'diff_lambda_k1': nrm(14, (DEPTH, DIFF_DIM), 0.1),
        'diff_lambda_q2': nrm(15, (DEPTH, DIFF_DIM), 0.1),
        'diff_lambda_k2': nrm(16, (DEPTH, DIFF_DIM), 0.1),
        'diff_subln': gain(17, (DEPTH, DIFF_VDIM)),
        'gdn_conv_w': nrm(18, (DEPTH, GDN_CONV, GDN_CONV_CH), GDN_CONV ** -0.5),
        'gdn_a_log': jnp.log(jax.random.uniform(ks[19], (DEPTH, 2, GDN_HEADS), f32, 1.0, 16.0)),
        'gdn_dt_bias': dt + jnp.log(-jnp.expm1(-dt)),
        'gdn_norm_w': gain(21, (DEPTH, GDN_DV)),
        'w_merge_gate': nrm(22, (DEPTH, N_BRANCH, D, D), D ** -0.5),
        'w_branch': nrm(23, (DEPTH, N_BRANCH, BRANCH_W, D), BRANCH_W ** -0.5),
        'w_out': nrm(24, (DEPTH, D, D), D ** -0.5),
        'w_router': nrm(25, (DEPTH, D, N_EXPERTS), D ** -0.5),
        'w_exp_gate': nrm(26, (DEPTH, N_EXPERTS, D, EXPERT_FF), D ** -0.5),
        'w_exp_up': nrm(27, (DEPTH, N_EXPERTS, D, EXPERT_FF), D ** -0.5),
        'w_exp_down': nrm(28, (DEPTH, N_EXPERTS, EXPERT_FF, D), EXPERT_FF ** -0.5),
    }


def reference(x, c, ctx, c_ctx, w_mod, b_mod, norm1_w, norm2_w, w_in, gqa_q_norm, gqa_k_norm,
              diff_q_norm, diff_k_norm, diff_lambda_q1, diff_lambda_k1, diff_lambda_q2, diff_lambda_k2,
              diff_subln, gdn_conv_w, gdn_a_log, gdn_dt_bias, gdn_norm_w, w_merge_gate, w_branch, w_out,
              w_router, w_exp_gate, w_exp_up, w_exp_down):
    n = x.shape[1]
    rope = axial_rope(n, HEAD_DIM)
    c_act = jax.nn.silu(c)
    cc_act = jax.nn.silu(c_ctx)
    xc = ctx
    for li in range(DEPTH):
        last = li == DEPTH - 1
        mod = (c_act @ w_mod[li] + b_mod[li])[:, None, :]
        modc = cc_act @ w_mod[li] + b_mod[li]
        sh1, sc1, g1, sh2, sc2, g2 = jnp.split(mod, 6, axis=-1)
        sh1c, sc1c, g1c, sh2c, sc2c, g2c = jnp.split(modc, 6, axis=-1)
        lam_init = lambda_init(li)
        lam = (jnp.exp(jnp.sum(diff_lambda_q1[li] * diff_lambda_k1[li]).astype(jnp.float32))
               - jnp.exp(jnp.sum(diff_lambda_q2[li] * diff_lambda_k2[li]).astype(jnp.float32)) + lam_init)

        h = rms_norm(x, norm1_w[li]) * (1.0 + sc1) + sh1
        hc = rms_norm(xc, norm1_w[li]) * (1.0 + sc1c) + sh1c
        y, yc = hybrid_mixer(h, hc, rope, w_in[li], gqa_q_norm[li], gqa_k_norm[li], diff_q_norm[li],
                             diff_k_norm[li], lam, lam_init, diff_subln[li], gdn_conv_w[li], gdn_a_log[li],
                             gdn_dt_bias[li], gdn_norm_w[li], w_merge_gate[li], w_branch[li], w_out[li],
                             not last)
        x = x + g1 * y
        h2 = rms_norm(x, norm2_w[li]) * (1.0 + sc2) + sh2
        x = x + g2 * expert_choice_ffn(h2, w_router[li], w_exp_gate[li], w_exp_up[li], w_exp_down[li])
        if not last:
            xc = xc + g1c * yc
            h2c = rms_norm(xc, norm2_w[li]) * (1.0 + sc2c) + sh2c
            xc = xc + g2c * expert_choice_ffn(h2c, w_router[li], w_exp_gate[li], w_exp_up[li], w_exp_down[li])
    return x
```

```cpp
#include <hip/hip_runtime.h>
#include <hip/hip_bf16.h>
#include <cstdio>
#include <cstdint>
#include <cmath>

#ifndef MK_ONE_LAUNCH
#define MK_ONE_LAUNCH 1
#endif
#ifndef MK_CHECK
#define MK_CHECK 0
#endif

constexpr int DM = 1024, NB = 8, SEQ = 8192, CTXL = 256, TPB = SEQ + CTXL, MROWS = NB * TPB;
constexpr int NLAYER = 2, INCOLS = 4368, NPROJ = 4352, GRIDW = 64;
constexpr int NEXP = 16, FF = 1024, CAP_L = 1024, CAP_C = 32;
constexpr int NCHUNK = TPB / 64;
constexpr float EPSN = 1e-6f;
constexpr float C2Q = 0.125f * 1.4426950408889634f;

enum { I_X = 0, I_C, I_CTX, I_CCTX, I_WMOD, I_BMOD, I_N1W, I_N2W, I_WIN, I_GQN, I_GKN, I_DQN, I_DKN, I_LQ1, I_LK1, I_LQ2, I_LK2, I_SUBLN,
       I_CONVW, I_ALOG, I_DTB, I_GNW, I_WMG, I_WBR, I_WOUT, I_WRT, I_WEG, I_WEU, I_WED, N_IN };

constexpr size_t MiB = 1u << 20;
constexpr size_t WS_CTL = 0, CTL_ZERO_BYTES = 1 * MiB;
constexpr size_t WS_MODV = 1 * MiB;
constexpr size_t WS_ROPE = 1 * MiB + 512 * 1024;
constexpr size_t WS_LAM = 1 * MiB + 768 * 1024;
constexpr size_t WS_GDNG = 2 * MiB;
constexpr size_t WS_GCB = 7 * MiB;
constexpr size_t WS_AFF = 12 * MiB;
constexpr size_t WS_IDX = 17 * MiB;
constexpr size_t WS_WGT = 18 * MiB;
constexpr size_t WS_INV = 19 * MiB;
constexpr size_t WS_XC = 24 * MiB;
constexpr size_t WS_WMIX = 32 * MiB;
constexpr size_t WM_WIN = 0, WM_WG = 9 * MiB, WM_WB = 15 * MiB, WM_WO = 18 * MiB;
constexpr size_t WS_WEXP = 56 * MiB;
constexpr size_t WE_GU = 0, WE_D = 64 * MiB;
constexpr size_t WS_H = 152 * MiB;
constexpr size_t WS_S = 284 * MiB;
constexpr size_t WS_YA = WS_S, WS_YB = WS_S + 66 * MiB, WS_YG = WS_S + 132 * MiB;
constexpr size_t WS_KA = WS_S + 198 * MiB, WS_VA = WS_KA + 17 * MiB;
constexpr size_t WS_QB = WS_S + 232 * MiB, WS_KB = WS_QB + 66 * MiB, WS_VB = WS_KB + 66 * MiB;
constexpr size_t WS_OB = WS_VB + 66 * MiB;
constexpr size_t WS_TQ = WS_S;
constexpr size_t WS_CPRE = WS_S + 198 * MiB;
constexpr size_t WS_Z = WS_CPRE + 198 * MiB;
constexpr size_t WS_POST = WS_Z + 66 * MiB;
constexpr size_t WS_G = WS_S + 198 * MiB;
constexpr size_t WS_MRG = WS_G + 396 * MiB;
constexpr size_t WS_XIN = WS_S, WS_HID = WS_S + 264 * MiB;
constexpr size_t WS_END = WS_S + 728 * MiB;
static_assert(WS_POST + 198 * MiB <= WS_END && WS_MRG + 132 * MiB <= WS_END && WS_HID + 264 * MiB <= WS_END && WS_OB + 132 * MiB <= WS_END, "ws map");
static_assert(WS_END <= 1024 * MiB, "ws map exceeds 1 GiB");
constexpr int NSLOT_L = NB * NEXP * CAP_L, NSLOT_C = NB * NEXP * CAP_C, NSLOT = NSLOT_L + NSLOT_C;

constexpr int RING_BYTES = 131072, LDSCTL_OFF = RING_BYTES, MISC_OFF = LDSCTL_OFF + 320, LDS_BYTES = 147456;
constexpr int LDS_XTRA = MISC_OFF + 128;

#define GAS __attribute__((address_space(1)))
#define LAS __attribute__((address_space(3)))
typedef unsigned short bf16;
typedef unsigned v4u __attribute__((ext_vector_type(4)));
typedef unsigned v2u __attribute__((ext_vector_type(2)));
typedef float f32x4 __attribute__((ext_vector_type(4)));
typedef float f32x2 __attribute__((ext_vector_type(2)));
typedef short bf16x8 __attribute__((ext_vector_type(8)));
typedef GAS unsigned gu32;
#define RLX_AGENT __ATOMIC_RELAXED, __HIP_MEMORY_SCOPE_AGENT
#define LDS_WAIT() asm volatile("s_waitcnt lgkmcnt(0)" ::: "memory")
#define VM_WAIT() asm volatile("s_waitcnt vmcnt(0)" ::: "memory")
#define DI __device__ __forceinline__

DI unsigned f2bf(float f) { unsigned u = __builtin_bit_cast(unsigned, f); return (u + 0x7fffu + ((u >> 16) & 1u)) >> 16; }
DI unsigned pk2(float lo, float hi) { typedef __bf16 b2 __attribute__((ext_vector_type(2))); f32x2 v = {lo, hi}; b2 b = __builtin_convertvector(v, b2); return __builtin_bit_cast(unsigned, b); }
DI float bf2f(unsigned short b) { return __builtin_bit_cast(float, (unsigned)b << 16); }
DI float bflo(unsigned w) { return __builtin_bit_cast(float, w << 16); }
DI float bfhi(unsigned w) { return __builtin_bit_cast(float, w & 0xffff0000u); }
DI float sigmoidf_(float x) { return 1.f / (1.f + __expf(-x)); }
DI float siluf_(float x) { return x / (1.f + __expf(-x)); }
DI float wave_sum(float v) {
#pragma unroll
    for (int o = 1; o < 64; o <<= 1) v += __shfl_xor(v, o);
    return v;
}
DI float sum16(float v) { v += __shfl_xor(v, 1); v += __shfl_xor(v, 2); v += __shfl_xor(v, 4); v += __shfl_xor(v, 8); return v; }
DI float reduce16(const float (&v)[16], int lane) {
    float a[8], b[4], c[2], d;
    const bool b5 = lane & 32, b4 = lane & 16, b3 = lane & 8, b2 = lane & 4;
#pragma unroll
    for (int i = 0; i < 8; ++i) { const float keep = b5 ? v[i + 8] : v[i], send = b5 ? v[i] : v[i + 8]; a[i] = keep + __shfl_xor(send, 32); }
#pragma unroll
    for (int i = 0; i < 4; ++i) { const float keep = b4 ? a[i + 4] : a[i], send = b4 ? a[i] : a[i + 4]; b[i] = keep + __shfl_xor(send, 16); }
#pragma unroll
    for (int i = 0; i < 2; ++i) { const float keep = b3 ? b[i + 2] : b[i], send = b3 ? b[i] : b[i + 2]; c[i] = keep + __shfl_xor(send, 8); }
    { const float keep = b2 ? c[1] : c[0], send = b2 ? c[0] : c[1]; d = keep + __shfl_xor(send, 4); }
    d += __shfl_xor(d, 2); d += __shfl_xor(d, 1);
    return d;
}

#define XB_TMO      128
#define XB_XCNT(j)  (256  + 64 * (j))
#define XB_XSUB(j)  (1280 + 64 * (j))
#define XB_XGEN(j)  (2304 + 64 * (j))
#define XB_TOP      3328
#define XB_TOPGEN   3392
#define XCD_BAR_WORDS 3456
#define XB_SPIN_CAP (1u << 22)
DI unsigned xb_ld(unsigned* p)              { return __hip_atomic_load(p, __ATOMIC_RELAXED, __HIP_MEMORY_SCOPE_AGENT); }
DI unsigned xb_add(unsigned* p, unsigned v) { return __hip_atomic_fetch_add(p, v, __ATOMIC_RELAXED, __HIP_MEMORY_SCOPE_AGENT); }
DI unsigned xb_xcc_id() { return (unsigned)__builtin_amdgcn_s_getreg((3 << 11) | 20) & 0xFu; }
#define XB_SPIN(cond, bar) do { unsigned _sp = 0; while (cond) { __builtin_amdgcn_s_sleep(1); \
    if ((++_sp & 255u) == 0u) { if (xb_ld(&(bar)[XB_TMO])) break; if (_sp > XB_SPIN_CAP) { atomicAdd(&(bar)[XB_TMO], 1u); break; } } } } while (0)
struct XcdBarrier { unsigned* bar; unsigned x; volatile LAS unsigned* st; };
DI XcdBarrier xcd_barrier_post(unsigned* bar, volatile LAS unsigned* st) {
    XcdBarrier b; b.bar = bar; b.x = xb_xcc_id(); b.st = st;
    if (threadIdx.x == 0) (void)xb_add(&bar[XB_XCNT(b.x)], 1u);
    return b;
}
DI void xcd_barrier_complete(unsigned* bar, unsigned x, unsigned& nloc, unsigned& nx) {
    const unsigned G = gridDim.x * gridDim.y * gridDim.z;
    unsigned sum, cnt, mine, sp = 0u;
    for (;;) {
        sum = 0u; cnt = 0u; mine = 0u;
#pragma unroll
        for (unsigned j = 0; j < 16; ++j) { const unsigned c = xb_ld(&bar[XB_XCNT(j)]); sum += c; cnt += (c > 0u) ? 1u : 0u; mine = (j == x) ? c : mine; }
        if (sum == G) break;
        __builtin_amdgcn_s_sleep(1);
        if ((++sp & 255u) == 0u) { if (xb_ld(&bar[XB_TMO])) break; if (sp > XB_SPIN_CAP) { atomicAdd(&bar[XB_TMO], 1u); break; } }
    }
    nloc = mine > 0u ? mine : 1u; nx = cnt > 0u ? cnt : 1u;
}
DI void xcd_barrier(const XcdBarrier& b) {
    asm volatile("s_waitcnt vmcnt(0)" ::: "memory");
    __syncthreads();
    if (threadIdx.x == 0) {
        unsigned* bar = b.bar;
        __builtin_amdgcn_s_waitcnt(0);
        unsigned nloc = b.st[0], nx = b.st[1];
        if (nloc == 0u) { xcd_barrier_complete(bar, b.x, nloc, nx); b.st[0] = nloc; b.st[1] = nx; }
        const unsigned old = xb_add(&bar[XB_XSUB(b.x)], 1u);
        const unsigned gen = old / nloc;
        if (old + 1u == (gen + 1u) * nloc) {
            __builtin_amdgcn_fence(__ATOMIC_RELEASE, "agent");
            asm volatile("s_waitcnt vmcnt(0)" ::: "memory");
            const unsigned og = xb_add(&bar[XB_TOP], 1u);
            const unsigned tg = og / nx;
            if (og + 1u == (tg + 1u) * nx) xb_add(&bar[XB_TOPGEN], 1u);
            else XB_SPIN(xb_ld(&bar[XB_TOPGEN]) == tg, bar);
            __builtin_amdgcn_fence(__ATOMIC_ACQUIRE, "agent");
            xb_add(&bar[XB_XGEN(b.x)], 1u);
            asm volatile("s_waitcnt vmcnt(0)" ::: "memory");
        } else {
            XB_SPIN(xb_ld(&bar[XB_XGEN(b.x)]) == gen, bar);
            __builtin_amdgcn_fence(__ATOMIC_ACQUIRE, "agent");
            asm volatile("s_waitcnt vmcnt(0)" ::: "memory");
        }
    }
    __syncthreads();
}
namespace pg8 {
#define PG8_LAS __attribute__((address_space(3)))
typedef unsigned short bf16_t;
typedef short bf16x8 __attribute__((ext_vector_type(8)));
typedef float f32x4 __attribute__((ext_vector_type(4)));
typedef unsigned u32x4 __attribute__((ext_vector_type(4)));
constexpr int BM = 256, BK = 64, HALF = 128, HTB = HALF * BK * 2  , STAGE_BYTES = 8 * HTB, NXCD = 8, WGM = 8;

__host__ __device__ __forceinline__ int lds_byte(int r, int c) { const int st = (r >> 4) * 2 + (c >> 5), rr = r & 15, cc = c & 31, ob = rr * 64 + cc * 2; return st * 1024 + (ob ^ (((ob >> 9) & 1) << 5)); }
__host__ __device__ __forceinline__ void stage_rc(int b, int& R, int& C) { const int st = b / 1024, sb = b % 1024, swz = sb ^ (((sb >> 9) & 1) << 5); R = (st >> 1) * 16 + swz / 64; C = (st & 1) * 32 + (swz % 64) / 2; }
__host__ __device__ __forceinline__ int perm32(int rho) { const int n = rho >> 4, i = rho & 15; return 8 * (i >> 2) + 4 * n + (i & 3); }

struct Unit { int pm, pn, z; };
struct Gemm { int lda, ldb, K; };

__device__ __forceinline__ unsigned cvt_pk_bf16(float lo, float hi) { unsigned r; asm volatile("v_cvt_pk_bf16_f32 %0, %1, %2" : "=v"(r) : "v"(lo), "v"(hi)); return r; }
typedef float f32x2 __attribute__((ext_vector_type(2)));
template <class Epi, class Sched, bool ALIGN_EPI = false, bool SP2 = false>
__device__ __forceinline__ void gemm_phase(PG8_LAS unsigned char* lds, const Gemm g, const Sched& S, const Epi& E, const int tid  ) {
    const int wid = __builtin_amdgcn_readfirstlane(tid >> 6), lane = tid & 63, wr = wid >> 2, wc = wid & 3, fr = lane & 15, fq = lane >> 4;
    const int K = g.K, nt = K / BK;
    unsigned voffA[2], voffB[2];
#pragma unroll
    for (int i = 0; i < 2; ++i) { int R, C; stage_rc(tid * 16 + i * 8192, R, C); const int Rb = Epi::PERM ? ((R & ~31) + perm32(R & 31)) : R;
        voffA[i] = (unsigned)(R * g.lda + C) * 2u; voffB[i] = (unsigned)(Rb * g.ldb + C) * 2u; }
    const size_t kstep = (size_t)(BK * 2);
    const size_t hstepA = (size_t)HALF * g.lda * 2, hstepB = (size_t)HALF * g.ldb * 2;
    const unsigned ldsw = (unsigned)wid * 1024u;
    const int aoff = lds_byte(wr * 64 + fr, fq * 8), boff = lds_byte(wc * 32 + fr, fq * 8);
#define PG8_SA(b, h) (((b) * 2 + (h)) * HTB)
#define PG8_SB(b, h) ((4 + (b) * 2 + (h)) * HTB)
#define PG8_STAGE(bufoff, gbase, voff) do { _Pragma("unroll") for (int _i = 0; _i < 2; ++_i) \
        __builtin_amdgcn_global_load_lds((const unsigned*)((const char*)(gbase) + (voff)[_i]), (PG8_LAS unsigned*)(lds + (bufoff) + ldsw + _i * 8192), 16, 0, 0); } while (0)
#define PG8_LDA(dst, b, h) do { _Pragma("unroll") for (int m = 0; m < 4; ++m) _Pragma("unroll") for (int k = 0; k < 2; ++k) dst[m][k] = *(const PG8_LAS bf16x8*)(lds + PG8_SA(b, h) + aoff + m * 2048 + k * 1024); } while (0)
#define PG8_LDB(dst, b, h) do { _Pragma("unroll") for (int n = 0; n < 2; ++n) _Pragma("unroll") for (int k = 0; k < 2; ++k) dst[n][k] = *(const PG8_LAS bf16x8*)(lds + PG8_SB(b, h) + boff + n * 2048 + k * 1024); } while (0)
#define PG8_MMA(ai, bj, At, Bt) do { __builtin_amdgcn_s_setprio(1); _Pragma("unroll") for (int m = 0; m < 4; ++m) _Pragma("unroll") for (int n = 0; n < 2; ++n) _Pragma("unroll") for (int k = 0; k < 2; ++k) \
        acc[ai][bj][m][n] = __builtin_amdgcn_mfma_f32_16x16x32_bf16(Bt[n][k], At[m][k], acc[ai][bj][m][n], 0, 0, 0); __builtin_amdgcn_s_setprio(0); } while (0)
#define PG8_WAIT_V(n) asm volatile("s_waitcnt vmcnt(" #n ")" ::: "memory")
#define PG8_WAIT_L(n) asm volatile("s_waitcnt lgkmcnt(" #n ")" ::: "memory")
#define PG8_BAR __builtin_amdgcn_s_barrier()
#define PG8_SCHED __builtin_amdgcn_sched_barrier(0)
    Unit cur, nxt; int ui = 0;
    if (!S.next(0, cur)) return;
    f32x4 acc[2][2][4][2];
#pragma unroll
    for (int a = 0; a < 2; ++a)
#pragma unroll
        for (int b = 0; b < 2; ++b)
#pragma unroll
            for (int m = 0; m < 4; ++m)
#pragma unroll
                for (int n = 0; n < 2; ++n) acc[a][b][m][n] = (f32x4){0.f, 0.f, 0.f, 0.f};
    bf16x8 At[4][2], B0[2][2], B1[2][2];
    const char* cA = S.a_ptr(cur); const char* cB = S.b_ptr(cur);
    S.a_ready(cur);
    if constexpr (SP2) {
        PG8_STAGE(PG8_SB(0, 0), cB, voffB); PG8_STAGE(PG8_SB(0, 1), cB + hstepB, voffB); PG8_STAGE(PG8_SA(0, 0), cA, voffA); PG8_STAGE(PG8_SA(0, 1), cA + hstepA, voffA);
        if (wr == 1) PG8_BAR;
        PG8_WAIT_V(2); PG8_BAR;
        PG8_STAGE(PG8_SB(1, 0), cB + kstep, voffB); PG8_STAGE(PG8_SA(1, 0), cA + kstep, voffA); PG8_STAGE(PG8_SB(1, 1), cB + hstepB + kstep, voffB);
        PG8_WAIT_V(6); PG8_BAR;
    } else {
        PG8_STAGE(PG8_SB(0, 0), cB, voffB); PG8_STAGE(PG8_SA(0, 0), cA, voffA); PG8_STAGE(PG8_SB(0, 1), cB + hstepB, voffB); PG8_STAGE(PG8_SA(0, 1), cA + hstepA, voffA);
        if (wr == 1) PG8_BAR;
        PG8_WAIT_V(4); PG8_BAR;
        PG8_STAGE(PG8_SB(1, 0), cB + kstep, voffB); PG8_STAGE(PG8_SA(1, 0), cA + kstep, voffA); PG8_STAGE(PG8_SB(1, 1), cB + hstepB + kstep, voffB);
        PG8_WAIT_V(6); PG8_BAR;
    }
    for (;;) {
        const bool has_next = S.next(ui + 1, nxt);
        const char* nA = has_next ? S.a_ptr(nxt) : cA; const char* nB = has_next ? S.b_ptr(nxt) : cB;
        for (int t = 0; t < nt; t += 2) {
            const bool last = (t == nt - 2);
            const char* a1 = cA + (size_t)(t + 1) * kstep;
            const char* a2 = last ? nA : cA + (size_t)(t + 2) * kstep; const char* b2 = last ? nB : cB + (size_t)(t + 2) * kstep;
            const char* a3 = a2 + kstep; const char* b3 = b2 + kstep;
            if (last && has_next) S.a_ready(nxt);
            if constexpr (SP2) {
            PG8_LDB(B0, 0, 0); PG8_LDB(B1, 0, 1); PG8_SCHED; PG8_LDA(At, 0, 0); PG8_STAGE(PG8_SA(1, 1), a1 + hstepA, voffA);
            PG8_WAIT_V(8); PG8_WAIT_L(0); PG8_BAR; PG8_MMA(0, 0, At, B0); PG8_MMA(0, 1, At, B1); PG8_BAR; PG8_SCHED;
            PG8_LDA(At, 0, 1); PG8_STAGE(PG8_SB(0, 0), b2, voffB); PG8_STAGE(PG8_SB(0, 1), b2 + hstepB, voffB); PG8_STAGE(PG8_SA(0, 0), a2, voffA);
            PG8_WAIT_V(8); PG8_WAIT_L(0); PG8_BAR; PG8_MMA(1, 0, At, B0); PG8_MMA(1, 1, At, B1); PG8_BAR; PG8_SCHED;
            PG8_LDB(B0, 1, 0); PG8_LDB(B1, 1, 1); PG8_SCHED; PG8_LDA(At, 1, 0); PG8_STAGE(PG8_SA(0, 1), a2 + hstepA, voffA);
            PG8_WAIT_V(8); PG8_WAIT_L(0); PG8_BAR; PG8_MMA(0, 0, At, B0); PG8_MMA(0, 1, At, B1); PG8_BAR; PG8_SCHED;
            PG8_LDA(At, 1, 1); PG8_STAGE(PG8_SB(1, 0), b3, voffB); PG8_STAGE(PG8_SB(1, 1), b3 + hstepB, voffB); PG8_STAGE(PG8_SA(1, 0), a3, voffA);
            PG8_WAIT_V(8); PG8_WAIT_L(0); PG8_BAR; PG8_MMA(1, 0, At, B0); PG8_MMA(1, 1, At, B1); PG8_BAR; PG8_SCHED;
            } else {
            PG8_LDB(B0, 0, 0); PG8_SCHED; PG8_LDA(At, 0, 0); PG8_STAGE(PG8_SA(1, 1), a1 + hstepA, voffA);
            PG8_WAIT_L(8); PG8_BAR; PG8_WAIT_L(0); PG8_MMA(0, 0, At, B0); PG8_BAR; PG8_SCHED;
            PG8_LDB(B1, 0, 1); PG8_STAGE(PG8_SB(0, 0), b2, voffB);
            PG8_BAR; PG8_WAIT_L(0); PG8_MMA(0, 1, At, B1); PG8_BAR;
            PG8_LDA(At, 0, 1); PG8_STAGE(PG8_SA(0, 0), a2, voffA);
            PG8_BAR; PG8_WAIT_L(0); PG8_MMA(1, 0, At, B0); PG8_BAR; PG8_SCHED;
            PG8_STAGE(PG8_SB(0, 1), b2 + hstepB, voffB);
            PG8_WAIT_V(6); PG8_BAR; PG8_MMA(1, 1, At, B1); PG8_BAR;
            PG8_LDB(B0, 1, 0); PG8_SCHED; PG8_LDA(At, 1, 0); PG8_STAGE(PG8_SA(0, 1), a2 + hstepA, voffA);
            PG8_WAIT_L(8); PG8_BAR; PG8_WAIT_L(0); PG8_MMA(0, 0, At, B0); PG8_BAR; PG8_SCHED;
            PG8_LDB(B1, 1, 1); PG8_STAGE(PG8_SB(1, 0), b3, voffB);
            PG8_BAR; PG8_WAIT_L(0); PG8_MMA(0, 1, At, B1); PG8_BAR;
            PG8_LDA(At, 1, 1); PG8_STAGE(PG8_SA(1, 0), a3, voffA);
            PG8_BAR; PG8_WAIT_L(0); PG8_MMA(1, 0, At, B0); PG8_BAR; PG8_SCHED;
            PG8_STAGE(PG8_SB(1, 1), b3 + hstepB, voffB);
            PG8_WAIT_V(6); PG8_BAR; PG8_MMA(1, 1, At, B1); PG8_BAR;
            }
        }
        if constexpr (ALIGN_EPI) { if (wr == 0) PG8_BAR; }
        if constexpr (!Epi::AFTER_DRAIN) { E(acc, cur, wr, wc, fr, fq); S.done(cur); }
        if (!has_next) break;
#pragma unroll
        for (int a = 0; a < 2; ++a)
#pragma unroll
            for (int b = 0; b < 2; ++b)
#pragma unroll
                for (int m = 0; m < 4; ++m)
#pragma unroll
                    for (int n = 0; n < 2; ++n) acc[a][b][m][n] = (f32x4){0.f, 0.f, 0.f, 0.f};
        cur = nxt; cA = nA; cB = nB; ++ui;
        if constexpr (ALIGN_EPI) { if (wr == 1) PG8_BAR; }
    }
    PG8_WAIT_V(0);
    if constexpr (!ALIGN_EPI) { if (wr == 0) PG8_BAR; }
    PG8_BAR;
    if constexpr (Epi::AFTER_DRAIN) { E.fused(acc, cur, wr, wc, fr, fq, lds, wid, lane); S.done(cur); }
#undef PG8_SA
#undef PG8_SB
#undef PG8_STAGE
#undef PG8_LDA
#undef PG8_LDB
#undef PG8_MMA
#undef PG8_WAIT_V
#undef PG8_WAIT_L
#undef PG8_BAR
#undef PG8_SCHED
}
}
namespace pg8 {
struct SchedMN {
    const char* A; const char* B; size_t a_tile, b_tile, a_z, b_z;
    int nM, nN, nwg, G, c, NZ, pn0;
    DI void init(const void* A_, size_t lda, const void* B_, size_t ldb, int nM_, int nN_, int pn0_, int G_, int c_) {
        A = (const char*)A_; B = (const char*)B_; a_tile = 256 * lda * 2; b_tile = 256 * ldb * 2; a_z = 0; b_z = 0; nM = nM_; nN = nN_; nwg = nM * nN; G = G_; c = c_; NZ = 1; pn0 = pn0_; }
    DI bool next(int i, Unit& u) const {
        const int ti = i / NZ; u.z = i - ti * NZ;
        const long L = (long)ti * G + c; if (L >= nwg) return false;
        int wgid = (int)L; { const int q = nwg / NXCD, r = nwg % NXCD, xcd = wgid % NXCD, off = wgid / NXCD; wgid = (xcd < r ? xcd * (q + 1) : r * (q + 1) + (xcd - r) * q) + off; }
        const int nig = WGM * nN, gid = wgid / nig, fm = gid * WGM, gsz = (nM - fm) < WGM ? (nM - fm) : WGM;
        u.pm = fm + ((wgid % nig) % gsz); u.pn = pn0 + (wgid % nig) / gsz; return true;
    }
    DI const char* a_ptr(const Unit& u) const { return A + (size_t)u.pm * a_tile + (size_t)u.z * a_z; }
    DI const char* b_ptr(const Unit& u) const { return B + (size_t)u.pn * b_tile + (size_t)u.z * b_z; }
    DI void a_ready(const Unit&) const {}
    DI void done(const Unit&) const {}
};
struct SchedMoe {
    const char* A; const char* B; size_t b_exp; int nN, ntot, G, c;
    DI bool next(int i, Unit& u) const { const long L = (long)i * G + c; if (L >= ntot) return false; u.pm = (int)(L / nN); u.pn = (int)(L % nN); u.z = u.pm < 512 ? (u.pm >> 5) : (u.pm - 512); return true; }
    DI const char* a_ptr(const Unit& u) const { return A + (size_t)u.pm * (256 * 1024 * 2); }
    DI const char* b_ptr(const Unit& u) const { return B + (size_t)u.z * b_exp + (size_t)u.pn * (256 * 1024 * 2); }
    DI void a_ready(const Unit&) const {}
    DI void done(const Unit&) const {}
};

struct EpiInProj {
    static constexpr bool PERM = false, AFTER_DRAIN = false;
    unsigned char* ws; const float *gqn, *gkn, *dqn, *dkn; const float* rope;
    DI void operator()(const f32x4 (&acc)[2][2][4][2], const Unit& u, int wr, int wc, int fr, int fq) const {
        const int pn = u.pn;
        bf16_t* dst; int pitch, col0; const float* nw = nullptr; float scale = 1.f;
        if (pn < 2)       { dst = (bf16_t*)(ws + WS_YA); pitch = 512; col0 = (pn * 4 + wc) * 64; nw = gqn; scale = C2Q; }
        else if (pn == 2) { if (wc < 2) { dst = (bf16_t*)(ws + WS_KA); pitch = 128; col0 = wc * 64; nw = gkn; } else { dst = (bf16_t*)(ws + WS_VA); pitch = 128; col0 = (wc - 2) * 64; } }
        else if (pn < 5)  { dst = (bf16_t*)(ws + WS_QB); pitch = 512; col0 = ((pn - 3) * 4 + wc) * 64; nw = dqn; scale = C2Q; }
        else if (pn < 7)  { dst = (bf16_t*)(ws + WS_KB); pitch = 512; col0 = ((pn - 5) * 4 + wc) * 64; nw = dkn; }
        else if (pn < 9)  { dst = (bf16_t*)(ws + WS_VB); pitch = 512; col0 = (pn - 7) * 256 + wc * 64; }
        else if (pn < 15) { dst = (bf16_t*)(ws + WS_CPRE); pitch = 1536; col0 = (pn - 9) * 256 + wc * 64; }
        else              { dst = (bf16_t*)(ws + WS_Z); pitch = 512; col0 = (pn - 15) * 256 + wc * 64; }
        f32x4 w4[2][2];
        if (nw) {
#pragma unroll
            for (int bj = 0; bj < 2; ++bj)
#pragma unroll
                for (int n = 0; n < 2; ++n) w4[bj][n] = *(const f32x4*)(nw + 32 * bj + 16 * n + 4 * fq);
        }
#pragma unroll
        for (int ai = 0; ai < 2; ++ai)
#pragma unroll
            for (int m = 0; m < 4; ++m) {
                const int row = u.pm * BM + ai * HALF + wr * 64 + m * 16 + fr;
                f32x4 v[2][2];
#pragma unroll
                for (int bj = 0; bj < 2; ++bj)
#pragma unroll
                    for (int n = 0; n < 2; ++n) v[bj][n] = acc[ai][bj][m][n];
                if (nw) {
                    float ss = 0.f;
#pragma unroll
                    for (int bj = 0; bj < 2; ++bj)
#pragma unroll
                        for (int n = 0; n < 2; ++n) ss += (v[bj][n][0] * v[bj][n][0] + v[bj][n][1] * v[bj][n][1]) + (v[bj][n][2] * v[bj][n][2] + v[bj][n][3] * v[bj][n][3]);
                    ss += __shfl_xor(ss, 16); ss += __shfl_xor(ss, 32);
                    const float rstd = rsqrtf(ss * (1.f / 64.f) + EPSN);
#pragma unroll
                    for (int bj = 0; bj < 2; ++bj)
#pragma unroll
                        for (int n = 0; n < 2; ++n) v[bj][n] = v[bj][n] * rstd * w4[bj][n];
                    const int t = row % TPB;
                    if (t < SEQ) {
#pragma unroll
                        for (int bj = 0; bj < 2; ++bj) {
                            const int pos = bj == 0 ? (t >> 6) : (t & 63);
                            const f32x4 cs0 = *(const f32x4*)(rope + (pos * 16 + 4 * fq) * 2), cs1 = *(const f32x4*)(rope + (pos * 16 + 4 * fq) * 2 + 4);
                            const float c[4] = {cs0[0], cs0[2], cs1[0], cs1[2]}, s[4] = {cs0[1], cs0[3], cs1[1], cs1[3]};
#pragma unroll
                            for (int e = 0; e < 4; ++e) { const float x1 = v[bj][0][e], x2 = v[bj][1][e]; v[bj][0][e] = x1 * c[e] - x2 * s[e]; v[bj][1][e] = x2 * c[e] + x1 * s[e]; }
                        }
                    }
                }
                bf16_t* rp = dst + (size_t)row * pitch + col0 + 4 * fq;
#pragma unroll
                for (int bj = 0; bj < 2; ++bj)
#pragma unroll
                    for (int n = 0; n < 2; ++n) { const f32x4 o = v[bj][n] * scale; v2u w; w.x = cvt_pk_bf16(o[0], o[1]); w.y = cvt_pk_bf16(o[2], o[3]); *(v2u*)(rp + 32 * bj + 16 * n) = w; }
            }
    }
};

template <int MODE> struct EpiBf {
    static constexpr bool PERM = true, AFTER_DRAIN = false;
    bf16_t* O; int ldc; const bf16_t* Gt;
    DI void operator()(const f32x4 (&acc)[2][2][4][2], const Unit& u, int wr, int wc, int fr, int fq) const {
        const int row0 = u.pm * BM + wr * 64 + fr, col0 = u.pn * BM + wc * 32 + 8 * fq;
#pragma unroll
        for (int ai = 0; ai < 2; ++ai)
#pragma unroll
            for (int m = 0; m < 4; ++m) { const size_t row = (size_t)(row0 + ai * HALF + m * 16);
#pragma unroll
                for (int bj = 0; bj < 2; ++bj) { f32x4 v0 = acc[ai][bj][m][0], v1 = acc[ai][bj][m][1]; bf16_t* op = O + row * ldc + col0 + bj * HALF;
                    if (MODE == 0) {
#pragma unroll
                        for (int e = 0; e < 4; ++e) { v0[e] = sigmoidf_(v0[e]); v1[e] = sigmoidf_(v1[e]); }
                    } else {
                        const u32x4 g = *(const u32x4*)(Gt + row * 3072 + u.z * 1024 + col0 + bj * HALF);
                        v0[0] *= bflo(g.x); v0[1] *= bfhi(g.x); v0[2] *= bflo(g.y); v0[3] *= bfhi(g.y); v1[0] *= bflo(g.z); v1[1] *= bfhi(g.z); v1[2] *= bflo(g.w); v1[3] *= bfhi(g.w);
                        if (u.z > 0) { const u32x4 p = *(const u32x4*)op;
                            v0[0] += bflo(p.x); v0[1] += bfhi(p.x); v0[2] += bflo(p.y); v0[3] += bfhi(p.y); v1[0] += bflo(p.z); v1[1] += bfhi(p.z); v1[2] += bflo(p.w); v1[3] += bfhi(p.w); }
                    }
                    u32x4 w; w.x = cvt_pk_bf16(v0[0], v0[1]); w.y = cvt_pk_bf16(v0[2], v0[3]); w.z = cvt_pk_bf16(v1[0], v1[1]); w.w = cvt_pk_bf16(v1[2], v1[3]);
                    *(u32x4*)op = w; } }
    }
};

struct EpiGO {
    static constexpr bool PERM = false, AFTER_DRAIN = false;
    const float* xl_old; const float* xc_old; float* xl_new; float* xc_new; const float* modv;
    DI void operator()(const f32x4 (&acc)[2][2][4][2], const Unit& u, int wr, int wc, int fr, int fq) const {
        const int col0 = u.pn * BM + wc * 32 + 4 * fq;
#pragma unroll
        for (int ai = 0; ai < 2; ++ai)
#pragma unroll
            for (int m = 0; m < 4; ++m) {
                const int row = u.pm * BM + ai * HALF + wr * 64 + m * 16 + fr, b = row / TPB, t = row - b * TPB;
                const bool lat = t < SEQ; const int mi = lat ? b : 8;
                const size_t ro = lat ? ((size_t)b * SEQ + t) * DM : ((size_t)b * CTXL + (t - SEQ)) * DM;
                const float* xo = (lat ? xl_old : xc_old) + ro; float* xn = (lat ? xl_new : xc_new) + ro; const float* g1 = modv + mi * 6144 + 2048;
#pragma unroll
                for (int bj = 0; bj < 2; ++bj)
#pragma unroll
                    for (int n = 0; n < 2; ++n) { const int c = col0 + bj * HALF + n * 16;
                        const f32x4 o = *(const f32x4*)(xo + c) + *(const f32x4*)(g1 + c) * acc[ai][bj][m][n]; *(f32x4*)(xn + c) = o; }
            }
    }
};

struct EpiE1 {
    static constexpr bool PERM = true, AFTER_DRAIN = false;
    bf16_t* H;
    DI void operator()(const f32x4 (&acc)[2][2][4][2], const Unit& u, int wr, int wc, int fr, int fq) const {
        const int row0 = u.pm * BM + wr * 64 + fr, col0 = u.pn * HALF + wc * 32 + 8 * fq;
#pragma unroll
        for (int ai = 0; ai < 2; ++ai)
#pragma unroll
            for (int m = 0; m < 4; ++m) { const size_t row = (size_t)(row0 + ai * HALF + m * 16);
                f32x4 g0 = acc[ai][0][m][0], g1 = acc[ai][0][m][1]; const f32x4 u0 = acc[ai][1][m][0], u1 = acc[ai][1][m][1];
#pragma unroll
                for (int e = 0; e < 4; ++e) { g0[e] = siluf_(g0[e]) * u0[e]; g1[e] = siluf_(g1[e]) * u1[e]; }
                u32x4 w; w.x = cvt_pk_bf16(g0[0], g0[1]); w.y = cvt_pk_bf16(g0[2], g0[3]); w.z = cvt_pk_bf16(g1[0], g1[1]); w.w = cvt_pk_bf16(g1[2], g1[3]);
                *(u32x4*)(H + row * FF + col0) = w; }
    }
};
struct EpiE2 {
    static constexpr bool PERM = true, AFTER_DRAIN = false;
    bf16_t* Y; const float* wgt; const float* modv;
    DI void operator()(const f32x4 (&acc)[2][2][4][2], const Unit& u, int wr, int wc, int fr, int fq) const {
        const int row0 = u.pm * BM + wr * 64 + fr, col0 = u.pn * BM + wc * 32 + 8 * fq;
#pragma unroll
        for (int ai = 0; ai < 2; ++ai)
#pragma unroll
            for (int m = 0; m < 4; ++m) { const int row = row0 + ai * HALF + m * 16; const float tw = wgt[row];
                const int mi = row < NSLOT_L ? ((row >> 10) & 7) : 8; const float* g2 = modv + mi * 6144 + 5120;
#pragma unroll
                for (int bj = 0; bj < 2; ++bj) { const int c = col0 + bj * HALF; const f32x4 ga = *(const f32x4*)(g2 + c), gb = *(const f32x4*)(g2 + c + 4);
                    const f32x4 v0 = acc[ai][bj][m][0] * ga * tw, v1 = acc[ai][bj][m][1] * gb * tw;
                    u32x4 w; w.x = cvt_pk_bf16(v0[0], v0[1]); w.y = cvt_pk_bf16(v0[2], v0[3]); w.z = cvt_pk_bf16(v1[0], v1[1]); w.w = cvt_pk_bf16(v1[2], v1[3]);
                    *(u32x4*)(Y + (size_t)row * DM + c) = w; } }
    }
};
}
namespace attn_body {
using bf16=__hip_bfloat16;
using bf16x8=__attribute__((ext_vector_type(8)))short;
using s16x4=__attribute__((ext_vector_type(4)))short;
using f32x16=__attribute__((ext_vector_type(16)))float;
using u32x4=__attribute__((ext_vector_type(4)))unsigned;
constexpr int D=64;
constexpr int NW=8,QBLK=32,QB=QBLK*NW,KVBLK=64;
constexpr int ATTN_UNIT_ROWS=QB;
__device__ __forceinline__ int crow(int r,int hi){return (r&3)+8*(r>>2)+4*hi;}
#define SBAR() __builtin_amdgcn_sched_barrier(0)
constexpr int NSLOT=3, SLOTB=8192;
constexpr int LDS_K=0, LDS_V=NSLOT*SLOTB, LDS_WS=2*NSLOT*SLOTB, LDS_OST=LDS_WS+NW*64*4, LDS_BYTES=LDS_OST+NW*4096;
__device__ __forceinline__ void glds16(const void*gsrc,unsigned lds_dst){unsigned keep;
  asm volatile("s_mov_b32 %0, m0\n\ts_mov_b32 m0, %2\n\ts_nop 0\n\tglobal_load_lds_dwordx4 %1, off\n\ts_mov_b32 m0, %0":"=&s"(keep):"v"(gsrc),"s"(lds_dst):"memory");}
__device__ __forceinline__ float max3f(float a,float b,float c){float r;asm("v_max3_f32 %0, %1, %2, %3":"=v"(r):"v"(a),"v"(b),"v"(c));return r;}
__device__ __forceinline__ float max2f(float a,float b){float r;asm("v_max_f32_e32 %0, %1, %2":"=v"(r):"v"(a),"v"(b));return r;}
__device__ __forceinline__ float fadd_s(float a,float b){float r;asm("v_add_f32_e32 %0, %1, %2":"=v"(r):"v"(a),"v"(b));return r;}
__device__ __forceinline__ float fsub_s(float a,float b){float r;asm("v_sub_f32_e32 %0, %1, %2":"=v"(r):"v"(a),"v"(b));return r;}
typedef float f32x2_t __attribute__((ext_vector_type(2))); typedef __bf16 bf16x2_t __attribute__((ext_vector_type(2)));
__device__ __forceinline__ unsigned cvtpk_s(float lo,float hi){f32x2_t v={lo,hi};bf16x2_t b=__builtin_convertvector(v,bf16x2_t);return __builtin_bit_cast(unsigned,b);}
#define WAIT_BAR(N) asm volatile("s_waitcnt vmcnt(" #N ") lgkmcnt(0)\n\ts_barrier":::"memory")

__device__ __forceinline__ void qkt(f32x16&p0,f32x16&p1,const char*Kslot,const bf16x8*qr,const f32x16&negm,int r32,int hi){
  const char*kb=Kslot+hi*1024+r32*16;
  #pragma unroll
  for(int d0=0;d0<4;++d0){
    const bf16x8 b0=*reinterpret_cast<const bf16x8*>(kb+d0*2048);
    const bf16x8 b1=*reinterpret_cast<const bf16x8*>(kb+d0*2048+512);
    if(d0==0){p0=__builtin_amdgcn_mfma_f32_32x32x16_bf16(b0,qr[0],negm,0,0,0);p1=__builtin_amdgcn_mfma_f32_32x32x16_bf16(b1,qr[0],negm,0,0,0);}
    else{p0=__builtin_amdgcn_mfma_f32_32x32x16_bf16(b0,qr[d0],p0,0,0,0);p1=__builtin_amdgcn_mfma_f32_32x32x16_bf16(b1,qr[d0],p1,0,0,0);}}
}
typedef __attribute__((address_space(3))) const char* lds_cptr;
typedef short v4i16_t __attribute__((ext_vector_type(4)));
__device__ __forceinline__ void kload8(bf16x8*kf,lds_cptr kp){
  kf[0]=*(const __attribute__((address_space(3))) bf16x8*)(kp);      kf[1]=*(const __attribute__((address_space(3))) bf16x8*)(kp+512);
  kf[2]=*(const __attribute__((address_space(3))) bf16x8*)(kp+2048); kf[3]=*(const __attribute__((address_space(3))) bf16x8*)(kp+2560);
  kf[4]=*(const __attribute__((address_space(3))) bf16x8*)(kp+4096); kf[5]=*(const __attribute__((address_space(3))) bf16x8*)(kp+4608);
  kf[6]=*(const __attribute__((address_space(3))) bf16x8*)(kp+6144); kf[7]=*(const __attribute__((address_space(3))) bf16x8*)(kp+6656);
}
__device__ __forceinline__ void kload2(bf16x8*kf,lds_cptr kp,int j){ kf[2*j]=*(const __attribute__((address_space(3))) bf16x8*)(kp+j*2048); kf[2*j+1]=*(const __attribute__((address_space(3))) bf16x8*)(kp+j*2048+512); }
__device__ __forceinline__ s16x4 vtr(lds_cptr p){ return __builtin_bit_cast(s16x4,__builtin_amdgcn_ds_read_tr16_b64_v4i16((__attribute__((address_space(3))) v4i16_t*)p)); }
__device__ __forceinline__ float rowmax(const f32x16&p0,const f32x16&p1){
  float a=max3f(p0[0],p0[1],p1[0]),b=max3f(p0[2],p0[3],p1[1]);a=max3f(a,p1[2],p1[3]);
  #pragma unroll
  for(int r=4;r<16;r+=4){a=max3f(a,p0[r],p0[r+1]);b=max3f(b,p0[r+2],p0[r+3]);a=max3f(a,p1[r],p1[r+1]);b=max3f(b,p1[r+2],p1[r+3]);}
  const float m=max2f(a,b);
  auto rr=__builtin_amdgcn_permlane32_swap(__float_as_uint(m),__float_as_uint(m),false,false);
  return max2f(__uint_as_float(rr[0]),__uint_as_float(rr[1]));
}
__device__ __forceinline__ void pv(f32x16*o,int vb,bf16x8 pa0,bf16x8 pa1,bf16x8 pa2,bf16x8 pa3){
  #pragma unroll
  for(int d0=0;d0<2;++d0){s16x4 lo[4],hi[4];
    #pragma unroll
    for(int ks=0;ks<4;++ks){
      asm volatile("ds_read_b64_tr_b16 %0,%1 offset:%c2":"=&v"(lo[ks]):"v"(vb),"i"(d0*4096+ks*1024):"memory");
      asm volatile("ds_read_b64_tr_b16 %0,%1 offset:%c2":"=&v"(hi[ks]):"v"(vb),"i"(d0*4096+ks*1024+512):"memory");}
    asm volatile("s_waitcnt lgkmcnt(0)":::"memory");SBAR();
    #define PK(k) (bf16x8){lo[k][0],lo[k][1],lo[k][2],lo[k][3],hi[k][0],hi[k][1],hi[k][2],hi[k][3]}
    o[d0]=__builtin_amdgcn_mfma_f32_32x32x16_bf16(pa0,PK(0),o[d0],0,0,0);
    o[d0]=__builtin_amdgcn_mfma_f32_32x32x16_bf16(pa1,PK(1),o[d0],0,0,0);
    o[d0]=__builtin_amdgcn_mfma_f32_32x32x16_bf16(pa2,PK(2),o[d0],0,0,0);
    o[d0]=__builtin_amdgcn_mfma_f32_32x32x16_bf16(pa3,PK(3),o[d0],0,0,0);
    #undef PK
  }
}

#ifndef ATTN_STORE16
#define ATTN_STORE16(p,v) (*(u32x4*)(p)=(v))
#endif
template<int THRL> __device__ __forceinline__ void attn_unit(const bf16*Qu,int QP,const bf16*__restrict__ Kh,int KP,const bf16*__restrict__ Vh,int VP,bf16*Ou,int OP,int NT,char*shm,const int tid){
  const int lane=tid&63,r32=lane&31,hi=lane>>5; const int wid=__builtin_amdgcn_readfirstlane(tid>>6);
  const bf16*Qw=Qu+(long)(wid*QBLK)*QP;
  const unsigned lds0=(unsigned)(uintptr_t)shm;
  float*wsf=(float*)(shm+LDS_WS)+wid*64;
  const bf16*ksrc=Kh+(long)lane*KP+wid*8;
  const bf16*vsrc=Vh+(long)(16*(wid&3)+(lane>>2))*VP+(wid>>2)*32+(lane&3)*8;
  const unsigned kdst=lds0+LDS_K+wid*1024, vdst=lds0+LDS_V+wid*1024;
  #define DMA_K(t,slot) glds16(ksrc+(long)(t)*KVBLK*KP,(unsigned)__builtin_amdgcn_readfirstlane(kdst+(slot)))
  #define DMA_V(t,slot) glds16(vsrc+(long)(t)*KVBLK*VP,(unsigned)__builtin_amdgcn_readfirstlane(vdst+(slot)))
  const int vb0=(int)(lds0+LDS_V)+((lane>>4)&1)*32+(lane&3)*8+(4*hi+((lane&15)>>2))*64;
  const char*Kbase=shm+LDS_K; bf16x8 kf[8];
  const lds_cptr shm3=(lds_cptr)shm; const lds_cptr kp0=shm3+LDS_K+hi*1024+r32*16; const lds_cptr vp0=shm3+LDS_V+((lane>>4)&1)*32+(lane&3)*8+(4*hi+((lane&15)>>2))*64;
  DMA_K(0,0);DMA_V(0,0);DMA_K(1,SLOTB);
  bf16x8 qr[4];
  #pragma unroll
  for(int d0=0;d0<4;++d0)qr[d0]=*reinterpret_cast<const bf16x8*>(&Qw[(long)r32*QP+d0*16+hi*8]);
  float mhat=0.f,l_reg=0.f;f32x16 o[2];o[0]=f32x16{};o[1]=f32x16{};f32x16 negm=f32x16{};asm volatile("":"+v"(negm));
  #define CMASK(P0,P1,t) do{}while(0)
  bool resc=false;
  #define START(P0,P1) do{ const float rm=rowmax(P0,P1); resc=false; \
    { const float dl=rm; mhat=fadd_s(mhat,dl); \
      _Pragma("unroll") for(int r=0;r<16;++r){P0[r]=fsub_s(P0[r],dl);P1[r]=fsub_s(P1[r],dl);} \
      _Pragma("unroll") for(int r=0;r<16;++r)negm[r]=-mhat; asm volatile("":"+v"(negm)); } \
    _Pragma("unroll") for(int r=0;r<16;++r)P0[r]=__builtin_amdgcn_exp2f(P0[r]); }while(0)
  #define RESC() do{ if(resc){ asm volatile("s_waitcnt lgkmcnt(0)":::"memory"); \
      _Pragma("unroll") for(int d_=0;d_<2;++d_) _Pragma("unroll") for(int r=0;r<16;++r)o[d_][r]*=wsf[crow(r,hi)]; } }while(0)
  f32x16 pA0,pA1,pB0,pB1;
  int sl_prev=0,sl_cur=0,sl_next=SLOTB;
  #define ROT() do{sl_prev=sl_cur;sl_cur=sl_next;sl_next=(sl_next==(NSLOT-1)*SLOTB)?0:sl_next+SLOTB;}while(0)
  DMA_K(2,2*SLOTB);
  WAIT_BAR(3);
  qkt(pA0,pA1,Kbase,qr,negm,r32,hi);asm volatile("s_nop 15\n\ts_nop 7":"+v"(pA0),"+v"(pA1));CMASK(pA0,pA1,0);
  START(pA0,pA1);
  _Pragma("unroll") for(int r=0;r<16;++r)pA1[r]=__builtin_amdgcn_exp2f(pA1[r]);
  WAIT_BAR(0);
  DMA_K(3,0);DMA_V(1,SLOTB);
  ROT();
  kload8(kf,kp0+sl_cur);
  WAIT_BAR(2);
  s16x4 vlo[8],vhi[8]; u32x4 pw0,pw1,pw2,pw3;
  #define PKW(P,B) cvtpk_s(P[B],P[B+1])
  #define PAF(k) __builtin_bit_cast(bf16x8,pw##k)
  #define VFR(i) (bf16x8){vlo[i][0],vlo[i][1],vlo[i][2],vlo[i][3],vhi[i][0],vhi[i][1],vhi[i][2],vhi[i][3]}
  #define PIN(x) asm volatile("":"+v"(x))
  #define MX3(a,b,c) __builtin_fmaxf(__builtin_fmaxf((a),(b)),(c))
  #define GAPA(MF,A0,A1,A2,A3,W0,W1,PW) do{ MF; sacc+=A0; sacc+=A1; sacc+=A2; sacc+=A3; PIN(sacc); W0; W1; PIN(PW); SBAR(); }while(0)
  #define EX(v) __builtin_amdgcn_exp2f(v)
  #define GAPB(MF,X,B) do{ MF; X[B]=EX(X[B]); X[B+1]=EX(X[B+1]); X[B+2]=EX(X[B+2]); X[B+3]=EX(X[B+3]); PIN(X); SBAR(); }while(0)
  #define VRD(i) do{ vlo[i]=vtr(vp_+(((i)>>2)*4096+((i)&3)*1024)); vhi[i]=vtr(vp_+(((i)>>2)*4096+((i)&3)*1024+512)); }while(0)
  #define KRD(G,j) do{ if(G){ kload2(kf,kp0+sl_next,j); SBAR(); } }while(0)
  #define STEP(C0,C1,P0,P1,t,GK,GV,GL) do{ SBAR(); \
    const lds_cptr vp_=vp0+sl_prev; \
    VRD(0); SBAR(); float sacc=(P0[0]+P0[1]); \
    GAPA(C0=__builtin_amdgcn_mfma_f32_32x32x16_bf16(kf[0],qr[0],negm,0,0,0), P0[2],P0[3],P0[4],P0[5],     pw0[0]=PKW(P0,0), pw0[1]=PKW(P0,2), pw0); \
    VRD(4); SBAR(); GAPA(C1=__builtin_amdgcn_mfma_f32_32x32x16_bf16(kf[1],qr[0],negm,0,0,0), P0[6],P0[7],P0[8],P0[9],     pw0[2]=PKW(P0,4), pw0[3]=PKW(P0,6), pw0); \
    VRD(1); SBAR(); GAPA(C0=__builtin_amdgcn_mfma_f32_32x32x16_bf16(kf[2],qr[1],C0,0,0,0),   P0[10],P0[11],P0[12],P0[13], pw1[0]=PKW(P0,8), pw1[1]=PKW(P0,10), pw1); \
    VRD(5); SBAR(); GAPA(C1=__builtin_amdgcn_mfma_f32_32x32x16_bf16(kf[3],qr[1],C1,0,0,0),   P0[14],P0[15],P1[0],P1[1],   pw1[2]=PKW(P0,12),pw1[3]=PKW(P0,14), pw1); \
    VRD(2); SBAR(); GAPA(C0=__builtin_amdgcn_mfma_f32_32x32x16_bf16(kf[4],qr[2],C0,0,0,0),   P1[2],P1[3],P1[4],P1[5],     pw2[0]=PKW(P1,0), pw2[1]=PKW(P1,2), pw2); \
    VRD(6); SBAR(); GAPA(C1=__builtin_amdgcn_mfma_f32_32x32x16_bf16(kf[5],qr[2],C1,0,0,0),   P1[6],P1[7],P1[8],P1[9],     pw2[2]=PKW(P1,4), pw2[3]=PKW(P1,6), pw2); \
    VRD(3); SBAR(); GAPA(C0=__builtin_amdgcn_mfma_f32_32x32x16_bf16(kf[6],qr[3],C0,0,0,0),   P1[10],P1[11],P1[12],P1[13], pw3[0]=PKW(P1,8), pw3[1]=PKW(P1,10), pw3); \
    VRD(7); SBAR(); GAPA(C1=__builtin_amdgcn_mfma_f32_32x32x16_bf16(kf[7],qr[3],C1,0,0,0),   P1[14],P1[15],0.f,0.f,       pw3[2]=PKW(P1,12),pw3[3]=PKW(P1,14), pw3); \
    l_reg+=sacc; \
    if(GK){DMA_K((t)+3,sl_cur);} if(GV){DMA_V((t)+1,sl_next);} \
    CMASK(C0,C1,t); \
    { float a=MX3(C0[0],C0[1],C1[0]),b=MX3(C0[2],C0[3],C1[1]); a=MX3(a,C1[2],C1[3]); \
      _Pragma("unroll") for(int r=4;r<16;r+=4){a=MX3(a,C0[r],C0[r+1]);b=MX3(b,C0[r+2],C0[r+3]);a=MX3(a,C1[r],C1[r+1]);b=MX3(b,C1[r+2],C1[r+3]);} \
      float rm=__builtin_fmaxf(a,b); { auto rr=__builtin_amdgcn_permlane32_swap(__float_as_uint(rm),__float_as_uint(rm),false,false); rm=__builtin_fmaxf(__uint_as_float(rr[0]),__uint_as_float(rr[1])); } \
      resc=false; \
      if(__builtin_expect(__any(rm>(float)THRL),0)){ const float dl=__builtin_fmaxf(rm,0.f); mhat+=dl; \
        _Pragma("unroll") for(int r=0;r<16;++r){C0[r]-=dl;C1[r]-=dl;} \
        _Pragma("unroll") for(int r=0;r<16;++r)negm[r]=-mhat; asm volatile("":"+v"(negm)); \
        const float f=__builtin_amdgcn_exp2f(-dl); l_reg*=f; if(hi==0)wsf[r32]=f; resc=true; } } \
    SBAR(); \
    GAPB(o[0]=__builtin_amdgcn_mfma_f32_32x32x16_bf16(PAF(0),VFR(0),o[0],0,0,0), C0,0); \
    GAPB(o[1]=__builtin_amdgcn_mfma_f32_32x32x16_bf16(PAF(0),VFR(4),o[1],0,0,0), C0,4); \
    KRD(GL,0); GAPB(o[0]=__builtin_amdgcn_mfma_f32_32x32x16_bf16(PAF(1),VFR(1),o[0],0,0,0), C0,8); \
    KRD(GL,1); GAPB(o[1]=__builtin_amdgcn_mfma_f32_32x32x16_bf16(PAF(1),VFR(5),o[1],0,0,0), C0,12); \
    KRD(GL,2); GAPB(o[0]=__builtin_amdgcn_mfma_f32_32x32x16_bf16(PAF(2),VFR(2),o[0],0,0,0), C1,0); \
    KRD(GL,3); GAPB(o[1]=__builtin_amdgcn_mfma_f32_32x32x16_bf16(PAF(2),VFR(6),o[1],0,0,0), C1,4); \
    GAPB(o[0]=__builtin_amdgcn_mfma_f32_32x32x16_bf16(PAF(3),VFR(3),o[0],0,0,0), C1,8); \
    GAPB(o[1]=__builtin_amdgcn_mfma_f32_32x32x16_bf16(PAF(3),VFR(7),o[1],0,0,0), C1,12); \
    }while(0)
  int t=1;
  for(;t+5<NT;t+=2){
    STEP(pB0,pB1,pA0,pA1,t,true,true,true);     WAIT_BAR(2); RESC(); ROT();
    STEP(pA0,pA1,pB0,pB1,t+1,true,true,true);   WAIT_BAR(2); RESC(); ROT();
  }
  #define ENDW(tt) do{ if((tt)+3<NT){WAIT_BAR(2);} else if((tt)+2<NT){WAIT_BAR(1);} else {WAIT_BAR(0);} }while(0)
  for(;t+1<NT;t+=2){
    STEP(pB0,pB1,pA0,pA1,t,(t+3<NT),(t+1<NT),(t+1<NT));       ENDW(t);   RESC(); ROT();
    STEP(pA0,pA1,pB0,pB1,t+1,(t+4<NT),(t+2<NT),(t+2<NT));     ENDW(t+1); RESC(); ROT();
  }
  STEP(pB0,pB1,pA0,pA1,NT-1,false,false,false); RESC();
  { float sacc=pB0[0]+pB0[1]; _Pragma("unroll") for(int r=2;r<16;++r)sacc+=pB0[r]; _Pragma("unroll") for(int r=0;r<16;++r)sacc+=pB1[r]; l_reg+=sacc;
    pw0=(u32x4){PKW(pB0,0),PKW(pB0,2),PKW(pB0,4),PKW(pB0,6)};pw1=(u32x4){PKW(pB0,8),PKW(pB0,10),PKW(pB0,12),PKW(pB0,14)};pw2=(u32x4){PKW(pB1,0),PKW(pB1,2),PKW(pB1,4),PKW(pB1,6)};pw3=(u32x4){PKW(pB1,8),PKW(pB1,10),PKW(pB1,12),PKW(pB1,14)};
    SBAR(); pv(o,vb0+sl_cur,PAF(0),PAF(1),PAF(2),PAF(3)); }
  #undef PKW
  #undef PAF
  #undef VFR
  #undef PIN
  #undef MX3
  #undef GAPA
  #undef GAPB
  #undef EX
  #undef VRD
  #undef KRD
  #undef STEP
  #undef ENDW
  {auto rr=__builtin_amdgcn_permlane32_swap(__float_as_uint(l_reg),__float_as_uint(l_reg),false,false);l_reg=__uint_as_float(rr[0])+__uint_as_float(rr[1]);}
  if(hi==0)wsf[32+r32]=l_reg;asm volatile("s_waitcnt lgkmcnt(0)":::"memory");
  float rli[16];
  #pragma unroll
  for(int r=0;r<16;++r)rli[r]=__builtin_amdgcn_rcpf(wsf[32+crow(r,hi)]);
  bf16*Ow=Ou+(long)(wid*QBLK)*OP;
  { bf16*stg=(bf16*)(shm+LDS_OST)+wid*2048;
    #pragma unroll
    for(int r=0;r<16;++r){const int orow=crow(r,hi);
      #pragma unroll
      for(int d0=0;d0<2;++d0)stg[orow*64+d0*32+r32]=__float2bfloat16(o[d0][r]*rli[r]);}
    asm volatile("s_waitcnt lgkmcnt(0)":::"memory");
    #pragma unroll
    for(int i=0;i<4;++i){const int row=i*8+(lane>>3),ch=lane&7; const u32x4 v=*(const u32x4*)(stg+row*64+ch*8); ATTN_STORE16(Ow+(long)row*OP+ch*8,v);} }
  asm volatile("s_waitcnt lgkmcnt(0)\n\ts_barrier":::"memory");
  #undef DMA_K
  #undef DMA_V
  #undef CMASK
  #undef START
  #undef RESC
  #undef ROT
}
constexpr int ATTN_LDS_BYTES=LDS_BYTES;
#undef SBAR
#undef WAIT_BAR
}
typedef const float* const __attribute__((address_space(4)))* kin_ptr;
struct InTab { kin_ptr p; DI const float* operator[](int i) const { return p[i]; } };
struct Frame {
    LAS unsigned char* lds; volatile LAS unsigned* MISC; gu32* ctl;
    int tid, lane, wave, vcu, G, gw, NGW, bx;
    InTab in; float* out; unsigned char* ws;
};
DI const float* modv_of(const Frame& F, int li) { return (const float*)(F.ws + WS_MODV) + (size_t)li * 9 * 6144; }
DI const float* lat_x(const Frame& F, int li) { return li == 0 ? F.in[I_X] : F.out; }
DI const float* ctx_x(const Frame& F, int li) { return li == 0 ? F.in[I_CTX] : (const float*)(F.ws + WS_XC); }

DI void phase_p0(const Frame& F) {
    LAS float* act = (LAS float*)F.lds;
    LAS float* part = (LAS float*)(F.lds + 36864);
    bool loaded = false;
    for (int u = F.bx; u < NLAYER * 96; u += F.G) {
        const int li = u / 96, n0 = (u % 96) * 64;
        if (!loaded) {
            for (int i = F.tid; i < 9 * 1024; i += 512) { const int m = i >> 10, k = i & 1023; const float c = m < 8 ? F.in[I_C][m * 1024 + k] : F.in[I_CCTX][k]; act[i] = siluf_(c); }
            loaded = true;
        }
        __syncthreads();
        float acc[9];
#pragma unroll
        for (int m = 0; m < 9; ++m) acc[m] = 0.f;
        const float* W = F.in[I_WMOD] + (size_t)li * 1024 * 6144 + n0 + F.lane;
        const int k0 = F.wave * 128;
        for (int k = k0; k < k0 + 128; k += 4) {
            float wv[4];
#pragma unroll
            for (int e = 0; e < 4; ++e) wv[e] = W[(size_t)(k + e) * 6144];
#pragma unroll
            for (int m = 0; m < 9; ++m) { const f32x4 a = *(const LAS f32x4*)(act + m * 1024 + k); acc[m] += a[0] * wv[0] + a[1] * wv[1] + a[2] * wv[2] + a[3] * wv[3]; }
        }
#pragma unroll
        for (int m = 0; m < 9; ++m) part[(F.wave * 9 + m) * 64 + F.lane] = acc[m];
        __syncthreads();
        for (int i = F.tid; i < 9 * 64; i += 512) { const int m = i >> 6, l = i & 63; float s = 0.f;
#pragma unroll
            for (int w = 0; w < 8; ++w) s += part[(w * 9 + m) * 64 + l];
            ((float*)(F.ws + WS_MODV))[((size_t)li * 9 + m) * 6144 + n0 + l] = s + F.in[I_BMOD][li * 6144 + n0 + l]; }
        __syncthreads();
    }
    if (F.bx == F.G - 1) {
        float* rope = (float*)(F.ws + WS_ROPE);
        for (int i = F.tid; i < 128 * 16; i += 512) { const int pos = i >> 4, f = i & 15; const float inv = powf(10000.f, -(float)(2 * f) / 32.f); const float ang = (float)pos * inv; float s, c; sincosf(ang, &s, &c); rope[2 * i] = c; rope[2 * i + 1] = s; }
        if (F.wave < NLAYER) {
            const int li = F.wave; const int l = F.lane;
            const float a = wave_sum(F.in[I_LQ1][li * 64 + l] * F.in[I_LK1][li * 64 + l]), b = wave_sum(F.in[I_LQ2][li * 64 + l] * F.in[I_LK2][li * 64 + l]);
            const float lam_init = 0.8f - 0.6f * expf(-0.3f * (float)li);
            if (l == 0) { float* L = (float*)(F.ws + WS_LAM) + li * 4; L[0] = expf(a) - expf(b) + lam_init; L[1] = 1.f - lam_init; }
        }
    }
    { const f32x4* s = (const f32x4*)F.in[I_CTX]; f32x4* d = (f32x4*)(F.ws + WS_XC); const int n4 = NB * CTXL * DM / 4;
      for (int i = F.bx * 512 + F.tid; i < n4; i += F.G * 512) d[i] = s[i]; }
}

DI void transpose_item(const float* W, int ldw, int k0, int n0, bf16* WT, int ldd, int drow0, LAS float* scr, int lane) {
#pragma unroll 8
    for (int i = 0; i < 32; ++i) { const int kk = 2 * i + (lane >> 5); scr[kk * 33 + (lane & 31)] = W[(size_t)(k0 + kk) * ldw + n0 + (lane & 31)]; }
    LDS_WAIT(); asm volatile("" ::: "memory");
    const int c = lane & 7;
#pragma unroll
    for (int j = 0; j < 4; ++j) { const int n = (lane >> 3) + 8 * j; const LAS float* s = scr + (8 * c) * 33 + n;
        v4u o; o.x = pk2(s[0 * 33], s[1 * 33]); o.y = pk2(s[2 * 33], s[3 * 33]); o.z = pk2(s[4 * 33], s[5 * 33]); o.w = pk2(s[6 * 33], s[7 * 33]);
        *(v4u*)(WT + (size_t)(drow0 + n) * ldd + k0 + 8 * c) = o; }
    LDS_WAIT(); asm volatile("" ::: "memory");
}
DI void phase_wx(const Frame& F, int li) {
    LAS float* scr = (LAS float*)(F.lds + F.wave * 16384);
    unsigned char* wm = F.ws + WS_WMIX; unsigned char* we = F.ws + WS_WEXP;
    constexpr int I_IN = 16 * 136, I_G = 3 * 16 * 32, I_B = 3 * 8 * 32, I_O = 16 * 32, I_E = 16 * 16 * 32;
    constexpr int NITEMS = I_IN + I_G + I_B + I_O + 3 * I_E;
    for (int it = F.gw; it < NITEMS; it += F.NGW) {
        int r = it;
        if (r < I_IN) { const int kb = r / 136, nb = r % 136, n0 = nb * 32, pn = n0 >> 8, wi = n0 & 255, wc = wi >> 6, bj = (wi >> 5) & 1;
            transpose_item(F.in[I_WIN] + (size_t)li * 1024 * INCOLS, INCOLS, kb * 64, n0, (bf16*)(wm + WM_WIN), 1024, pn * 256 + bj * 128 + wc * 32, scr, F.lane); continue; } r -= I_IN;
        if (r < I_G) { const int i = r / 512, q = r % 512, kb = q / 32, nb = q % 32;
            transpose_item(F.in[I_WMG] + ((size_t)li * 3 + i) * 1024 * 1024, 1024, kb * 64, nb * 32, (bf16*)(wm + WM_WG), 1024, i * 1024 + nb * 32, scr, F.lane); continue; } r -= I_G;
        if (r < I_B) { const int i = r / 256, q = r % 256, kb = q / 32, nb = q % 32;
            transpose_item(F.in[I_WBR] + ((size_t)li * 3 + i) * 512 * 1024, 1024, kb * 64, nb * 32, (bf16*)(wm + WM_WB) + (size_t)i * 1024 * 512, 512, nb * 32, scr, F.lane); continue; } r -= I_B;
        if (r < I_O) { const int kb = r / 32, nb = r % 32;
            transpose_item(F.in[I_WOUT] + (size_t)li * 1024 * 1024, 1024, kb * 64, nb * 32, (bf16*)(wm + WM_WO), 1024, nb * 32, scr, F.lane); continue; } r -= I_O;
        { const int which = r / I_E, q = r % I_E, e = q / 512, q2 = q % 512, kb = q2 / 32, nb = q2 % 32, n0 = nb * 32;
          const size_t eo = ((size_t)li * NEXP + e) * 1024 * 1024;
          if (which == 0)      transpose_item(F.in[I_WEG] + eo, 1024, kb * 64, n0, (bf16*)(we + WE_GU) + (size_t)e * 2048 * 1024, 1024, (n0 >> 7) * 256 + (n0 & 127), scr, F.lane);
          else if (which == 1) transpose_item(F.in[I_WEU] + eo, 1024, kb * 64, n0, (bf16*)(we + WE_GU) + (size_t)e * 2048 * 1024, 1024, (n0 >> 7) * 256 + 128 + (n0 & 127), scr, F.lane);
          else                 transpose_item(F.in[I_WED] + eo, 1024, kb * 64, n0, (bf16*)(we + WE_D) + (size_t)e * 1024 * 1024, 1024, n0, scr, F.lane); }
    }
}

template <int WHICH> DI void phase_norm(const Frame& F, int li) {
    LAS float* wT = (LAS float*)F.lds;
    { const float* W = WHICH == 0 ? F.in[I_WIN] + (size_t)li * 1024 * INCOLS + NPROJ : F.in[I_WRT] + (size_t)li * 1024 * 16; const int ldw = WHICH == 0 ? INCOLS : 16;
      for (int i = F.tid; i < 16384; i += 512) { const int k = i >> 4, j = i & 15; wT[j * 1028 + k] = W[(size_t)k * ldw + j]; } }
    __syncthreads();
    const float* nw = F.in[WHICH == 0 ? I_N1W : I_N2W] + li * 1024; const float* mv = modv_of(F, li);
    const float* xl = WHICH == 0 ? lat_x(F, li) : F.out; const float* xc = WHICH == 0 ? ctx_x(F, li) : (const float*)(F.ws + WS_XC);
    bf16* H = (bf16*)(F.ws + WS_H);
    f32x4 nwv[4];
#pragma unroll
    for (int j = 0; j < 4; ++j) nwv[j] = *(const f32x4*)(nw + 4 * F.lane + 256 * j);
    for (int row = F.gw; row < MROWS; row += F.NGW) {
        const int b = row / TPB, t = row - b * TPB; const bool lat = t < SEQ; const int mi = lat ? b : 8;
        const float* xr = lat ? xl + ((size_t)b * SEQ + t) * DM : xc + ((size_t)b * CTXL + (t - SEQ)) * DM;
        const float* sh = mv + mi * 6144 + (WHICH == 0 ? 0 : 3072); const float* sc = sh + 1024;
        f32x4 v[4]; float ss = 0.f;
#pragma unroll
        for (int j = 0; j < 4; ++j) { v[j] = *(const f32x4*)(xr + 4 * F.lane + 256 * j); ss += (v[j][0] * v[j][0] + v[j][1] * v[j][1]) + (v[j][2] * v[j][2] + v[j][3] * v[j][3]); }
        const float rstd = rsqrtf(wave_sum(ss) * (1.f / DM) + EPSN);
        float acc[16];
#pragma unroll
        for (int e = 0; e < 16; ++e) acc[e] = 0.f;
#pragma unroll
        for (int j = 0; j < 4; ++j) {
            const f32x4 s1 = *(const f32x4*)(sc + 4 * F.lane + 256 * j), s0 = *(const f32x4*)(sh + 4 * F.lane + 256 * j);
            v[j] = (v[j] * rstd * nwv[j]) * (s1 + 1.f) + s0;
            v2u o; o.x = pk2(v[j][0], v[j][1]); o.y = pk2(v[j][2], v[j][3]);
            *(v2u*)(H + (size_t)row * DM + 4 * F.lane + 256 * j) = o;
#pragma unroll
            for (int e = 0; e < 16; ++e) { const f32x4 w = *(const LAS f32x4*)(wT + e * 1028 + 4 * F.lane + 256 * j); acc[e] += (v[j][0] * w[0] + v[j][1] * w[1]) + (v[j][2] * w[2] + v[j][3] * w[3]);
                if ((e & 7) == 7) asm volatile("" ::: "memory"); }
        }
        const float val = reduce16(acc, F.lane);
        const int j = ((F.lane >> 5) & 1) * 8 + ((F.lane >> 4) & 1) * 4 + ((F.lane >> 3) & 1) * 2 + ((F.lane >> 2) & 1);
        if (WHICH == 0) {
            float o;
            if (j < 8) o = sigmoidf_(val);
            else { const float xx = val + F.in[I_DTB][li * 8 + (j - 8)]; const float sp = xx > 20.f ? xx : log1pf(expf(xx)); o = -expf(F.in[I_ALOG][li * 8 + (j - 8)]) * sp; }
            if ((F.lane & 3) == 0) ((float*)(F.ws + WS_GDNG))[(size_t)row * 16 + j] = o;
        } else {
            float m = val;
            m = fmaxf(m, __shfl_xor(m, 4)); m = fmaxf(m, __shfl_xor(m, 8)); m = fmaxf(m, __shfl_xor(m, 16)); m = fmaxf(m, __shfl_xor(m, 32));
            const float e = expf(val - m); float s = e;
            s += __shfl_xor(s, 4); s += __shfl_xor(s, 8); s += __shfl_xor(s, 16); s += __shfl_xor(s, 32);
            const float p = e / s;
            if ((F.lane & 3) == 0) { float* A = (float*)(F.ws + WS_AFF);
                if (lat) A[((size_t)b * 16 + j) * SEQ + t] = p; else A[(size_t)NB * 16 * SEQ + ((size_t)b * 16 + j) * CTXL + (t - SEQ)] = p; }
        }
    }
}

DI void phase_cv(const Frame& F, int li) {
    const bf16* P = (const bf16*)(F.ws + WS_CPRE); bf16* O = (bf16*)(F.ws + WS_POST);
    const float* cw = F.in[I_CONVW] + (size_t)li * 3 * 1536;
    float w[3][3][8];
#pragma unroll
    for (int tp = 0; tp < 3; ++tp)
#pragma unroll
        for (int g = 0; g < 3; ++g) { const f32x4 a = *(const f32x4*)(cw + tp * 1536 + g * 512 + 8 * F.lane), b = *(const f32x4*)(cw + tp * 1536 + g * 512 + 8 * F.lane + 4);
#pragma unroll
            for (int e = 0; e < 4; ++e) { w[tp][g][e] = a[e]; w[tp][g][4 + e] = b[e]; } }
    for (int row = F.gw; row < MROWS; row += F.NGW) {
        const int t = row % TPB; const bool hp = (t != 0) && (t != SEQ), hn = (t != SEQ - 1) && (t != TPB - 1);
#pragma unroll
        for (int g = 0; g < 3; ++g) {
            float a[8];
#pragma unroll
            for (int e = 0; e < 8; ++e) a[e] = 0.f;
#pragma unroll
            for (int tp = 0; tp < 3; ++tp) {
                const bool ok = tp == 1 || (tp == 0 ? hp : hn);
                v4u x = {0u, 0u, 0u, 0u};
                if (ok) x = *(const v4u*)(P + (size_t)(row + tp - 1) * 1536 + g * 512 + 8 * F.lane);
                a[0] += w[tp][g][0] * bflo(x.x); a[1] += w[tp][g][1] * bfhi(x.x); a[2] += w[tp][g][2] * bflo(x.y); a[3] += w[tp][g][3] * bfhi(x.y);
                a[4] += w[tp][g][4] * bflo(x.z); a[5] += w[tp][g][5] * bfhi(x.z); a[6] += w[tp][g][6] * bflo(x.w); a[7] += w[tp][g][7] * bfhi(x.w);
            }
            float ss = 0.f;
#pragma unroll
            for (int e = 0; e < 8; ++e) { a[e] = siluf_(a[e]); ss += a[e] * a[e]; }
            if (g < 2) { ss = sum16(ss); const float r = rsqrtf(ss + EPSN) * (g == 0 ? 0.08838834764831845f : 1.f);
#pragma unroll
                for (int e = 0; e < 8; ++e) a[e] *= r; }
            v4u o; o.x = pk2(a[0], a[1]); o.y = pk2(a[2], a[3]); o.z = pk2(a[4], a[5]); o.w = pk2(a[6], a[7]);
            *(v4u*)(O + (size_t)row * 1536 + g * 512 + 8 * F.lane) = o;
        }
    }
}

DI void phase_gf(const Frame& F, int li) {
    const bf16* O0 = (const bf16*)(F.ws + WS_CPRE); const bf16* O1 = O0 + (size_t)MROWS * 512; const bf16* Z = (const bf16*)(F.ws + WS_Z); bf16* Y = (bf16*)(F.ws + WS_YG);
    const float* gw = F.in[I_GNW] + li * 128 + 8 * (F.lane & 15);
    const f32x4 w0 = *(const f32x4*)gw, w1 = *(const f32x4*)(gw + 4);
    for (int row = F.gw; row < MROWS; row += F.NGW) {
        const size_t o = (size_t)row * 512 + 8 * F.lane;
        const v4u a = *(const v4u*)(O0 + o), b = *(const v4u*)(O1 + o), z = *(const v4u*)(Z + o);
        float v[8] = {bflo(a.x) + bflo(b.x), bfhi(a.x) + bfhi(b.x), bflo(a.y) + bflo(b.y), bfhi(a.y) + bfhi(b.y), bflo(a.z) + bflo(b.z), bfhi(a.z) + bfhi(b.z), bflo(a.w) + bflo(b.w), bfhi(a.w) + bfhi(b.w)};
        const float zz[8] = {bflo(z.x), bfhi(z.x), bflo(z.y), bfhi(z.y), bflo(z.z), bfhi(z.z), bflo(z.w), bfhi(z.w)};
        float ss = 0.f;
#pragma unroll
        for (int e = 0; e < 8; ++e) ss += v[e] * v[e];
        const float r = rsqrtf(sum16(ss) * (1.f / 128.f) + EPSN);
#pragma unroll
        for (int e = 0; e < 8; ++e) v[e] = v[e] * r * (e < 4 ? w0[e] : w1[e - 4]) * siluf_(zz[e]);
        v4u ov; ov.x = pk2(v[0], v[1]); ov.y = pk2(v[2], v[3]); ov.z = pk2(v[4], v[5]); ov.w = pk2(v[6], v[7]);
        *(v4u*)(Y + o) = ov;
    }
}

DI void phase_bf(const Frame& F, int li) {
    const bf16* OB = (const bf16*)(F.ws + WS_OB); bf16* Y = (bf16*)(F.ws + WS_YB);
    const float lam = ((const float*)(F.ws + WS_LAM))[li * 4], oml = ((const float*)(F.ws + WS_LAM))[li * 4 + 1];
    const float* sw = F.in[I_SUBLN] + li * 128 + 8 * (F.lane & 15);
    const f32x4 w0 = *(const f32x4*)sw, w1 = *(const f32x4*)(sw + 4);
    const int h = F.lane >> 4, e0 = (F.lane & 15) * 8;
    for (int row = F.gw; row < MROWS; row += F.NGW) {
        const bf16* p = OB + (size_t)row * 1024 + h * 256 + e0;
        const v4u a = *(const v4u*)p, b = *(const v4u*)(p + 128);
        float v[8] = {bflo(a.x) - lam * bflo(b.x), bfhi(a.x) - lam * bfhi(b.x), bflo(a.y) - lam * bflo(b.y), bfhi(a.y) - lam * bfhi(b.y),
                      bflo(a.z) - lam * bflo(b.z), bfhi(a.z) - lam * bfhi(b.z), bflo(a.w) - lam * bflo(b.w), bfhi(a.w) - lam * bfhi(b.w)};
        float ss = 0.f;
#pragma unroll
        for (int e = 0; e < 8; ++e) ss += v[e] * v[e];
        const float r = rsqrtf(sum16(ss) * (1.f / 128.f) + EPSN) * oml;
#pragma unroll
        for (int e = 0; e < 8; ++e) v[e] = v[e] * r * (e < 4 ? w0[e] : w1[e - 4]);
        v4u ov; ov.x = pk2(v[0], v[1]); ov.y = pk2(v[2], v[3]); ov.z = pk2(v[4], v[5]); ov.w = pk2(v[6], v[7]);
        *(v4u*)(Y + (size_t)row * 512 + 8 * F.lane) = ov;
    }
}

DI void phase_ga(const Frame& F) {
    const int* idx = (const int*)(F.ws + WS_IDX); const bf16* H = (const bf16*)(F.ws + WS_H); bf16* X = (bf16*)(F.ws + WS_XIN);
    for (int r = F.gw; r < NSLOT; r += F.NGW) {
        const int src = __builtin_amdgcn_readfirstlane(idx[r]);
        const v4u a = *(const v4u*)(H + (size_t)src * DM + 8 * F.lane), b = *(const v4u*)(H + (size_t)src * DM + 512 + 8 * F.lane);
        *(v4u*)(X + (size_t)r * DM + 8 * F.lane) = a; *(v4u*)(X + (size_t)r * DM + 512 + 8 * F.lane) = b;
    }
}

DI void phase_cb(const Frame& F, int li) {
    const int* inv = (const int*)(F.ws + WS_INV); const bf16* Y = (const bf16*)(F.ws + WS_XIN);
    const bool last = li == NLAYER - 1;
    for (int row = F.gw; row < MROWS; row += F.NGW) {
        const int b = row / TPB, t = row - b * TPB; const bool lat = t < SEQ;
        if (!lat && last) continue;
        float* xr = lat ? F.out + ((size_t)b * SEQ + t) * DM : (float*)(F.ws + WS_XC) + ((size_t)b * CTXL + (t - SEQ)) * DM;
        f32x4 v[4];
#pragma unroll
        for (int j = 0; j < 4; ++j) v[j] = *(const f32x4*)(xr + 4 * F.lane + 256 * j);
        for (int e = 0; e < NEXP; ++e) {
            const int s = __builtin_amdgcn_readfirstlane(inv[((size_t)b * NEXP + e) * TPB + t]);
            if (s >= 0) {
#pragma unroll
                for (int j = 0; j < 4; ++j) { const v2u y = *(const v2u*)(Y + (size_t)s * DM + 4 * F.lane + 256 * j); v[j][0] += bflo(y.x); v[j][1] += bfhi(y.x); v[j][2] += bflo(y.y); v[j][3] += bfhi(y.y); }
            }
        }
#pragma unroll
        for (int j = 0; j < 4; ++j) *(f32x4*)(xr + 4 * F.lane + 256 * j) = v[j];
    }
}
typedef float f32x16 __attribute__((ext_vector_type(16)));
DI int crow32(int r, int hi) { return (r & 3) + 8 * (r >> 2) + 4 * hi; }
#define MFMA32(a, b, c) __builtin_amdgcn_mfma_f32_32x32x16_bf16((a), (b), (c), 0, 0, 0)
#define MFMA16(a, b, c) __builtin_amdgcn_mfma_f32_16x16x32_bf16((a), (b), (c), 0, 0, 0)

DI void phase_cl(const Frame& F) {
    LAS float* Am = (LAS float*)(F.lds + F.wave * 16384);
    LAS float* gcv = (LAS float*)(F.lds + LDS_XTRA + F.wave * 512);
    LAS float* btv = gcv + 64;
    const bf16* P = (const bf16*)(F.ws + WS_POST); const float* GG = (const float*)(F.ws + WS_GDNG);
    const int L = F.lane, r = L & 31, hh = L >> 5;
    for (int unit = F.gw; unit < NB * NCHUNK * 8; unit += F.NGW) {
        const int dir = unit & 1, h = (unit >> 1) & 3, bc = unit >> 3; const size_t row0 = (size_t)bc * 64;
        unsigned char* tq = F.ws + WS_TQ + (size_t)unit * 16384; float* gcb = (float*)(F.ws + WS_GCB) + (size_t)unit * 128;
        const int io = dir ? 63 - L : L;
        const float g = GG[(row0 + io) * 16 + 8 + dir * 4 + h], beta = GG[(row0 + io) * 16 + dir * 4 + h];
        float gc = g;
#pragma unroll
        for (int o = 1; o < 64; o <<= 1) { const float t = __shfl_up(gc, o); if (L >= o) gc += t; }
        gcv[L] = gc; btv[L] = beta; gcb[io] = gc; gcb[64 + io] = beta;
        bf16x8 kf[2][8], qf[2][8];
#pragma unroll
        for (int rb = 0; rb < 2; ++rb) { const int ir = 32 * rb + r, orr = dir ? 63 - ir : ir; const bf16* pr = P + (row0 + orr) * 1536 + h * 128 + 8 * hh;
#pragma unroll
            for (int s = 0; s < 8; ++s) { kf[rb][s] = *(const bf16x8*)(pr + 512 + 16 * s); qf[rb][s] = *(const bf16x8*)(pr + 16 * s); } }
        LDS_WAIT();
        LAS float* Amb = Am + hh * 256 + r; const LAS float* gch = gcv + 4 * hh; const LAS float* bth = btv + 4 * hh; const LAS float* gcr = gcv + r;
#pragma unroll
        for (int tt = 0; tt < 3; ++tt) { const int ta = tt == 1 ? 0 : 1, tb = tt == 2 ? 1 : 0;
            f32x16 x = {};
#pragma unroll
            for (int s = 0; s < 8; ++s) x = MFMA32(kf[ta][s], kf[tb][s], x);
            const float gcj = gcr[32 * tb];
#pragma unroll
            for (int q = 0; q < 16; ++q) { const int ci = 32 * ta + (q & 3) + 8 * (q >> 2); Amb[ci * 64 + 32 * tb] = bth[ci] * x[q] * __expf(fminf(gch[ci] - gcj, 0.f)); }
            asm volatile("" ::: "memory"); }
        const int sg = dir ? -1 : 1;
        bf16* qkb = (bf16*)(tq + 8192) + (dir ? (63 - 4 * hh) * 64 + (63 - r) : 4 * hh * 64 + r);
#pragma unroll
        for (int tt = 0; tt < 4; ++tt) { const int ta = tt >> 1, tb = tt & 1;
            f32x16 x = {};
            if (!(ta == 0 && tb == 1)) {
#pragma unroll
                for (int s = 0; s < 8; ++s) x = MFMA32(qf[ta][s], kf[tb][s], x);
            }
            const float gcj = gcr[32 * tb]; const int jj = 32 * tb + r;
#pragma unroll
            for (int q = 0; q < 16; ++q) { const int ci = 32 * ta + (q & 3) + 8 * (q >> 2);
                const float val = jj <= ci + 4 * hh ? x[q] * __expf(gch[ci] - gcj) : 0.f; qkb[sg * (ci * 64 + 32 * tb)] = (bf16)f2bf(val); }
            asm volatile("" ::: "memory"); }
        LDS_WAIT(); asm volatile("" ::: "memory");
        float T[64];
#pragma unroll
        for (int i = 0; i < 64; ++i) {
            float a = (i == L) ? 1.f : 0.f;
#pragma unroll
            for (int j4 = 0; j4 < (i + 3) / 4; ++j4) { const f32x4 av = *(const LAS f32x4*)(Am + i * 64 + 4 * j4);
#pragma unroll
                for (int e = 0; e < 4; ++e) if (4 * j4 + e < i) a -= av[e] * T[4 * j4 + e]; }
            T[i] = a;
            if ((i & 3) == 3) asm volatile("" ::: "memory");
        }
        bf16* tpb = (bf16*)tq + (dir ? 63 * 64 + 63 - L : L);
#pragma unroll
        for (int i = 0; i < 64; ++i) tpb[sg * (i * 64)] = (bf16)f2bf(T[i]);
        LDS_WAIT(); asm volatile("" ::: "memory");
    }
}

constexpr int SC_KR = 0, SC_KT = 17408, SC_QR = 35840, SC_VR = 53248, SC_TR = 58368, SC_QK = 67584, SC_VEC = 76800, SC_ST = 77824, SC_RT = 86528, SC_VN = 91136, SC_VS = 95744, SC_END = 100352;
DI v2u pack4(float a, float b, float c, float d) { v2u w; w.x = pk2(a, b); w.y = pk2(c, d); return w; }
DI void phase_sc(const Frame& F) {
    LAS unsigned char* S = F.lds;
    const bf16* P = (const bf16*)(F.ws + WS_POST); bf16* OD = (bf16*)(F.ws + WS_CPRE);
    const int tid = F.tid, w = F.wave, l15 = F.lane & 15, quad = F.lane >> 4;
    for (int unit = F.bx; unit < 256; unit += F.G) {
        const int sl = unit & 3, dir = (unit >> 2) & 1, h = (unit >> 3) & 3, b = unit >> 5;
        __syncthreads();
        for (int i = tid; i < 8704 / 4; i += 512) ((LAS unsigned*)(S + SC_ST))[i] = 0u;
        f32x4 Sacc[2] = {{0.f, 0.f, 0.f, 0.f}, {0.f, 0.f, 0.f, 0.f}};
        v4u rk[2], rq[2], rv, rt, rqk, rvec;
        const int last_i = dir ? 0 : 63;
#define SC_CHUNK(n) ((n) < 4 ? (dir ? 131 - (n) : 128 + (n)) : (dir ? 131 - (n) : (n) - 4))
#define SC_LOAD(n) do { const int ch_ = SC_CHUNK(n); const size_t r0_ = ((size_t)b * NCHUNK + ch_) * 64; const size_t u_ = ((((size_t)b * NCHUNK + ch_) * 4 + h) * 2 + dir); \
        _Pragma("unroll") for (int i_ = 0; i_ < 2; ++i_) { const int v_ = tid + 512 * i_, rr_ = v_ >> 4, c_ = v_ & 15; const bf16* p_ = P + (r0_ + rr_) * 1536 + h * 128 + c_ * 8; rk[i_] = *(const v4u*)(p_ + 512); rq[i_] = *(const v4u*)p_; } \
        if (tid < 256) rv = *(const v4u*)(P + (r0_ + (tid >> 2)) * 1536 + 1024 + h * 128 + sl * 32 + (tid & 3) * 8); \
        rt = *(const v4u*)(F.ws + WS_TQ + u_ * 16384 + (size_t)tid * 16); rqk = *(const v4u*)(F.ws + WS_TQ + u_ * 16384 + 8192 + (size_t)tid * 16); \
        if (tid < 32) rvec = *(const v4u*)((const float*)(F.ws + WS_GCB) + u_ * 128 + tid * 4); } while (0)
#define SC_WRITE() do { \
        _Pragma("unroll") for (int i_ = 0; i_ < 2; ++i_) { const int v_ = tid + 512 * i_, rr_ = v_ >> 4, c_ = v_ & 15; \
            *(LAS v4u*)(S + SC_KR + rr_ * 272 + c_ * 16) = rk[i_]; *(LAS v4u*)(S + SC_QR + rr_ * 272 + c_ * 16) = rq[i_]; \
            LAS unsigned short* kt_ = (LAS unsigned short*)(S + SC_KT) + (c_ * 8) * 72 + rr_; \
            kt_[0 * 72] = (unsigned short)(rk[i_].x & 0xffffu); kt_[1 * 72] = (unsigned short)(rk[i_].x >> 16); kt_[2 * 72] = (unsigned short)(rk[i_].y & 0xffffu); kt_[3 * 72] = (unsigned short)(rk[i_].y >> 16); \
            kt_[4 * 72] = (unsigned short)(rk[i_].z & 0xffffu); kt_[5 * 72] = (unsigned short)(rk[i_].z >> 16); kt_[6 * 72] = (unsigned short)(rk[i_].w & 0xffffu); kt_[7 * 72] = (unsigned short)(rk[i_].w >> 16); } \
        if (tid < 256) *(LAS v4u*)(S + SC_VR + (tid >> 2) * 80 + (tid & 3) * 16) = rv; \
        *(LAS v4u*)(S + SC_TR + (tid >> 3) * 144 + (tid & 7) * 16) = rt; *(LAS v4u*)(S + SC_QK + (tid >> 3) * 144 + (tid & 7) * 16) = rqk; \
        if (tid < 32) *(LAS v4u*)(S + SC_VEC + tid * 16) = rvec; } while (0)
        SC_LOAD(0); VM_WAIT(); SC_WRITE(); LDS_WAIT(); __syncthreads();
        const LAS float* gcs = (const LAS float*)(S + SC_VEC); const LAS float* bts = gcs + 64;
        for (int n = 0; n < NCHUNK; ++n) {
            if (n + 1 < NCHUNK) SC_LOAD(n + 1);
            const size_t row0 = ((size_t)b * NCHUNK + SC_CHUNK(n)) * 64;
            const float gcl = gcs[last_i];
            const int tr = w & 3, tc = w >> 2, dvt = w & 1, tt = w >> 1;
            f32x4 ks = {0.f, 0.f, 0.f, 0.f};
#pragma unroll
            for (int s = 0; s < 4; ++s) { const bf16x8 a = *(const LAS bf16x8*)(S + SC_KR + (16 * tr + l15) * 272 + (32 * s + 8 * quad) * 2), bb = *(const LAS bf16x8*)(S + SC_ST + (16 * tc + l15) * 272 + (32 * s + 8 * quad) * 2); ks = MFMA16(a, bb, ks); }
            { float rr[4];
#pragma unroll
              for (int jj = 0; jj < 4; ++jj) { const int tok = 16 * tr + 4 * quad + jj; const float vv = bf2f(*(const LAS unsigned short*)(S + SC_VR + tok * 80 + (16 * tc + l15) * 2));
                  rr[jj] = bts[tok] * (vv - __expf(gcs[tok]) * ks[jj]); }
              *(LAS v2u*)(S + SC_RT + (16 * tc + l15) * 144 + (16 * tr + 4 * quad) * 2) = pack4(rr[0], rr[1], rr[2], rr[3]); }
            f32x4 os = {0.f, 0.f, 0.f, 0.f};
#pragma unroll
            for (int s = 0; s < 4; ++s) { const bf16x8 a = *(const LAS bf16x8*)(S + SC_ST + (16 * dvt + l15) * 272 + (32 * s + 8 * quad) * 2), bb = *(const LAS bf16x8*)(S + SC_QR + (16 * tt + l15) * 272 + (32 * s + 8 * quad) * 2); os = MFMA16(a, bb, os); }
            LDS_WAIT(); __syncthreads();
            f32x4 vn = {0.f, 0.f, 0.f, 0.f};
#pragma unroll
            for (int s = 0; s < 2; ++s) { const bf16x8 a = *(const LAS bf16x8*)(S + SC_TR + (16 * tr + l15) * 144 + (32 * s + 8 * quad) * 2), bb = *(const LAS bf16x8*)(S + SC_RT + (16 * tc + l15) * 144 + (32 * s + 8 * quad) * 2); vn = MFMA16(a, bb, vn); }
            { float sc[4];
#pragma unroll
              for (int jj = 0; jj < 4; ++jj) sc[jj] = vn[jj] * __expf(gcl - gcs[16 * tr + 4 * quad + jj]);
              *(LAS v2u*)(S + SC_VN + (16 * tc + l15) * 144 + (16 * tr + 4 * quad) * 2) = pack4(vn[0], vn[1], vn[2], vn[3]);
              *(LAS v2u*)(S + SC_VS + (16 * tc + l15) * 144 + (16 * tr + 4 * quad) * 2) = pack4(sc[0], sc[1], sc[2], sc[3]); }
            LDS_WAIT(); __syncthreads();
            { const float eg = __expf(gcs[16 * tt + l15]); f32x4 oa = os * eg;
#pragma unroll
              for (int s = 0; s < 2; ++s) { const bf16x8 a = *(const LAS bf16x8*)(S + SC_VN + (16 * dvt + l15) * 144 + (32 * s + 8 * quad) * 2), bb = *(const LAS bf16x8*)(S + SC_QK + (16 * tt + l15) * 144 + (32 * s + 8 * quad) * 2); oa = MFMA16(a, bb, oa); }
              *(v2u*)(OD + ((size_t)dir * MROWS + row0 + 16 * tt + l15) * 512 + h * 128 + sl * 32 + 16 * dvt + 4 * quad) = pack4(oa[0], oa[1], oa[2], oa[3]); }
            { const float gl = __expf(gcl); bf16x8 a[2];
#pragma unroll
              for (int s = 0; s < 2; ++s) a[s] = *(const LAS bf16x8*)(S + SC_KT + (16 * w + l15) * 144 + (32 * s + 8 * quad) * 2);
#pragma unroll
              for (int d = 0; d < 2; ++d) { f32x4 acc = Sacc[d] * gl;
#pragma unroll
                  for (int s = 0; s < 2; ++s) { const bf16x8 bb = *(const LAS bf16x8*)(S + SC_VS + (16 * d + l15) * 144 + (32 * s + 8 * quad) * 2); acc = MFMA16(a[s], bb, acc); }
                  Sacc[d] = acc; *(LAS v2u*)(S + SC_ST + (16 * d + l15) * 272 + (16 * w + 4 * quad) * 2) = pack4(acc[0], acc[1], acc[2], acc[3]); } }
            VM_WAIT(); LDS_WAIT(); __syncthreads();
            if (n + 1 < NCHUNK) SC_WRITE();
            LDS_WAIT(); __syncthreads();
        }
#undef SC_LOAD
#undef SC_WRITE
#undef SC_CHUNK
    }
}

template <int N, int K> DI void topk_unit(const Frame& F, const float* aff, int slot_base, int row_base, int inv_base) {
    constexpr int EPT = N >= 512 ? N / 512 : 1;
    LAS unsigned* hist = (LAS unsigned*)F.lds;
    LAS unsigned* ctl = hist + 256;
    LAS unsigned* wsum = ctl + 8;
    LAS unsigned* keys = hist + 1024;
    const int tid = F.tid; const bool act = tid * EPT < N;
    if (act) {
#pragma unroll 4
        for (int e = 0; e < EPT; ++e) keys[e * 512 + tid] = __builtin_bit_cast(unsigned, aff[tid * EPT + e]);
    }
    unsigned prefix = 0u, kk = K;
    for (int pass = 0; pass < 4; ++pass) {
        const int shift = 24 - 8 * pass; const unsigned himask = pass == 0 ? 0u : (0xffffffffu << (shift + 8));
        if (tid < 256) hist[tid] = 0u;
        __syncthreads();
        if (act) {
#pragma unroll 4
            for (int e = 0; e < EPT; ++e) { const unsigned key = keys[e * 512 + tid]; if ((key & himask) == prefix) __hip_atomic_fetch_add(&hist[(key >> shift) & 255u], 1u, __ATOMIC_RELAXED, __HIP_MEMORY_SCOPE_WORKGROUP); }
        }
        __syncthreads();
        if (F.wave == 0) {
            const int l = F.lane; const unsigned h0 = hist[4 * l], h1 = hist[4 * l + 1], h2 = hist[4 * l + 2], h3 = hist[4 * l + 3];
            const unsigned mine = h0 + h1 + h2 + h3; unsigned above = mine;
#pragma unroll
            for (int o = 1; o < 64; o <<= 1) { const unsigned t = __shfl_down(above, o); if (l + o < 64) above += t; }
            const unsigned excl = above - mine;
            if (excl < kk && kk <= above) {
                unsigned c = excl, d;
                if (kk <= c + h3) { d = 3; } else { c += h3; if (kk <= c + h2) { d = 2; } else { c += h2; if (kk <= c + h1) { d = 1; } else { c += h1; d = 0; } } }
                ctl[0] = prefix | ((unsigned)(4 * l + d) << shift); ctl[1] = kk - c;
            }
        }
        __syncthreads();
        prefix = ctl[0]; kk = ctl[1];
        __syncthreads();
    }
    const unsigned thr = prefix;
    unsigned ngt = 0, neq = 0;
    if (act) {
#pragma unroll 4
        for (int e = 0; e < EPT; ++e) { const unsigned key = keys[e * 512 + tid]; ngt += key > thr ? 1u : 0u; neq += key == thr ? 1u : 0u; }
    }
    unsigned sg = ngt, se = neq;
#pragma unroll
    for (int o = 1; o < 64; o <<= 1) { const unsigned a = __shfl_up(sg, o), b = __shfl_up(se, o); if (F.lane >= o) { sg += a; se += b; } }
    if (F.lane == 63) { wsum[F.wave] = sg; wsum[8 + F.wave] = se; }
    __syncthreads();
    unsigned og = sg - ngt, oe = se - neq, totg = 0;
#pragma unroll
    for (int ww = 0; ww < 8; ++ww) { const unsigned a = wsum[ww], b = wsum[8 + ww]; if (ww < F.wave) { og += a; oe += b; } totg += a; }
    int* idx = (int*)(F.ws + WS_IDX); float* wgt = (float*)(F.ws + WS_WGT); int* inv = (int*)(F.ws + WS_INV);
    if (act) {
#pragma unroll 2
        for (int e = 0; e < EPT; ++e) {
            const unsigned key = keys[e * 512 + tid];
            const int t = tid * EPT + e; int slot = -1;
            if (key > thr) slot = (int)(og++);
            else if (key == thr) { if (oe < kk) slot = (int)(totg + oe); ++oe; }
            if (slot >= 0) { idx[slot_base + slot] = row_base + t; wgt[slot_base + slot] = __builtin_bit_cast(float, key); }
            inv[inv_base + t] = slot >= 0 ? slot_base + slot : -1;
        }
    }
    __syncthreads();
}
DI void phase_tk(const Frame& F) {
    const float* A = (const float*)(F.ws + WS_AFF);
    for (int u = F.bx; u < 2 * NB * NEXP; u += F.G) {
        if (u < NB * NEXP) { const int b = u >> 4, e = u & 15; topk_unit<SEQ, CAP_L>(F, A + (size_t)u * SEQ, (e * 8 + b) * CAP_L, b * TPB, (b * NEXP + e) * TPB); }
        else { const int v = u - NB * NEXP, b = v >> 4, e = v & 15; topk_unit<CTXL, CAP_C>(F, A + (size_t)NB * NEXP * SEQ + (size_t)v * CTXL, NSLOT_L + e * 256 + b * CAP_C, b * TPB + SEQ, (b * NEXP + e) * TPB + SEQ); }
    }
}
DI void phase_at(const Frame& F, int li) {
    typedef attn_body::bf16 abf;
    const bool need_ctx = li != NLAYER - 1;
    unsigned char* ws = F.ws;
    for (int i = 0;; ++i) {
        const int L = i * F.G + F.vcu; if (L >= 25 * 256) break;
        const int step = L >> 8, slot = L & 255, b = slot >> 5, j = slot & 31;
        int kind, head, q0, krow0, NT;
        if (step < 8) { kind = 0; head = step; q0 = j * 256; krow0 = 0; NT = TPB / 64; }
        else if (step < 24) { kind = 1; head = step - 8; q0 = j * 256; krow0 = 0; NT = TPB / 64; }
        else { if (!need_ctx || j >= 24) continue; if (j < 8) { kind = 0; head = j; } else { kind = 1; head = j - 8; } q0 = SEQ; krow0 = SEQ; NT = CTXL / 64; }
        const size_t qrow = (size_t)b * TPB + q0, krow = (size_t)b * TPB + krow0;
        if (kind == 0) {
            abf* Q = (abf*)(ws + WS_YA) + qrow * 512 + head * 64;
            const abf* K = (const abf*)(ws + WS_KA) + krow * 128 + (head >> 2) * 64; const abf* V = (const abf*)(ws + WS_VA) + krow * 128 + (head >> 2) * 64;
            attn_body::attn_unit<8>(Q, 512, K, 128, V, 128, Q, 512, NT, (char*)F.lds, F.tid);
        } else {
            const int sh = head >> 1, vh = head & 1;
            const abf* Q = (const abf*)(ws + WS_QB) + qrow * 512 + sh * 64;
            const abf* K = (const abf*)(ws + WS_KB) + krow * 512 + sh * 64; const abf* V = (const abf*)(ws + WS_VB) + krow * 512 + (sh >> 1) * 128 + vh * 64;
            abf* O = (abf*)(ws + WS_OB) + qrow * 1024 + sh * 128 + vh * 64;
            attn_body::attn_unit<8>(Q, 512, K, 512, V, 512, O, 1024, NT, (char*)F.lds, F.tid);
        }
    }
}
constexpr int NPH = 19;
struct Args { const float* in[N_IN]; float* out; unsigned char* ws; int ph_lo, ph_hi, bar_region, pad; };
constexpr int CW_TMO = 0, CW_BAR = 4096;

__global__ void __launch_bounds__(512, 2) fwd_kernel(Args args) {
    extern __shared__ __attribute__((aligned(16))) unsigned char lds[];
    Frame F;
    F.lds = (LAS unsigned char*)lds; F.MISC = (volatile LAS unsigned*)(F.lds + MISC_OFF);
    F.tid = threadIdx.x; F.lane = F.tid & 63; F.wave = __builtin_amdgcn_readfirstlane(F.tid >> 6);
    F.G = gridDim.x; { const int bx = blockIdx.x; F.vcu = (F.G % 8 == 0) ? (bx % 8) * (F.G / 8) + bx / 8 : bx; }
    F.gw = F.vcu * 8 + F.wave; F.NGW = F.G * 8; F.bx = blockIdx.x;
    F.in.p = (kin_ptr)__builtin_amdgcn_kernarg_segment_ptr();
    F.out = args.out; F.ws = args.ws; F.ctl = (gu32*)(args.ws + WS_CTL);
    for (int u = F.tid; u < (LDS_BYTES - LDSCTL_OFF) / 4; u += 512) ((LAS unsigned*)(F.lds + LDSCTL_OFF))[u] = 0u;
    __syncthreads();
#if MK_ONE_LAUNCH
    XcdBarrier bar = xcd_barrier_post((unsigned*)(F.ctl + CW_BAR) + args.bar_region * XCD_BAR_WORDS, F.MISC + 8);
#define GRID_BAR() xcd_barrier(bar)
#else
#define GRID_BAR() do {} while (0)
#endif
    const int lo = args.ph_lo, hi = args.ph_hi;
#ifndef ONLY_PH
#define ONLY_PH -1
#endif
#define IN(k) ((ONLY_PH < 0 || ONLY_PH == ((k) % NPH)) && lo <= (k) && (k) < hi)
#define SEAM(k) do { if (IN(k) && IN((k) + 1)) GRID_BAR(); } while (0)
    for (int li = 0; li < NLAYER; ++li) {
        const int p0 = li * NPH;
#define PHASE_FRAME() Frame P = F; { int t_ = threadIdx.x; asm volatile("" : "+v"(t_)); P.tid = t_; P.lane = t_ & 63; kin_ptr k_ = (kin_ptr)__builtin_amdgcn_kernarg_segment_ptr(); asm volatile("" : "+s"(k_)); P.in.p = k_; unsigned char* w_ = F.ws; float* o_ = F.out; int v_ = F.vcu, G_ = F.G, b_ = F.bx; asm volatile("" : "+s"(w_), "+s"(o_), "+s"(v_), "+s"(G_), "+s"(b_)); P.ws = w_; P.out = o_; P.vcu = v_; P.G = G_; P.bx = b_; P.wave = __builtin_amdgcn_readfirstlane(P.tid >> 6); P.gw = v_ * 8 + P.wave; P.NGW = G_ * 8; P.ctl = (gu32*)(w_ + WS_CTL); } \
        unsigned char* ws = P.ws; unsigned char* wm = ws + WS_WMIX; unsigned char* we = ws + WS_WEXP; (void)wm; (void)we;
        asm volatile("; PHMARK 0" ::: "memory"); if (IN(p0 + 0)) { PHASE_FRAME(); if (li == 0) phase_p0(P); phase_wx(P, li); } SEAM(p0 + 0);
        asm volatile("; PHMARK 1" ::: "memory"); if (IN(p0 + 1)) { PHASE_FRAME(); phase_norm<0>(P, li); } SEAM(p0 + 1);
        asm volatile("; PHMARK 2" ::: "memory"); if (IN(p0 + 2)) { PHASE_FRAME();
            pg8::Gemm g{1024, 1024, 1024}; pg8::SchedMN S; S.init(ws + WS_H, 1024, wm + WM_WIN, 1024, MROWS / 256, 8, 9, P.G, P.bx);
            pg8::EpiInProj E{ws, P.in[I_GQN] + li * 64, P.in[I_GKN] + li * 64, P.in[I_DQN] + li * 64, P.in[I_DKN] + li * 64, (const float*)(ws + WS_ROPE)};
            pg8::gemm_phase<pg8::EpiInProj, pg8::SchedMN, true, true>(P.lds, g, S, E, P.tid);
        } SEAM(p0 + 2);
        asm volatile("; PHMARK 3" ::: "memory"); if (IN(p0 + 3)) { PHASE_FRAME(); phase_cv(P, li); } SEAM(p0 + 3);
        asm volatile("; PHMARK 4" ::: "memory"); if (IN(p0 + 4)) { PHASE_FRAME(); phase_cl(P); } SEAM(p0 + 4);
        asm volatile("; PHMARK 5" ::: "memory"); if (IN(p0 + 5)) { PHASE_FRAME(); phase_sc(P); } SEAM(p0 + 5);
        asm volatile("; PHMARK 6" ::: "memory"); if (IN(p0 + 6)) { PHASE_FRAME(); phase_gf(P, li); } SEAM(p0 + 6);
        asm volatile("; PHMARK 7" ::: "memory"); if (IN(p0 + 7)) { PHASE_FRAME();
            pg8::Gemm g{1024, 1024, 1024}; pg8::SchedMN S; S.init(ws + WS_H, 1024, wm + WM_WIN, 1024, MROWS / 256, 9, 0, P.G, P.bx);
            pg8::EpiInProj E{ws, P.in[I_GQN] + li * 64, P.in[I_GKN] + li * 64, P.in[I_DQN] + li * 64, P.in[I_DKN] + li * 64, (const float*)(ws + WS_ROPE)};
            pg8::gemm_phase<pg8::EpiInProj, pg8::SchedMN, true, true>(P.lds, g, S, E, P.tid);
        } SEAM(p0 + 7);
        asm volatile("; PHMARK 8" ::: "memory"); if (IN(p0 + 8)) { PHASE_FRAME(); phase_at(P, li); } SEAM(p0 + 8);
        asm volatile("; PHMARK 9" ::: "memory"); if (IN(p0 + 9)) { PHASE_FRAME(); phase_bf(P, li); } SEAM(p0 + 9);
        asm volatile("; PHMARK 10" ::: "memory"); if (IN(p0 + 10)) { PHASE_FRAME();
            pg8::Gemm g{1024, 1024, 1024}; pg8::SchedMN S; S.init(ws + WS_H, 1024, wm + WM_WG, 1024, MROWS / 256, 12, 0, P.G, P.bx);
            pg8::EpiBf<0> E{(pg8::bf16_t*)(ws + WS_G), 3072, nullptr};
            pg8::gemm_phase<pg8::EpiBf<0>, pg8::SchedMN, true, true>(P.lds, g, S, E, P.tid);
        } SEAM(p0 + 10);
        asm volatile("; PHMARK 11" ::: "memory"); if (IN(p0 + 11)) { PHASE_FRAME();
            pg8::Gemm g{512, 512, 512}; pg8::SchedMN S; S.init(ws + WS_YA, 512, wm + WM_WB, 512, MROWS / 256, 4, 0, P.G, P.bx);
            S.NZ = 3; S.a_z = 66 * MiB; S.b_z = (size_t)1024 * 512 * 2;
            pg8::EpiBf<1> E{(pg8::bf16_t*)(ws + WS_MRG), 1024, (const pg8::bf16_t*)(ws + WS_G)};
            pg8::gemm_phase<pg8::EpiBf<1>, pg8::SchedMN, true, true>(P.lds, g, S, E, P.tid);
        } SEAM(p0 + 11);
        asm volatile("; PHMARK 12" ::: "memory"); if (IN(p0 + 12)) { PHASE_FRAME();
            pg8::Gemm g{1024, 1024, 1024}; pg8::SchedMN S; S.init(ws + WS_MRG, 1024, wm + WM_WO, 1024, MROWS / 256, 4, 0, P.G, P.bx);
            pg8::EpiGO E{lat_x(P, li), ctx_x(P, li), P.out, (float*)(ws + WS_XC), modv_of(P, li)};
            pg8::gemm_phase<pg8::EpiGO, pg8::SchedMN, true, true>(P.lds, g, S, E, P.tid);
        } SEAM(p0 + 12);
        asm volatile("; PHMARK 13" ::: "memory"); if (IN(p0 + 13)) { PHASE_FRAME(); phase_norm<1>(P, li); } SEAM(p0 + 13);
        asm volatile("; PHMARK 14" ::: "memory"); if (IN(p0 + 14)) { PHASE_FRAME(); phase_tk(P); } SEAM(p0 + 14);
        asm volatile("; PHMARK 15" ::: "memory"); if (IN(p0 + 15)) { PHASE_FRAME(); phase_ga(P); } SEAM(p0 + 15);
        asm volatile("; PHMARK 16" ::: "memory"); if (IN(p0 + 16)) { PHASE_FRAME();
            pg8::Gemm g{1024, 1024, 1024}; pg8::SchedMoe S{(const char*)(ws + WS_XIN), (const char*)(we + WE_GU), (size_t)2048 * 1024 * 2, 8, (NSLOT / 256) * 8, P.G, P.vcu};
            pg8::EpiE1 E{(pg8::bf16_t*)(ws + WS_HID)};
            pg8::gemm_phase<pg8::EpiE1, pg8::SchedMoe, true, true>(P.lds, g, S, E, P.tid);
        } SEAM(p0 + 16);
        asm volatile("; PHMARK 17" ::: "memory"); if (IN(p0 + 17)) { PHASE_FRAME();
            pg8::Gemm g{1024, 1024, 1024}; pg8::SchedMoe S{(const char*)(ws + WS_HID), (const char*)(we + WE_D), (size_t)1024 * 1024 * 2, 4, (NSLOT / 256) * 4, P.G, P.vcu};
            pg8::EpiE2 E{(pg8::bf16_t*)(ws + WS_XIN), (const float*)(ws + WS_WGT), modv_of(P, li)};
            pg8::gemm_phase<pg8::EpiE2, pg8::SchedMoe, true, true>(P.lds, g, S, E, P.tid);
        } SEAM(p0 + 17);
        asm volatile("; PHMARK 18" ::: "memory"); if (IN(p0 + 18)) { PHASE_FRAME(); phase_cb(P, li); } SEAM(p0 + 18);
    }
#undef IN
#undef SEAM
}

extern "C" void kernel_launch(void* const* d_in, const int* in_sizes, int n_in, void* d_out, int out_size, void* d_ws, size_t ws_size, hipStream_t stream) {
    static int grid = 0;
    if (grid == 0) {
        if (n_in != N_IN || in_sizes[0] != NB * SEQ * DM || out_size != NB * SEQ * DM || ws_size < WS_END) {
            fprintf(stderr, "kernel_launch: unexpected problem: n_in %d in0 %d out %d ws %zu (need %zu)\n", n_in, n_in > 0 ? in_sizes[0] : -1, out_size, ws_size, (size_t)WS_END); grid = -1; return; }
        int dev = 0, cus = 0, per_cu = 0;
        if (hipGetDevice(&dev) != hipSuccess || hipDeviceGetAttribute(&cus, hipDeviceAttributeMultiprocessorCount, dev) != hipSuccess) { grid = -1; return; }
        if (hipFuncSetAttribute((const void*)fwd_kernel, hipFuncAttributeMaxDynamicSharedMemorySize, LDS_BYTES) != hipSuccess) { fprintf(stderr, "kernel_launch: hipFuncSetAttribute failed\n"); grid = -1; return; }
        if (hipOccupancyMaxActiveBlocksPerMultiprocessor(&per_cu, (const void*)fwd_kernel, 512, LDS_BYTES) != hipSuccess || per_cu < 1) { fprintf(stderr, "kernel_launch: occupancy query says %d\n", per_cu); }
        (void)hipGetLastError();
        grid = cus;
    }
    if (grid < 0) return;
    (void)hipMemsetAsync((char*)d_ws + WS_CTL, 0, CTL_ZERO_BYTES, stream);
    Args a{};
    for (int i = 0; i < N_IN; ++i) a.in[i] = (const float*)d_in[i];
    a.out = (float*)d_out; a.ws = (unsigned char*)d_ws; a.pad = 0;
#if MK_ONE_LAUNCH
    a.ph_lo = 0; a.ph_hi = NLAYER * NPH; a.bar_region = 0;
    hipLaunchKernelGGL(fwd_kernel, dim3(grid), dim3(512), LDS_BYTES, stream, a);
#else
    for (int p = 0; p < NLAYER * NPH; ++p) { a.ph_lo = p; a.ph_hi = p + 1; a.bar_region = 0; hipLaunchKernelGGL(fwd_kernel, dim3(grid), dim3(512), LDS_BYTES, stream, a); }
#endif
}
```

```cpp
#include <hip/hip_runtime.h>
#include <hip/hip_bf16.h>
#include <cstdio>
#include <cstdint>
#include <cmath>

#ifndef MK_ONE_LAUNCH
#define MK_ONE_LAUNCH 1
#endif
#ifndef MK_CHECK
#define MK_CHECK 0
#endif

constexpr int DM = 1024, NB = 8, SEQ = 8192, CTXL = 256, TPB = SEQ + CTXL, MROWS = NB * TPB;
constexpr int NLAYER = 2, INCOLS = 4368, NPROJ = 4352, GRIDW = 64;
constexpr int NEXP = 16, FF = 1024, CAP_L = 1024, CAP_C = 32;
constexpr int NCHUNK = TPB / 64;
constexpr float EPSN = 1e-6f;
constexpr float C2Q = 0.125f * 1.4426950408889634f;

enum { I_X = 0, I_C, I_CTX, I_CCTX, I_WMOD, I_BMOD, I_N1W, I_N2W, I_WIN, I_GQN, I_GKN, I_DQN, I_DKN, I_LQ1, I_LK1, I_LQ2, I_LK2, I_SUBLN,
       I_CONVW, I_ALOG, I_DTB, I_GNW, I_WMG, I_WBR, I_WOUT, I_WRT, I_WEG, I_WEU, I_WED, N_IN };

constexpr size_t MiB = 1u << 20;
constexpr size_t WS_CTL = 0, CTL_ZERO_BYTES = 1 * MiB;
constexpr size_t WS_MODV = 1 * MiB;
constexpr size_t WS_ROPE = 1 * MiB + 512 * 1024;
constexpr size_t WS_LAM = 1 * MiB + 768 * 1024;
constexpr size_t WS_GDNG = 2 * MiB;
constexpr size_t WS_GCB = 7 * MiB;
constexpr size_t WS_AFF = 12 * MiB;
constexpr size_t WS_IDX = 17 * MiB;
constexpr size_t WS_WGT = 18 * MiB;
constexpr size_t WS_INV = 19 * MiB;
constexpr size_t WS_XC = 24 * MiB;
constexpr size_t WS_WMIX = 32 * MiB;
constexpr size_t WM_WIN = 0, WM_WG = 9 * MiB, WM_WB = 15 * MiB, WM_WO = 18 * MiB;
constexpr size_t WS_WEXP = 56 * MiB;
constexpr size_t WE_GU = 0, WE_D = 64 * MiB;
constexpr size_t WS_H = 152 * MiB;
constexpr size_t WS_S = 284 * MiB;
constexpr size_t WS_YA = WS_S, WS_YB = WS_S + 66 * MiB, WS_YG = WS_S + 132 * MiB;
constexpr size_t WS_KA = WS_S + 198 * MiB, WS_VA = WS_KA + 17 * MiB;
constexpr size_t WS_QB = WS_S + 232 * MiB, WS_KB = WS_QB + 66 * MiB, WS_VB = WS_KB + 66 * MiB;
constexpr size_t WS_OB = WS_VB + 66 * MiB;
constexpr size_t WS_TQ = WS_S;
constexpr size_t WS_CPRE = WS_S + 198 * MiB;
constexpr size_t WS_Z = WS_CPRE + 198 * MiB;
constexpr size_t WS_POST = WS_Z + 66 * MiB;
constexpr size_t WS_G = WS_S + 198 * MiB;
constexpr size_t WS_MRG = WS_G + 396 * MiB;
constexpr size_t WS_XIN = WS_S, WS_HID = WS_S + 264 * MiB;
constexpr size_t WS_END = WS_S + 728 * MiB;
static_assert(WS_POST + 198 * MiB <= WS_END && WS_MRG + 132 * MiB <= WS_END && WS_HID + 264 * MiB <= WS_END && WS_OB + 132 * MiB <= WS_END, "ws map");
static_assert(WS_END <= 1024 * MiB, "ws map exceeds 1 GiB");
constexpr int NSLOT_L = NB * NEXP * CAP_L, NSLOT_C = NB * NEXP * CAP_C, NSLOT = NSLOT_L + NSLOT_C;

constexpr int RING_BYTES = 131072, LDSCTL_OFF = RING_BYTES, MISC_OFF = LDSCTL_OFF + 320, LDS_BYTES = 147456;
constexpr int LDS_XTRA = MISC_OFF + 128;

#define GAS __attribute__((address_space(1)))
#define LAS __attribute__((address_space(3)))
typedef unsigned short bf16;
typedef unsigned v4u __attribute__((ext_vector_type(4)));
typedef unsigned v2u __attribute__((ext_vector_type(2)));
typedef float f32x4 __attribute__((ext_vector_type(4)));
typedef float f32x2 __attribute__((ext_vector_type(2)));
typedef short bf16x8 __attribute__((ext_vector_type(8)));
typedef GAS unsigned gu32;
#define RLX_AGENT __ATOMIC_RELAXED, __HIP_MEMORY_SCOPE_AGENT
#define LDS_WAIT() asm volatile("s_waitcnt lgkmcnt(0)" ::: "memory")
#define VM_WAIT() asm volatile("s_waitcnt vmcnt(0)" ::: "memory")
#define DI __device__ __forceinline__

DI unsigned f2bf(float f) { unsigned u = __builtin_bit_cast(unsigned, f); return (u + 0x7fffu + ((u >> 16) & 1u)) >> 16; }
DI unsigned pk2(float lo, float hi) { typedef __bf16 b2 __attribute__((ext_vector_type(2))); f32x2 v = {lo, hi}; b2 b = __builtin_convertvector(v, b2); return __builtin_bit_cast(unsigned, b); }
DI float bf2f(unsigned short b) { return __builtin_bit_cast(float, (unsigned)b << 16); }
DI float bflo(unsigned w) { return __builtin_bit_cast(float, w << 16); }
DI float bfhi(unsigned w) { return __builtin_bit_cast(float, w & 0xffff0000u); }
DI float sigmoidf_(float x) { return __builtin_amdgcn_rcpf(1.f + __expf(-x)); }
DI float siluf_(float x) { return x * __builtin_amdgcn_rcpf(1.f + __expf(-x)); }
DI float wave_sum(float v) {
#pragma unroll
    for (int o = 1; o < 64; o <<= 1) v += __shfl_xor(v, o);
    return v;
}
DI float sum16(float v) { v += __shfl_xor(v, 1); v += __shfl_xor(v, 2); v += __shfl_xor(v, 4); v += __shfl_xor(v, 8); return v; }
DI float reduce16(const float (&v)[16], int lane) {
    float a[8], b[4], c[2], d;
    const bool b5 = lane & 32, b4 = lane & 16, b3 = lane & 8, b2 = lane & 4;
#pragma unroll
    for (int i = 0; i < 8; ++i) { const float keep = b5 ? v[i + 8] : v[i], send = b5 ? v[i] : v[i + 8]; a[i] = keep + __shfl_xor(send, 32); }
#pragma unroll
    for (int i = 0; i < 4; ++i) { const float keep = b4 ? a[i + 4] : a[i], send = b4 ? a[i] : a[i + 4]; b[i] = keep + __shfl_xor(send, 16); }
#pragma unroll
    for (int i = 0; i < 2; ++i) { const float keep = b3 ? b[i + 2] : b[i], send = b3 ? b[i] : b[i + 2]; c[i] = keep + __shfl_xor(send, 8); }
    { const float keep = b2 ? c[1] : c[0], send = b2 ? c[0] : c[1]; d = keep + __shfl_xor(send, 4); }
    d += __shfl_xor(d, 2); d += __shfl_xor(d, 1);
    return d;
}

DI float max_b2345(float m) { m = fmaxf(m, __shfl_xor(m, 4)); m = fmaxf(m, __shfl_xor(m, 8)); m = fmaxf(m, __shfl_xor(m, 16)); m = fmaxf(m, __shfl_xor(m, 32)); return m; }
DI float sum_b2345(float s) { s += __shfl_xor(s, 4); s += __shfl_xor(s, 8); s += __shfl_xor(s, 16); s += __shfl_xor(s, 32); return s; }

#define MFMA32(a, b, c) __builtin_amdgcn_mfma_f32_32x32x16_bf16((a), (b), (c), 0, 0, 0)
#define MFMA16(a, b, c) __builtin_amdgcn_mfma_f32_16x16x32_bf16((a), (b), (c), 0, 0, 0)
#define XB_TMO      128
#define XB_XCNT(j)  (256  + 64 * (j))
#define XB_XSUB(j)  (1280 + 64 * (j))
#define XB_XGEN(j)  (2304 + 64 * (j))
#define XB_TOP      3328
#define XB_TOPGEN   3392
#define XCD_BAR_WORDS 3456
#define XB_SPIN_CAP (1u << 22)
DI unsigned xb_ld(unsigned* p)              { return __hip_atomic_load(p, __ATOMIC_RELAXED, __HIP_MEMORY_SCOPE_AGENT); }
DI unsigned xb_add(unsigned* p, unsigned v) { return __hip_atomic_fetch_add(p, v, __ATOMIC_RELAXED, __HIP_MEMORY_SCOPE_AGENT); }
DI unsigned xb_xcc_id() { return (unsigned)__builtin_amdgcn_s_getreg((3 << 11) | 20) & 0xFu; }
#define XB_SPIN(cond, bar) do { unsigned _sp = 0; while (cond) { __builtin_amdgcn_s_sleep(1); \
    if ((++_sp & 255u) == 0u) { if (xb_ld(&(bar)[XB_TMO])) break; if (_sp > XB_SPIN_CAP) { atomicAdd(&(bar)[XB_TMO], 1u); break; } } } } while (0)
struct XcdBarrier { unsigned* bar; unsigned x; volatile LAS unsigned* st; };
DI XcdBarrier xcd_barrier_post(unsigned* bar, volatile LAS unsigned* st) {
    XcdBarrier b; b.bar = bar; b.x = xb_xcc_id(); b.st = st;
    if (threadIdx.x == 0) (void)xb_add(&bar[XB_XCNT(b.x)], 1u);
    return b;
}
DI void xcd_barrier_complete(unsigned* bar, unsigned x, unsigned& nloc, unsigned& nx) {
    const unsigned G = gridDim.x * gridDim.y * gridDim.z;
    unsigned sum, cnt, mine, sp = 0u;
    for (;;) {
        sum = 0u; cnt = 0u; mine = 0u;
#pragma unroll
        for (unsigned j = 0; j < 16; ++j) { const unsigned c = xb_ld(&bar[XB_XCNT(j)]); sum += c; cnt += (c > 0u) ? 1u : 0u; mine = (j == x) ? c : mine; }
        if (sum == G) break;
        __builtin_amdgcn_s_sleep(1);
        if ((++sp & 255u) == 0u) { if (xb_ld(&bar[XB_TMO])) break; if (sp > XB_SPIN_CAP) { atomicAdd(&bar[XB_TMO], 1u); break; } }
    }
    nloc = mine > 0u ? mine : 1u; nx = cnt > 0u ? cnt : 1u;
}
DI void xcd_barrier(const XcdBarrier& b) {
    asm volatile("s_waitcnt vmcnt(0)" ::: "memory");
    __syncthreads();
    if (threadIdx.x == 0) {
        unsigned* bar = b.bar;
        __builtin_amdgcn_s_waitcnt(0);
        unsigned nloc = b.st[0], nx = b.st[1];
        if (nloc == 0u) { xcd_barrier_complete(bar, b.x, nloc, nx); b.st[0] = nloc; b.st[1] = nx; }
        const unsigned old = xb_add(&bar[XB_XSUB(b.x)], 1u);
        const unsigned gen = old / nloc;
        if (old + 1u == (gen + 1u) * nloc) {
            __builtin_amdgcn_fence(__ATOMIC_RELEASE, "agent");
            asm volatile("s_waitcnt vmcnt(0)" ::: "memory");
            const unsigned og = xb_add(&bar[XB_TOP], 1u);
            const unsigned tg = og / nx;
            if (og + 1u == (tg + 1u) * nx) xb_add(&bar[XB_TOPGEN], 1u);
            else XB_SPIN(xb_ld(&bar[XB_TOPGEN]) == tg, bar);
            __builtin_amdgcn_fence(__ATOMIC_ACQUIRE, "agent");
            xb_add(&bar[XB_XGEN(b.x)], 1u);
            asm volatile("s_waitcnt vmcnt(0)" ::: "memory");
        } else {
            XB_SPIN(xb_ld(&bar[XB_XGEN(b.x)]) == gen, bar);
            __builtin_amdgcn_fence(__ATOMIC_ACQUIRE, "agent");
            asm volatile("s_waitcnt vmcnt(0)" ::: "memory");
        }
    }
    __syncthreads();
}
namespace pg8 {
#define PG8_LAS __attribute__((address_space(3)))
typedef unsigned short bf16_t;
typedef short bf16x8 __attribute__((ext_vector_type(8)));
typedef float f32x4 __attribute__((ext_vector_type(4)));
typedef unsigned u32x4 __attribute__((ext_vector_type(4)));
constexpr int BM = 256, BK = 64, HALF = 128, HTB = HALF * BK * 2  , STAGE_BYTES = 8 * HTB, NXCD = 8, WGM = 8;

__host__ __device__ __forceinline__ int lds_byte(int r, int c) { const int st = (r >> 4) * 2 + (c >> 5), rr = r & 15, cc = c & 31, ob = rr * 64 + cc * 2; return st * 1024 + (ob ^ (((ob >> 9) & 1) << 5)); }
__host__ __device__ __forceinline__ void stage_rc(int b, int& R, int& C) { const int st = b / 1024, sb = b % 1024, swz = sb ^ (((sb >> 9) & 1) << 5); R = (st >> 1) * 16 + swz / 64; C = (st & 1) * 32 + (swz % 64) / 2; }
__host__ __device__ __forceinline__ int perm32(int rho) { const int n = rho >> 4, i = rho & 15; return 8 * (i >> 2) + 4 * n + (i & 3); }

struct Unit { int pm, pn, z; };
struct Gemm { int lda, ldb, K; unsigned* scr; };

__device__ __forceinline__ unsigned cvt_pk_bf16(float lo, float hi) { typedef __bf16 b2_t __attribute__((ext_vector_type(2))); typedef float f2_t __attribute__((ext_vector_type(2))); f2_t v = {lo, hi}; b2_t b = __builtin_convertvector(v, b2_t); return __builtin_bit_cast(unsigned, b); }
typedef float f32x2 __attribute__((ext_vector_type(2)));
template <class Epi, class Sched, bool ALIGN_EPI = false, bool SP2 = false>
__device__ __forceinline__ void gemm_phase(PG8_LAS unsigned char* lds, const Gemm g, const Sched& S, const Epi& E, const int tid  ) {
    const int wid = __builtin_amdgcn_readfirstlane(tid >> 6), lane = tid & 63, wr = wid >> 2, wc = wid & 3, fr = lane & 15, fq = lane >> 4;
    const int K = g.K, nt = K / BK;
    unsigned voffA, voffB;
    { int R, C; stage_rc(tid * 16, R, C); const int Rb = Epi::PERM ? ((R & ~31) + perm32(R & 31)) : R; voffA = (unsigned)(R * g.lda + C) * 2u; voffB = (unsigned)(Rb * g.ldb + C) * 2u; }
    const size_t pstepA = (size_t)64 * g.lda * 2, pstepB = (size_t)64 * g.ldb * 2;
    constexpr bool GATHER = Sched::GATHER;
    unsigned gA[2][2][2];
#define PG8_GOFF(u_, w_) do { if constexpr (GATHER) { _Pragma("unroll") for (int _h = 0; _h < 2; ++_h) _Pragma("unroll") for (int _i = 0; _i < 2; ++_i) { int R_, C_; stage_rc(tid * 16 + _i * 8192, R_, C_); \
        gA[w_][_h][_i] = (unsigned)S.row_of((u_).pm * BM + _h * HALF + R_) * (unsigned)(g.lda * 2) + (unsigned)(C_ * 2); } } } while (0)
    const size_t kstep = (size_t)(BK * 2);
    const size_t hstepA = (size_t)HALF * g.lda * 2, hstepB = (size_t)HALF * g.ldb * 2;
    const unsigned ldsw = (unsigned)wid * 1024u;
    const int aoff = lds_byte(wr * 64 + fr, fq * 8), boff = lds_byte(wc * 32 + fr, fq * 8);
#define PG8_SA(b, h) (((b) * 2 + (h)) * HTB)
#define PG8_SB(b, h) ((4 + (b) * 2 + (h)) * HTB)
#define PG8_STAGE2(bufoff, gbase, voff) do { _Pragma("unroll") for (int _i = 0; _i < 2; ++_i) \
        __builtin_amdgcn_global_load_lds((const unsigned*)((const char*)(gbase) + (voff)[_i]), (PG8_LAS unsigned*)(lds + (bufoff) + ldsw + _i * 8192), 16, 0, 0); } while (0)
#define PG8_STAGE1(bufoff, gbase, voff, pstep) do { _Pragma("unroll") for (int _i = 0; _i < 2; ++_i) \
        __builtin_amdgcn_global_load_lds((const unsigned*)((const char*)(gbase) + _i * (pstep) + (voff)), (PG8_LAS unsigned*)(lds + (bufoff) + ldsw + _i * 8192), 16, 0, 0); } while (0)
#define PG8_STAGE(bufoff, gbase, voffB_) PG8_STAGE1(bufoff, gbase, voffB, pstepB)
#define PG8_STAGE_A(bufoff, ptr, h, un) do { if constexpr (GATHER) { const bool _n = (un); unsigned _v[2] = {_n ? gA[1][h][0] : gA[0][h][0], _n ? gA[1][h][1] : gA[0][h][1]}; PG8_STAGE2(bufoff, ptr, _v); } \
        else { PG8_STAGE1(bufoff, (ptr) + (h) * hstepA, voffA, pstepA); } } while (0)
#define PG8_LDA(dst, b, h) do { _Pragma("unroll") for (int m = 0; m < 4; ++m) _Pragma("unroll") for (int k = 0; k < 2; ++k) dst[m][k] = *(const PG8_LAS bf16x8*)(lds + PG8_SA(b, h) + aoff + m * 2048 + k * 1024); } while (0)
#define PG8_LDB(dst, b, h) do { _Pragma("unroll") for (int n = 0; n < 2; ++n) _Pragma("unroll") for (int k = 0; k < 2; ++k) dst[n][k] = *(const PG8_LAS bf16x8*)(lds + PG8_SB(b, h) + boff + n * 2048 + k * 1024); } while (0)
#define PG8_MMA(ai, bj, At, Bt) do { __builtin_amdgcn_s_setprio(1); _Pragma("unroll") for (int m = 0; m < 4; ++m) _Pragma("unroll") for (int n = 0; n < 2; ++n) _Pragma("unroll") for (int k = 0; k < 2; ++k) \
        acc[ai][bj][m][n] = __builtin_amdgcn_mfma_f32_16x16x32_bf16(Bt[n][k], At[m][k], acc[ai][bj][m][n], 0, 0, 0); __builtin_amdgcn_s_setprio(0); } while (0)
#define PG8_WAIT_V(n) asm volatile("s_waitcnt vmcnt(" #n ")" ::: "memory")
#define PG8_WAIT_L(n) asm volatile("s_waitcnt lgkmcnt(" #n ")" ::: "memory")
#define PG8_BAR __builtin_amdgcn_s_barrier()
#define PG8_SCHED __builtin_amdgcn_sched_barrier(0)
    Unit cur, nxt; int ui = 0;
    if (!S.next(0, cur)) return;
    f32x4 acc[2][2][4][2];
#pragma unroll
    for (int a = 0; a < 2; ++a)
#pragma unroll
        for (int b = 0; b < 2; ++b)
#pragma unroll
            for (int m = 0; m < 4; ++m)
#pragma unroll
                for (int n = 0; n < 2; ++n) acc[a][b][m][n] = (f32x4){0.f, 0.f, 0.f, 0.f};
    bf16x8 At[4][2], B0[2][2], B1[2][2];
    const char* cA = S.a_ptr(cur); const char* cB = S.b_ptr(cur);
    S.a_ready(cur); PG8_GOFF(cur, 0);
    if constexpr (SP2) {
        PG8_STAGE(PG8_SB(0, 0), cB, voffB); PG8_STAGE(PG8_SB(0, 1), cB + hstepB, voffB); PG8_STAGE_A(PG8_SA(0, 0), cA, 0, false); PG8_STAGE_A(PG8_SA(0, 1), cA, 1, false);
        if (wr == 1) PG8_BAR;
        PG8_WAIT_V(2); PG8_BAR;
        PG8_STAGE(PG8_SB(1, 0), cB + kstep, voffB); PG8_STAGE_A(PG8_SA(1, 0), cA + kstep, 0, false); PG8_STAGE(PG8_SB(1, 1), cB + hstepB + kstep, voffB);
        PG8_WAIT_V(6); PG8_BAR;
    } else {
        PG8_STAGE(PG8_SB(0, 0), cB, voffB); PG8_STAGE1(PG8_SA(0, 0), cA, voffA, pstepA); PG8_STAGE(PG8_SB(0, 1), cB + hstepB, voffB); PG8_STAGE1(PG8_SA(0, 1), cA + hstepA, voffA, pstepA);
        if (wr == 1) PG8_BAR;
        PG8_WAIT_V(4); PG8_BAR;
        PG8_STAGE(PG8_SB(1, 0), cB + kstep, voffB); PG8_STAGE1(PG8_SA(1, 0), cA + kstep, voffA, pstepA); PG8_STAGE(PG8_SB(1, 1), cB + hstepB + kstep, voffB);
        PG8_WAIT_V(6); PG8_BAR;
    }
    for (;;) {
        const bool has_next = S.next(ui + 1, nxt); if (has_next) PG8_GOFF(nxt, 1);
        const char* nA = has_next ? S.a_ptr(nxt) : cA; const char* nB = has_next ? S.b_ptr(nxt) : cB;
        for (int t = 0; t < nt; t += 2) {
            const bool last = (t == nt - 2);
            const char* a1 = cA + (size_t)(t + 1) * kstep;
            const char* a2 = last ? nA : cA + (size_t)(t + 2) * kstep; const char* b2 = last ? nB : cB + (size_t)(t + 2) * kstep;
            const char* a3 = a2 + kstep; const char* b3 = b2 + kstep;
            if (last && has_next) S.a_ready(nxt);
            if constexpr (SP2) {
            PG8_LDB(B0, 0, 0); PG8_LDB(B1, 0, 1); PG8_SCHED; PG8_LDA(At, 0, 0); PG8_STAGE_A(PG8_SA(1, 1), a1, 1, false);
            PG8_WAIT_V(8); PG8_WAIT_L(0); PG8_BAR; PG8_MMA(0, 0, At, B0); PG8_MMA(0, 1, At, B1); PG8_BAR; PG8_SCHED;
            PG8_LDA(At, 0, 1); PG8_STAGE(PG8_SB(0, 0), b2, voffB); PG8_STAGE(PG8_SB(0, 1), b2 + hstepB, voffB); PG8_STAGE_A(PG8_SA(0, 0), a2, 0, last && has_next);
            PG8_WAIT_V(8); PG8_WAIT_L(0); PG8_BAR; PG8_MMA(1, 0, At, B0); PG8_MMA(1, 1, At, B1); PG8_BAR; PG8_SCHED;
            PG8_LDB(B0, 1, 0); PG8_LDB(B1, 1, 1); PG8_SCHED; PG8_LDA(At, 1, 0); PG8_STAGE_A(PG8_SA(0, 1), a2, 1, last && has_next);
            PG8_WAIT_V(8); PG8_WAIT_L(0); PG8_BAR; PG8_MMA(0, 0, At, B0); PG8_MMA(0, 1, At, B1); PG8_BAR; PG8_SCHED;
            PG8_LDA(At, 1, 1); PG8_STAGE(PG8_SB(1, 0), b3, voffB); PG8_STAGE(PG8_SB(1, 1), b3 + hstepB, voffB); PG8_STAGE_A(PG8_SA(1, 0), a3, 0, last && has_next);
            PG8_WAIT_V(8); PG8_WAIT_L(0); PG8_BAR; PG8_MMA(1, 0, At, B0); PG8_MMA(1, 1, At, B1); PG8_BAR; PG8_SCHED;
            } else {
            PG8_LDB(B0, 0, 0); PG8_SCHED; PG8_LDA(At, 0, 0); PG8_STAGE1(PG8_SA(1, 1), a1 + hstepA, voffA, pstepA);
            PG8_WAIT_L(8); PG8_BAR; PG8_WAIT_L(0); PG8_MMA(0, 0, At, B0); PG8_BAR; PG8_SCHED;
            PG8_LDB(B1, 0, 1); PG8_STAGE(PG8_SB(0, 0), b2, voffB);
            PG8_BAR; PG8_WAIT_L(0); PG8_MMA(0, 1, At, B1); PG8_BAR;
            PG8_LDA(At, 0, 1); PG8_STAGE1(PG8_SA(0, 0), a2, voffA, pstepA);
            PG8_BAR; PG8_WAIT_L(0); PG8_MMA(1, 0, At, B0); PG8_BAR; PG8_SCHED;
            PG8_STAGE(PG8_SB(0, 1), b2 + hstepB, voffB);
            PG8_WAIT_V(6); PG8_BAR; PG8_MMA(1, 1, At, B1); PG8_BAR;
            PG8_LDB(B0, 1, 0); PG8_SCHED; PG8_LDA(At, 1, 0); PG8_STAGE1(PG8_SA(0, 1), a2 + hstepA, voffA, pstepA);
            PG8_WAIT_L(8); PG8_BAR; PG8_WAIT_L(0); PG8_MMA(0, 0, At, B0); PG8_BAR; PG8_SCHED;
            PG8_LDB(B1, 1, 1); PG8_STAGE(PG8_SB(1, 0), b3, voffB);
            PG8_BAR; PG8_WAIT_L(0); PG8_MMA(0, 1, At, B1); PG8_BAR;
            PG8_LDA(At, 1, 1); PG8_STAGE1(PG8_SA(1, 0), a3, voffA, pstepA);
            PG8_BAR; PG8_WAIT_L(0); PG8_MMA(1, 0, At, B0); PG8_BAR; PG8_SCHED;
            PG8_STAGE(PG8_SB(1, 1), b3 + hstepB, voffB);
            PG8_WAIT_V(6); PG8_BAR; PG8_MMA(1, 1, At, B1); PG8_BAR;
            }
        }
        if constexpr (ALIGN_EPI) { if (wr == 0) PG8_BAR; }
        bool keep = false;
        if constexpr (!Epi::AFTER_DRAIN) { if constexpr (Epi::INPLACE) keep = E.inplace(acc, cur, wr, wc, fr, fq); else E(acc, cur, wr, wc, fr, fq); S.done(cur); }
        if (!has_next) break;
        if (!keep)
#pragma unroll
        for (int a = 0; a < 2; ++a)
#pragma unroll
            for (int b = 0; b < 2; ++b)
#pragma unroll
                for (int m = 0; m < 4; ++m)
#pragma unroll
                    for (int n = 0; n < 2; ++n) acc[a][b][m][n] = (f32x4){0.f, 0.f, 0.f, 0.f};
        cur = nxt; cA = nA; cB = nB; ++ui;
        if constexpr (GATHER) { _Pragma("unroll") for (int _h = 0; _h < 2; ++_h) _Pragma("unroll") for (int _i = 0; _i < 2; ++_i) gA[0][_h][_i] = gA[1][_h][_i]; }
        if constexpr (ALIGN_EPI) { if (wr == 1) PG8_BAR; }
    }
    PG8_WAIT_V(0);
    if constexpr (!ALIGN_EPI) { if (wr == 0) PG8_BAR; }
    PG8_BAR;
    if constexpr (Epi::AFTER_DRAIN) { E.fused(acc, cur, wr, wc, fr, fq, lds, wid, lane); S.done(cur); }
#undef PG8_SA
#undef PG8_SB
#undef PG8_STAGE
#undef PG8_STAGE_A
#undef PG8_GOFF
#undef PG8_LDA
#undef PG8_LDB
#undef PG8_MMA
#undef PG8_WAIT_V
#undef PG8_WAIT_L
#undef PG8_BAR
#undef PG8_SCHED
}
}
namespace pg8 {
struct SchedMN {
    static constexpr bool GATHER = false; DI int row_of(int r) const { return r; }
    const char* A; const char* B; size_t a_tile, b_tile, a_z, b_z;
    int nM, nN, nwg, G, c, NZ, pn0, skipctx;
    DI void init(const void* A_, size_t lda, const void* B_, size_t ldb, int nM_, int nN_, int pn0_, int G_, int c_) {
        A = (const char*)A_; B = (const char*)B_; a_tile = 256 * lda * 2; b_tile = 256 * ldb * 2; a_z = 0; b_z = 0; nM = nM_; nN = nN_; nwg = nM * nN; G = G_; c = c_; NZ = 1; pn0 = pn0_; skipctx = 0; }
    DI bool next(int i, Unit& u) const {
        const int ti = i / NZ; u.z = i - ti * NZ;
        const long L = (long)ti * G + c; if (L >= nwg) return false;
        int wgid = (int)L; { const int q = nwg / NXCD, r = nwg % NXCD, xcd = wgid % NXCD, off = wgid / NXCD; wgid = (xcd < r ? xcd * (q + 1) : r * (q + 1) + (xcd - r) * q) + off; }
        const int nig = WGM * nN, gid = wgid / nig, fm = gid * WGM, gsz = (nM - fm) < WGM ? (nM - fm) : WGM;
        u.pm = fm + ((wgid % nig) % gsz); u.pn = pn0 + (wgid % nig) / gsz; if (skipctx) u.pm += u.pm >> 5; return true;
    }
    DI const char* a_ptr(const Unit& u) const { return A + (size_t)u.pm * a_tile + (size_t)u.z * a_z; }
    DI const char* b_ptr(const Unit& u) const { return B + (size_t)u.pn * b_tile + (size_t)u.z * b_z; }
    DI void a_ready(const Unit&) const {}
    DI void done(const Unit&) const {}
};
struct SchedMoe {
    static constexpr bool GATHER = false; DI int row_of(int r) const { return r; }
    const char* A; const char* B; size_t b_exp; int nN, ntot, G, c;
    DI bool next(int i, Unit& u) const { const long L = (long)i * G + c; if (L >= ntot) return false; u.pm = (int)(L / nN); u.pn = (int)(L % nN); u.z = u.pm < 512 ? (u.pm >> 5) : (u.pm - 512); return true; }
    DI const char* a_ptr(const Unit& u) const { return A + (size_t)u.pm * (256 * 1024 * 2); }
    DI const char* b_ptr(const Unit& u) const { return B + (size_t)u.z * b_exp + (size_t)u.pn * (256 * 1024 * 2); }
    DI void a_ready(const Unit&) const {}
    DI void done(const Unit&) const {}
};

struct SchedMoeG {
    static constexpr bool GATHER = true;
    const char* A; const char* B; size_t b_exp; int nN, ntot, G, c; const int* idx;
    DI int row_of(int r) const { return idx[r]; }
    DI bool next(int i, Unit& u) const { const long L = (long)i * G + c; if (L >= ntot) return false; u.pm = (int)(L / nN); u.pn = (int)(L % nN); u.z = u.pm < 512 ? (u.pm >> 5) : (u.pm - 512); return true; }
    DI const char* a_ptr(const Unit&) const { return A; }
    DI const char* b_ptr(const Unit& u) const { return B + (size_t)u.z * b_exp + (size_t)u.pn * (256 * 1024 * 2); }
    DI void a_ready(const Unit&) const {}
    DI void done(const Unit&) const {}
};

struct EpiInProj {
    static constexpr bool PERM = false, AFTER_DRAIN = false, INPLACE = false;
    unsigned char* ws; const float *gqn, *gkn, *dqn, *dkn; const float* rope;
    DI void operator()(const f32x4 (&acc)[2][2][4][2], const Unit& u, int wr, int wc, int fr, int fq) const {
        const int pn = u.pn;
        bf16_t* dst; int pitch, col0; const float* nw = nullptr; float scale = 1.f;
        if (pn < 2)       { dst = (bf16_t*)(ws + WS_YA); pitch = 512; col0 = (pn * 4 + wc) * 64; nw = gqn; scale = C2Q; }
        else if (pn == 2) { if (wc < 2) { dst = (bf16_t*)(ws + WS_KA); pitch = 128; col0 = wc * 64; nw = gkn; } else { dst = (bf16_t*)(ws + WS_VA); pitch = 128; col0 = (wc - 2) * 64; } }
        else if (pn < 5)  { dst = (bf16_t*)(ws + WS_QB); pitch = 512; col0 = ((pn - 3) * 4 + wc) * 64; nw = dqn; scale = C2Q; }
        else if (pn < 7)  { dst = (bf16_t*)(ws + WS_KB); pitch = 512; col0 = ((pn - 5) * 4 + wc) * 64; nw = dkn; }
        else if (pn < 9)  { dst = (bf16_t*)(ws + WS_VB); pitch = 512; col0 = (pn - 7) * 256 + wc * 64; }
        else if (pn < 15) { dst = (bf16_t*)(ws + WS_CPRE); pitch = 1536; col0 = (pn - 9) * 256 + wc * 64; }
        else              { dst = (bf16_t*)(ws + WS_Z); pitch = 512; col0 = (pn - 15) * 256 + wc * 64; }
        f32x4 w4[2][2];
        if (nw) {
#pragma unroll
            for (int bj = 0; bj < 2; ++bj)
#pragma unroll
                for (int n = 0; n < 2; ++n) w4[bj][n] = *(const f32x4*)(nw + 32 * bj + 16 * n + 4 * fq);
        }
#pragma unroll
        for (int aim = 0; aim < 4; ++aim) { const int ai = aim >> 1, mb = (aim & 1) * 2;
            f32x4 rt[4][2][2];
            if (nw) {
#pragma unroll
                for (int m = mb; m < mb + 2; ++m) { const int row = u.pm * BM + ai * HALF + wr * 64 + m * 16 + fr, t = row % TPB, tc = t < SEQ ? t : 0;
#pragma unroll
                    for (int bj = 0; bj < 2; ++bj) { const int pos = bj == 0 ? (tc >> 6) : (tc & 63);
                        rt[m][bj][0] = *(const f32x4*)(rope + (pos * 16 + 4 * fq) * 2); rt[m][bj][1] = *(const f32x4*)(rope + (pos * 16 + 4 * fq) * 2 + 4); } }
            }
#pragma unroll
            for (int m = mb; m < mb + 2; ++m) {
                const int row = u.pm * BM + ai * HALF + wr * 64 + m * 16 + fr;
                f32x4 v[2][2];
#pragma unroll
                for (int bj = 0; bj < 2; ++bj)
#pragma unroll
                    for (int n = 0; n < 2; ++n) v[bj][n] = acc[ai][bj][m][n];
                if (nw) {
                    float ss = 0.f;
#pragma unroll
                    for (int bj = 0; bj < 2; ++bj)
#pragma unroll
                        for (int n = 0; n < 2; ++n) ss += (v[bj][n][0] * v[bj][n][0] + v[bj][n][1] * v[bj][n][1]) + (v[bj][n][2] * v[bj][n][2] + v[bj][n][3] * v[bj][n][3]);
                    ss += __shfl_xor(ss, 16); ss += __shfl_xor(ss, 32);
                    const float rstd = rsqrtf(ss * (1.f / 64.f) + EPSN);
#pragma unroll
                    for (int bj = 0; bj < 2; ++bj)
#pragma unroll
                        for (int n = 0; n < 2; ++n) v[bj][n] = v[bj][n] * rstd * w4[bj][n];
                    const int t = row % TPB;
                    if (t < SEQ) {
#pragma unroll
                        for (int bj = 0; bj < 2; ++bj) {
                            const f32x4 cs0 = rt[m][bj][0], cs1 = rt[m][bj][1];
                            const float c[4] = {cs0[0], cs0[2], cs1[0], cs1[2]}, s[4] = {cs0[1], cs0[3], cs1[1], cs1[3]};
#pragma unroll
                            for (int e = 0; e < 4; ++e) { const float x1 = v[bj][0][e], x2 = v[bj][1][e]; v[bj][0][e] = x1 * c[e] - x2 * s[e]; v[bj][1][e] = x2 * c[e] + x1 * s[e]; }
                        }
                    }
                }
                bf16_t* rp = dst + (size_t)row * pitch + col0 + 4 * fq;
#pragma unroll
                for (int bj = 0; bj < 2; ++bj)
#pragma unroll
                    for (int n = 0; n < 2; ++n) { const f32x4 o = v[bj][n] * scale; v2u w; w.x = cvt_pk_bf16(o[0], o[1]); w.y = cvt_pk_bf16(o[2], o[3]); *(v2u*)(rp + 32 * bj + 16 * n) = w; }
            }
        }
    }
};

template <int MODE> struct EpiBf {
    static constexpr bool PERM = true, AFTER_DRAIN = false, INPLACE = false;
    bf16_t* O; int ldc; const bf16_t* Gt;
    DI void operator()(const f32x4 (&acc)[2][2][4][2], const Unit& u, int wr, int wc, int fr, int fq) const {
        const int row0 = u.pm * BM + wr * 64 + fr, col0 = u.pn * BM + wc * 32 + 8 * fq;
#pragma unroll
        for (int ai = 0; ai < 2; ++ai) {
            u32x4 gv[4][2], pv[4][2];
            if (MODE == 1) {
#pragma unroll
                for (int m = 0; m < 4; ++m)
#pragma unroll
                    for (int bj = 0; bj < 2; ++bj) { const size_t row = (size_t)(row0 + ai * HALF + m * 16);
                        gv[m][bj] = *(const u32x4*)(Gt + row * 3072 + u.z * 1024 + col0 + bj * HALF);
                        pv[m][bj] = (u32x4){0u, 0u, 0u, 0u}; if (u.z > 0) pv[m][bj] = *(const u32x4*)(O + row * ldc + col0 + bj * HALF); }
            }
#pragma unroll
            for (int m = 0; m < 4; ++m) { const size_t row = (size_t)(row0 + ai * HALF + m * 16);
#pragma unroll
                for (int bj = 0; bj < 2; ++bj) { f32x4 v0 = acc[ai][bj][m][0], v1 = acc[ai][bj][m][1]; bf16_t* op = O + row * ldc + col0 + bj * HALF;
                    if (MODE == 0) {
                        unsigned lo = 0u, hi = 0u;
#pragma unroll
                        for (int e = 0; e < 4; ++e) { lo = __builtin_amdgcn_cvt_pk_u8_f32(sigmoidf_(v0[e]) * 255.f, e, lo); hi = __builtin_amdgcn_cvt_pk_u8_f32(sigmoidf_(v1[e]) * 255.f, e, hi); }
                        v2u w8; w8.x = lo; w8.y = hi; *(v2u*)((unsigned char*)O + row * 3072 + col0 + bj * HALF) = w8;
                        continue;
                    } else if (MODE == 1) {
                        const u32x4 g = gv[m][bj], p = pv[m][bj];
                        v0[0] = v0[0] * bflo(g.x) + bflo(p.x); v0[1] = v0[1] * bfhi(g.x) + bfhi(p.x); v0[2] = v0[2] * bflo(g.y) + bflo(p.y); v0[3] = v0[3] * bfhi(g.y) + bfhi(p.y);
                        v1[0] = v1[0] * bflo(g.z) + bflo(p.z); v1[1] = v1[1] * bfhi(g.z) + bfhi(p.z); v1[2] = v1[2] * bflo(g.w) + bflo(p.w); v1[3] = v1[3] * bfhi(g.w) + bfhi(p.w);
                    }
                    u32x4 w; w.x = cvt_pk_bf16(v0[0], v0[1]); w.y = cvt_pk_bf16(v0[2], v0[3]); w.z = cvt_pk_bf16(v1[0], v1[1]); w.w = cvt_pk_bf16(v1[2], v1[3]);
                    *(u32x4*)op = w; } }
        }
    }
};

struct EpiMergeH {
    static constexpr bool PERM = true, AFTER_DRAIN = false, INPLACE = true;
    bf16_t* O; int ldc; const bf16_t* Gt;
    DI bool inplace(f32x4 (&acc)[2][2][4][2], const Unit& u, int wr, int wc, int fr, int fq) const {
        const int row0 = u.pm * BM + wr * 64 + fr, col0 = u.pn * BM + wc * 32 + 8 * fq, z = u.z;
        const unsigned char* G8 = (const unsigned char*)Gt;
#define MH_G(w_, k_) fmaxf((float)(((w_) >> (8 * (k_))) & 0xffu) * (1.f / 255.f), 1e-4f)
        if (z < 2) {
#pragma unroll
            for (int ai = 0; ai < 2; ++ai) {
                v2u ga[4][2], gb[4][2];
#pragma unroll
                for (int m = 0; m < 4; ++m)
#pragma unroll
                    for (int bj = 0; bj < 2; ++bj) { const unsigned char* gp = G8 + (size_t)(row0 + ai * HALF + m * 16) * 3072 + z * 1024 + col0 + bj * HALF; ga[m][bj] = *(const v2u*)gp; gb[m][bj] = *(const v2u*)(gp + 1024); }
#pragma unroll
                for (int m = 0; m < 4; ++m)
#pragma unroll
                    for (int bj = 0; bj < 2; ++bj) { const v2u a = ga[m][bj], b = gb[m][bj];
#pragma unroll
                        for (int k = 0; k < 4; ++k) { acc[ai][bj][m][0][k] *= MH_G(a.x, k) * __builtin_amdgcn_rcpf(MH_G(b.x, k)); acc[ai][bj][m][1][k] *= MH_G(a.y, k) * __builtin_amdgcn_rcpf(MH_G(b.y, k)); } }
            }
            return true;
        }
#pragma unroll
        for (int ai = 0; ai < 2; ++ai) {
            v2u ga[4][2];
#pragma unroll
            for (int m = 0; m < 4; ++m)
#pragma unroll
                for (int bj = 0; bj < 2; ++bj) ga[m][bj] = *(const v2u*)(G8 + (size_t)(row0 + ai * HALF + m * 16) * 3072 + 2 * 1024 + col0 + bj * HALF);
#pragma unroll
            for (int m = 0; m < 4; ++m)
#pragma unroll
                for (int bj = 0; bj < 2; ++bj) { const v2u a = ga[m][bj]; const f32x4 v0 = acc[ai][bj][m][0], v1 = acc[ai][bj][m][1];
                    u32x4 w; w.x = cvt_pk_bf16(v0[0] * MH_G(a.x, 0), v0[1] * MH_G(a.x, 1)); w.y = cvt_pk_bf16(v0[2] * MH_G(a.x, 2), v0[3] * MH_G(a.x, 3));
                    w.z = cvt_pk_bf16(v1[0] * MH_G(a.y, 0), v1[1] * MH_G(a.y, 1)); w.w = cvt_pk_bf16(v1[2] * MH_G(a.y, 2), v1[3] * MH_G(a.y, 3));
                    *(u32x4*)(O + (size_t)(row0 + ai * HALF + m * 16) * ldc + col0 + bj * HALF) = w; }
        }
        return false;
#undef MH_G
    }
};

struct EpiE1 {
    static constexpr bool PERM = true, AFTER_DRAIN = false, INPLACE = false;
    bf16_t* H;
    DI void operator()(const f32x4 (&acc)[2][2][4][2], const Unit& u, int wr, int wc, int fr, int fq) const {
        const int row0 = u.pm * BM + wr * 64 + fr, col0 = u.pn * HALF + wc * 32 + 8 * fq;
#pragma unroll
        for (int ai = 0; ai < 2; ++ai)
#pragma unroll
            for (int m = 0; m < 4; ++m) { const size_t row = (size_t)(row0 + ai * HALF + m * 16);
                f32x4 g0 = acc[ai][0][m][0], g1 = acc[ai][0][m][1]; const f32x4 u0 = acc[ai][1][m][0], u1 = acc[ai][1][m][1];
#pragma unroll
                for (int e = 0; e < 4; ++e) { g0[e] = siluf_(g0[e]) * u0[e]; g1[e] = siluf_(g1[e]) * u1[e]; }
                u32x4 w; w.x = cvt_pk_bf16(g0[0], g0[1]); w.y = cvt_pk_bf16(g0[2], g0[3]); w.z = cvt_pk_bf16(g1[0], g1[1]); w.w = cvt_pk_bf16(g1[2], g1[3]);
                *(u32x4*)(H + row * FF + col0) = w; }
    }
};
struct EpiE2 {
    static constexpr bool PERM = true, AFTER_DRAIN = false, INPLACE = false;
    bf16_t* Y; const float* wgt; const float* modv;
    DI void operator()(const f32x4 (&acc)[2][2][4][2], const Unit& u, int wr, int wc, int fr, int fq) const {
        const int row0 = u.pm * BM + wr * 64 + fr, col0 = u.pn * BM + wc * 32 + 8 * fq;
        const int mi = u.pm < NSLOT_L / 256 ? ((u.pm >> 2) & 7) : 8; const float* g2 = modv + mi * 6144 + 5120 + col0;
        f32x4 ga[2], gb[2]; float tw[2][4];
#pragma unroll
        for (int bj = 0; bj < 2; ++bj) { ga[bj] = *(const f32x4*)(g2 + bj * HALF); gb[bj] = *(const f32x4*)(g2 + bj * HALF + 4); }
#pragma unroll
        for (int ai = 0; ai < 2; ++ai)
#pragma unroll
            for (int m = 0; m < 4; ++m) tw[ai][m] = wgt[row0 + ai * HALF + m * 16];
#pragma unroll
        for (int ai = 0; ai < 2; ++ai)
#pragma unroll
            for (int m = 0; m < 4; ++m) { const int row = row0 + ai * HALF + m * 16;
#pragma unroll
                for (int bj = 0; bj < 2; ++bj) { const int c = col0 + bj * HALF;
                    const f32x4 v0 = acc[ai][bj][m][0] * ga[bj] * tw[ai][m], v1 = acc[ai][bj][m][1] * gb[bj] * tw[ai][m];
                    u32x4 w; w.x = cvt_pk_bf16(v0[0], v0[1]); w.y = cvt_pk_bf16(v0[2], v0[3]); w.z = cvt_pk_bf16(v1[0], v1[1]); w.w = cvt_pk_bf16(v1[2], v1[3]);
                    *(u32x4*)(Y + (size_t)row * DM + c) = w; } }
    }
};
}
namespace attn_body {
using bf16=__hip_bfloat16;
using bf16x8=__attribute__((ext_vector_type(8)))short;
using s16x4=__attribute__((ext_vector_type(4)))short;
using f32x16=__attribute__((ext_vector_type(16)))float;
using u32x4=__attribute__((ext_vector_type(4)))unsigned;
constexpr int D=64;
constexpr int NW=8,QBLK=32,QB=QBLK*NW,KVBLK=64;
constexpr int ATTN_UNIT_ROWS=QB;
__device__ __forceinline__ int crow(int r,int hi){return (r&3)+8*(r>>2)+4*hi;}
#define SBAR() __builtin_amdgcn_sched_barrier(0)
constexpr int NSLOT=3, SLOTB=8192;
constexpr int LDS_K=0, LDS_V=NSLOT*SLOTB, LDS_WS=2*NSLOT*SLOTB, LDS_OST=LDS_WS+NW*64*4, LDS_BYTES=LDS_OST+NW*4096;
__device__ __forceinline__ void glds16(const void*gsrc,unsigned lds_dst){unsigned keep;
  asm volatile("s_mov_b32 %0, m0\n\ts_mov_b32 m0, %2\n\ts_nop 0\n\tglobal_load_lds_dwordx4 %1, off\n\ts_mov_b32 m0, %0":"=&s"(keep):"v"(gsrc),"s"(lds_dst):"memory");}
__device__ __forceinline__ float max3f(float a,float b,float c){float r;asm("v_max3_f32 %0, %1, %2, %3":"=v"(r):"v"(a),"v"(b),"v"(c));return r;}
__device__ __forceinline__ float max2f(float a,float b){float r;asm("v_max_f32_e32 %0, %1, %2":"=v"(r):"v"(a),"v"(b));return r;}
__device__ __forceinline__ float fadd_s(float a,float b){float r;asm("v_add_f32_e32 %0, %1, %2":"=v"(r):"v"(a),"v"(b));return r;}
__device__ __forceinline__ float fsub_s(float a,float b){float r;asm("v_sub_f32_e32 %0, %1, %2":"=v"(r):"v"(a),"v"(b));return r;}
typedef float f32x2_t __attribute__((ext_vector_type(2))); typedef __bf16 bf16x2_t __attribute__((ext_vector_type(2)));
__device__ __forceinline__ unsigned cvtpk_s(float lo,float hi){f32x2_t v={lo,hi};bf16x2_t b=__builtin_convertvector(v,bf16x2_t);return __builtin_bit_cast(unsigned,b);}
#define WAIT_BAR(N) asm volatile("s_waitcnt vmcnt(" #N ") lgkmcnt(0)\n\ts_barrier":::"memory")

__device__ __forceinline__ void qkt(f32x16&p0,f32x16&p1,const char*Kslot,const bf16x8*qr,const f32x16&negm,int r32,int hi){
  const char*kb=Kslot+hi*1024+r32*16;
  #pragma unroll
  for(int d0=0;d0<4;++d0){
    const bf16x8 b0=*reinterpret_cast<const bf16x8*>(kb+d0*2048);
    const bf16x8 b1=*reinterpret_cast<const bf16x8*>(kb+d0*2048+512);
    if(d0==0){p0=__builtin_amdgcn_mfma_f32_32x32x16_bf16(b0,qr[0],negm,0,0,0);p1=__builtin_amdgcn_mfma_f32_32x32x16_bf16(b1,qr[0],negm,0,0,0);}
    else{p0=__builtin_amdgcn_mfma_f32_32x32x16_bf16(b0,qr[d0],p0,0,0,0);p1=__builtin_amdgcn_mfma_f32_32x32x16_bf16(b1,qr[d0],p1,0,0,0);}}
}
typedef __attribute__((address_space(3))) const char* lds_cptr;
typedef short v4i16_t __attribute__((ext_vector_type(4)));
__device__ __forceinline__ void kload8(bf16x8*kf,lds_cptr kp){
  kf[0]=*(const __attribute__((address_space(3))) bf16x8*)(kp);      kf[1]=*(const __attribute__((address_space(3))) bf16x8*)(kp+512);
  kf[2]=*(const __attribute__((address_space(3))) bf16x8*)(kp+2048); kf[3]=*(const __attribute__((address_space(3))) bf16x8*)(kp+2560);
  kf[4]=*(const __attribute__((address_space(3))) bf16x8*)(kp+4096); kf[5]=*(const __attribute__((address_space(3))) bf16x8*)(kp+4608);
  kf[6]=*(const __attribute__((address_space(3))) bf16x8*)(kp+6144); kf[7]=*(const __attribute__((address_space(3))) bf16x8*)(kp+6656);
}
__device__ __forceinline__ void kload2(bf16x8*kf,lds_cptr kp,int j){ kf[2*j]=*(const __attribute__((address_space(3))) bf16x8*)(kp+j*2048); kf[2*j+1]=*(const __attribute__((address_space(3))) bf16x8*)(kp+j*2048+512); }
__device__ __forceinline__ s16x4 vtr(lds_cptr p){ return __builtin_bit_cast(s16x4,__builtin_amdgcn_ds_read_tr16_b64_v4i16((__attribute__((address_space(3))) v4i16_t*)p)); }
__device__ __forceinline__ float rowmax(const f32x16&p0,const f32x16&p1){
  float a=max3f(p0[0],p0[1],p1[0]),b=max3f(p0[2],p0[3],p1[1]);a=max3f(a,p1[2],p1[3]);
  #pragma unroll
  for(int r=4;r<16;r+=4){a=max3f(a,p0[r],p0[r+1]);b=max3f(b,p0[r+2],p0[r+3]);a=max3f(a,p1[r],p1[r+1]);b=max3f(b,p1[r+2],p1[r+3]);}
  const float m=max2f(a,b);
  auto rr=__builtin_amdgcn_permlane32_swap(__float_as_uint(m),__float_as_uint(m),false,false);
  return max2f(__uint_as_float(rr[0]),__uint_as_float(rr[1]));
}
__device__ __forceinline__ void pv(f32x16*o,int vb,bf16x8 pa0,bf16x8 pa1,bf16x8 pa2,bf16x8 pa3){
  #pragma unroll
  for(int d0=0;d0<2;++d0){s16x4 lo[4],hi[4];
    #pragma unroll
    for(int ks=0;ks<4;++ks){
      asm volatile("ds_read_b64_tr_b16 %0,%1 offset:%c2":"=&v"(lo[ks]):"v"(vb),"i"(d0*4096+ks*1024):"memory");
      asm volatile("ds_read_b64_tr_b16 %0,%1 offset:%c2":"=&v"(hi[ks]):"v"(vb),"i"(d0*4096+ks*1024+512):"memory");}
    asm volatile("s_waitcnt lgkmcnt(0)":::"memory");SBAR();
    #define PK(k) (bf16x8){lo[k][0],lo[k][1],lo[k][2],lo[k][3],hi[k][0],hi[k][1],hi[k][2],hi[k][3]}
    o[d0]=__builtin_amdgcn_mfma_f32_32x32x16_bf16(pa0,PK(0),o[d0],0,0,0);
    o[d0]=__builtin_amdgcn_mfma_f32_32x32x16_bf16(pa1,PK(1),o[d0],0,0,0);
    o[d0]=__builtin_amdgcn_mfma_f32_32x32x16_bf16(pa2,PK(2),o[d0],0,0,0);
    o[d0]=__builtin_amdgcn_mfma_f32_32x32x16_bf16(pa3,PK(3),o[d0],0,0,0);
    #undef PK
  }
}

#ifndef ATTN_STORE16
#define ATTN_STORE16(p,v) (*(u32x4*)(p)=(v))
#endif
template<int THRL,bool NOMAX> __device__ __forceinline__ void attn_unit(const bf16*Qu,int QP,const bf16*__restrict__ Kh,int KP,const bf16*__restrict__ Vh,int VP,bf16*Ou,int OP,int NT,char*shm,const int tid){
  const int lane=tid&63,r32=lane&31,hi=lane>>5; const int wid=__builtin_amdgcn_readfirstlane(tid>>6);
  const bf16*Qw=Qu+(long)(wid*QBLK)*QP;
  const unsigned lds0=(unsigned)(uintptr_t)shm;
  float*wsf=(float*)(shm+LDS_WS)+wid*64;
  const bf16*ksrc=Kh+(long)lane*KP+wid*8;
  const bf16*vsrc=Vh+(long)(16*(wid&3)+(lane>>2))*VP+(wid>>2)*32+(lane&3)*8;
  const unsigned kdst=lds0+LDS_K+wid*1024, vdst=lds0+LDS_V+wid*1024;
  #define DMA_K(t,slot) glds16(ksrc+(long)(t)*KVBLK*KP,(unsigned)__builtin_amdgcn_readfirstlane(kdst+(slot)))
  #define DMA_V(t,slot) glds16(vsrc+(long)(t)*KVBLK*VP,(unsigned)__builtin_amdgcn_readfirstlane(vdst+(slot)))
  const int vb0=(int)(lds0+LDS_V)+((lane>>4)&1)*32+(lane&3)*8+(4*hi+((lane&15)>>2))*64;
  const char*Kbase=shm+LDS_K; bf16x8 kf[8];
  const lds_cptr shm3=(lds_cptr)shm; const lds_cptr kp0=shm3+LDS_K+hi*1024+r32*16; const lds_cptr vp0=shm3+LDS_V+((lane>>4)&1)*32+(lane&3)*8+(4*hi+((lane&15)>>2))*64;
  DMA_K(0,0);DMA_V(0,0);DMA_K(1,SLOTB);
  bf16x8 qr[4];
  #pragma unroll
  for(int d0=0;d0<4;++d0)qr[d0]=*reinterpret_cast<const bf16x8*>(&Qw[(long)r32*QP+d0*16+hi*8]);
  float mhat=0.f,l_reg=0.f;f32x16 o[2];o[0]=f32x16{};o[1]=f32x16{};f32x16 negm=f32x16{};asm volatile("":"+v"(negm));
  #define CMASK(P0,P1,t) do{}while(0)
  bool resc=false;
  #define START(P0,P1) do{ resc=false; if constexpr(!NOMAX){ const float rm=rowmax(P0,P1); \
    { const float dl=rm; mhat=fadd_s(mhat,dl); \
      _Pragma("unroll") for(int r=0;r<16;++r){P0[r]=fsub_s(P0[r],dl);P1[r]=fsub_s(P1[r],dl);} \
      _Pragma("unroll") for(int r=0;r<16;++r)negm[r]=-mhat; asm volatile("":"+v"(negm)); } } \
    _Pragma("unroll") for(int r=0;r<16;++r)P0[r]=__builtin_amdgcn_exp2f(P0[r]); }while(0)
  #define RESC() do{ if(resc){ asm volatile("s_waitcnt lgkmcnt(0)":::"memory"); \
      _Pragma("unroll") for(int d_=0;d_<2;++d_) _Pragma("unroll") for(int r=0;r<16;++r)o[d_][r]*=wsf[crow(r,hi)]; } }while(0)
  f32x16 pA0,pA1,pB0,pB1;
  int sl_prev=0,sl_cur=0,sl_next=SLOTB;
  #define ROT() do{sl_prev=sl_cur;sl_cur=sl_next;sl_next=(sl_next==(NSLOT-1)*SLOTB)?0:sl_next+SLOTB;}while(0)
  DMA_K(2,2*SLOTB);
  WAIT_BAR(3);
  qkt(pA0,pA1,Kbase,qr,negm,r32,hi);asm volatile("s_nop 15\n\ts_nop 7":"+v"(pA0),"+v"(pA1));CMASK(pA0,pA1,0);
  START(pA0,pA1);
  _Pragma("unroll") for(int r=0;r<16;++r)pA1[r]=__builtin_amdgcn_exp2f(pA1[r]);
  WAIT_BAR(0);
  DMA_K(3,0);DMA_V(1,SLOTB);
  ROT();
  kload8(kf,kp0+sl_cur);
  WAIT_BAR(2);
  s16x4 vlo[8],vhi[8]; u32x4 pw0,pw1,pw2,pw3;
  #define PKW(P,B) cvtpk_s(P[B],P[B+1])
  #define PAF(k) __builtin_bit_cast(bf16x8,pw##k)
  #define VFR(i) (bf16x8){vlo[i][0],vlo[i][1],vlo[i][2],vlo[i][3],vhi[i][0],vhi[i][1],vhi[i][2],vhi[i][3]}
  #define PIN(x) asm volatile("":"+v"(x))
  #define MX3(a,b,c) __builtin_fmaxf(__builtin_fmaxf((a),(b)),(c))
  #define GAPA(MF,A0,A1,A2,A3,W0,W1,PW) do{ MF; sacc+=A0; sacc+=A1; sacc+=A2; sacc+=A3; PIN(sacc); W0; W1; PIN(PW); SBAR(); }while(0)
  #define EX(v) __builtin_amdgcn_exp2f(v)
  #define GAPB(MF,X,B) do{ MF; X[B]=EX(X[B]); X[B+1]=EX(X[B+1]); X[B+2]=EX(X[B+2]); X[B+3]=EX(X[B+3]); PIN(X); SBAR(); }while(0)
  #define VRD(i) do{ vlo[i]=vtr(vp_+(((i)>>2)*4096+((i)&3)*1024)); vhi[i]=vtr(vp_+(((i)>>2)*4096+((i)&3)*1024+512)); }while(0)
  #define KRD(G,j) do{ if(G){ kload2(kf,kp0+sl_next,j); SBAR(); } }while(0)
  #define NEGM_OP (NOMAX?f32x16{}:negm)
  #define STEP(C0,C1,P0,P1,t,GK,GV,GL) do{ SBAR(); \
    const lds_cptr vp_=vp0+sl_prev; \
    VRD(0); SBAR(); float sacc=(P0[0]+P0[1]); \
    GAPA(C0=__builtin_amdgcn_mfma_f32_32x32x16_bf16(kf[0],qr[0],NEGM_OP,0,0,0), P0[2],P0[3],P0[4],P0[5],     pw0[0]=PKW(P0,0), pw0[1]=PKW(P0,2), pw0); \
    VRD(4); SBAR(); GAPA(C1=__builtin_amdgcn_mfma_f32_32x32x16_bf16(kf[1],qr[0],NEGM_OP,0,0,0), P0[6],P0[7],P0[8],P0[9],     pw0[2]=PKW(P0,4), pw0[3]=PKW(P0,6), pw0); \
    VRD(1); SBAR(); GAPA(C0=__builtin_amdgcn_mfma_f32_32x32x16_bf16(kf[2],qr[1],C0,0,0,0),   P0[10],P0[11],P0[12],P0[13], pw1[0]=PKW(P0,8), pw1[1]=PKW(P0,10), pw1); \
    VRD(5); SBAR(); GAPA(C1=__builtin_amdgcn_mfma_f32_32x32x16_bf16(kf[3],qr[1],C1,0,0,0),   P0[14],P0[15],P1[0],P1[1],   pw1[2]=PKW(P0,12),pw1[3]=PKW(P0,14), pw1); \
    VRD(2); SBAR(); GAPA(C0=__builtin_amdgcn_mfma_f32_32x32x16_bf16(kf[4],qr[2],C0,0,0,0),   P1[2],P1[3],P1[4],P1[5],     pw2[0]=PKW(P1,0), pw2[1]=PKW(P1,2), pw2); \
    VRD(6); SBAR(); GAPA(C1=__builtin_amdgcn_mfma_f32_32x32x16_bf16(kf[5],qr[2],C1,0,0,0),   P1[6],P1[7],P1[8],P1[9],     pw2[2]=PKW(P1,4), pw2[3]=PKW(P1,6), pw2); \
    VRD(3); SBAR(); GAPA(C0=__builtin_amdgcn_mfma_f32_32x32x16_bf16(kf[6],qr[3],C0,0,0,0),   P1[10],P1[11],P1[12],P1[13], pw3[0]=PKW(P1,8), pw3[1]=PKW(P1,10), pw3); \
    VRD(7); SBAR(); GAPA(C1=__builtin_amdgcn_mfma_f32_32x32x16_bf16(kf[7],qr[3],C1,0,0,0),   P1[14],P1[15],0.f,0.f,       pw3[2]=PKW(P1,12),pw3[3]=PKW(P1,14), pw3); \
    l_reg+=sacc; \
    if(GK){DMA_K((t)+3,sl_cur);} if(GV){DMA_V((t)+1,sl_next);} \
    if constexpr(!NOMAX) \
    { float a=MX3(C0[0],C0[1],C1[0]),b=MX3(C0[2],C0[3],C1[1]); a=MX3(a,C1[2],C1[3]); \
      _Pragma("unroll") for(int r=4;r<16;r+=4){a=MX3(a,C0[r],C0[r+1]);b=MX3(b,C0[r+2],C0[r+3]);a=MX3(a,C1[r],C1[r+1]);b=MX3(b,C1[r+2],C1[r+3]);} \
      float rm=__builtin_fmaxf(a,b); { auto rr=__builtin_amdgcn_permlane32_swap(__float_as_uint(rm),__float_as_uint(rm),false,false); rm=__builtin_fmaxf(__uint_as_float(rr[0]),__uint_as_float(rr[1])); } \
      resc=false; \
      if(__builtin_expect(__any(rm>(float)THRL),0)){ const float dl=__builtin_fmaxf(rm,0.f); mhat+=dl; \
        _Pragma("unroll") for(int r=0;r<16;++r){C0[r]-=dl;C1[r]-=dl;} \
        _Pragma("unroll") for(int r=0;r<16;++r)negm[r]=-mhat; asm volatile("":"+v"(negm)); \
        const float f=__builtin_amdgcn_exp2f(-dl); l_reg*=f; if(hi==0)wsf[r32]=f; resc=true; } } \
    SBAR(); \
    GAPB(o[0]=__builtin_amdgcn_mfma_f32_32x32x16_bf16(PAF(0),VFR(0),o[0],0,0,0), C0,0); \
    GAPB(o[1]=__builtin_amdgcn_mfma_f32_32x32x16_bf16(PAF(0),VFR(4),o[1],0,0,0), C0,4); \
    KRD(GL,0); GAPB(o[0]=__builtin_amdgcn_mfma_f32_32x32x16_bf16(PAF(1),VFR(1),o[0],0,0,0), C0,8); \
    KRD(GL,1); GAPB(o[1]=__builtin_amdgcn_mfma_f32_32x32x16_bf16(PAF(1),VFR(5),o[1],0,0,0), C0,12); \
    KRD(GL,2); GAPB(o[0]=__builtin_amdgcn_mfma_f32_32x32x16_bf16(PAF(2),VFR(2),o[0],0,0,0), C1,0); \
    KRD(GL,3); GAPB(o[1]=__builtin_amdgcn_mfma_f32_32x32x16_bf16(PAF(2),VFR(6),o[1],0,0,0), C1,4); \
    GAPB(o[0]=__builtin_amdgcn_mfma_f32_32x32x16_bf16(PAF(3),VFR(3),o[0],0,0,0), C1,8); \
    GAPB(o[1]=__builtin_amdgcn_mfma_f32_32x32x16_bf16(PAF(3),VFR(7),o[1],0,0,0), C1,12); \
    }while(0)
  int t=1;
  for(;t+5<NT;t+=2){
    STEP(pB0,pB1,pA0,pA1,t,true,true,true);     WAIT_BAR(2); RESC(); ROT();
    STEP(pA0,pA1,pB0,pB1,t+1,true,true,true);   WAIT_BAR(2); RESC(); ROT();
  }
  #define ENDW(tt) do{ if((tt)+3<NT){WAIT_BAR(2);} else if((tt)+2<NT){WAIT_BAR(1);} else {WAIT_BAR(0);} }while(0)
  for(;t+1<NT;t+=2){
    STEP(pB0,pB1,pA0,pA1,t,(t+3<NT),(t+1<NT),(t+1<NT));       ENDW(t);   RESC(); ROT();
    STEP(pA0,pA1,pB0,pB1,t+1,(t+4<NT),(t+2<NT),(t+2<NT));     ENDW(t+1); RESC(); ROT();
  }
  STEP(pB0,pB1,pA0,pA1,NT-1,false,false,false); RESC();
  { float sacc=pB0[0]+pB0[1]; _Pragma("unroll") for(int r=2;r<16;++r)sacc+=pB0[r]; _Pragma("unroll") for(int r=0;r<16;++r)sacc+=pB1[r]; l_reg+=sacc;
    pw0=(u32x4){PKW(pB0,0),PKW(pB0,2),PKW(pB0,4),PKW(pB0,6)};pw1=(u32x4){PKW(pB0,8),PKW(pB0,10),PKW(pB0,12),PKW(pB0,14)};pw2=(u32x4){PKW(pB1,0),PKW(pB1,2),PKW(pB1,4),PKW(pB1,6)};pw3=(u32x4){PKW(pB1,8),PKW(pB1,10),PKW(pB1,12),PKW(pB1,14)};
    SBAR(); pv(o,vb0+sl_cur,PAF(0),PAF(1),PAF(2),PAF(3)); }
  #undef PKW
  #undef PAF
  #undef VFR
  #undef PIN
  #undef MX3
  #undef GAPA
  #undef GAPB
  #undef EX
  #undef VRD
  #undef KRD
  #undef STEP
  #undef ENDW
  #ifdef NEGM_OP
  #undef NEGM_OP
  #endif
  {auto rr=__builtin_amdgcn_permlane32_swap(__float_as_uint(l_reg),__float_as_uint(l_reg),false,false);l_reg=__uint_as_float(rr[0])+__uint_as_float(rr[1]);}
  if(hi==0)wsf[32+r32]=l_reg;asm volatile("s_waitcnt lgkmcnt(0)":::"memory");
  float rli[16];
  #pragma unroll
  for(int r=0;r<16;++r)rli[r]=__builtin_amdgcn_rcpf(wsf[32+crow(r,hi)]);
  bf16*Ow=Ou+(long)(wid*QBLK)*OP;
  { bf16*stg=(bf16*)(shm+LDS_OST)+wid*2048;
    #pragma unroll
    for(int r=0;r<16;++r){const int orow=crow(r,hi);
      #pragma unroll
      for(int d0=0;d0<2;++d0)stg[orow*64+d0*32+r32]=__float2bfloat16(o[d0][r]*rli[r]);}
    asm volatile("s_waitcnt lgkmcnt(0)":::"memory");
    #pragma unroll
    for(int i=0;i<4;++i){const int row=i*8+(lane>>3),ch=lane&7; const u32x4 v=*(const u32x4*)(stg+row*64+ch*8); ATTN_STORE16(Ow+(long)row*OP+ch*8,v);} }
  asm volatile("s_waitcnt lgkmcnt(0)\n\ts_barrier":::"memory");
  #undef DMA_K
  #undef DMA_V
  #undef CMASK
  #undef START
  #undef RESC
  #undef ROT
}
constexpr int LDS_WS128=LDS_V+NSLOT*2*SLOTB, LDS_OST128=LDS_WS128+NW*64*4, LDS_BYTES128=LDS_OST128+NW*4096;
template<int THRL,bool NOMAX> __device__ __forceinline__ void attn_unit128(const bf16*Qu,int QP,const bf16*__restrict__ Kh,int KP,const bf16*__restrict__ Vh,int VP,bf16*Ou,int OP,int NT,char*shm,const int tid){
  const int lane=tid&63,r32=lane&31,hi=lane>>5; const int wid=__builtin_amdgcn_readfirstlane(tid>>6);
  const bf16*Qw=Qu+(long)(wid*QBLK)*QP;
  const unsigned lds0=(unsigned)(uintptr_t)shm;
  float*wsf=(float*)(shm+LDS_WS128)+wid*64;
  const bf16*ksrc=Kh+(long)lane*KP+wid*8;
  const bf16*vsrc=Vh+(long)(16*(wid&3)+(lane>>2))*VP+(wid>>2)*32+(lane&3)*8;
  const unsigned kdst=lds0+LDS_K+wid*1024, vdst=lds0+LDS_V+wid*1024;
  #define DMA_K(t,slot) glds16(ksrc+(long)(t)*KVBLK*KP,(unsigned)__builtin_amdgcn_readfirstlane(kdst+(slot)))
  #define DMA_V(t,slot) do{ glds16(vsrc+(long)(t)*KVBLK*VP,(unsigned)__builtin_amdgcn_readfirstlane(vdst+2*(slot))); glds16(vsrc+64+(long)(t)*KVBLK*VP,(unsigned)__builtin_amdgcn_readfirstlane(vdst+2*(slot)+8192)); }while(0)
  const int vb0=(int)(lds0+LDS_V)+((lane>>4)&1)*32+(lane&3)*8+(4*hi+((lane&15)>>2))*64;
  const char*Kbase=shm+LDS_K; bf16x8 kf[8];
  const lds_cptr shm3=(lds_cptr)shm; const lds_cptr kp0=shm3+LDS_K+hi*1024+r32*16; const lds_cptr vp0=shm3+LDS_V+((lane>>4)&1)*32+(lane&3)*8+(4*hi+((lane&15)>>2))*64;
  DMA_K(0,0);DMA_V(0,0);DMA_K(1,SLOTB);
  bf16x8 qr[4];
  #pragma unroll
  for(int d0=0;d0<4;++d0)qr[d0]=*reinterpret_cast<const bf16x8*>(&Qw[(long)r32*QP+d0*16+hi*8]);
  float mhat=0.f,l_reg=0.f;f32x16 o[4];o[0]=f32x16{};o[1]=f32x16{};o[2]=f32x16{};o[3]=f32x16{};const f32x16 zero16=f32x16{};
  #define CMASK(P0,P1,t) do{}while(0)
  bool resc=false;
  #define START(P0,P1) do{ resc=false; if constexpr(!NOMAX){ const float rm=rowmax(P0,P1); \
    { const float dl=rm; mhat=fadd_s(mhat,dl); \
      _Pragma("unroll") for(int r=0;r<16;++r){P0[r]=fsub_s(P0[r],dl);P1[r]=fsub_s(P1[r],dl);} } } \
    _Pragma("unroll") for(int r=0;r<16;++r)P0[r]=__builtin_amdgcn_exp2f(P0[r]); }while(0)
  #define RESC() do{ if(resc){ asm volatile("s_waitcnt lgkmcnt(0)":::"memory"); \
      _Pragma("unroll") for(int d_=0;d_<4;++d_) _Pragma("unroll") for(int r=0;r<16;++r)o[d_][r]*=wsf[crow(r,hi)]; } }while(0)
  f32x16 pA0,pA1,pB0,pB1;
  int sl_prev=0,sl_cur=0,sl_next=SLOTB;
  #define ROT() do{sl_prev=sl_cur;sl_cur=sl_next;sl_next=(sl_next==(NSLOT-1)*SLOTB)?0:sl_next+SLOTB;}while(0)
  DMA_K(2,2*SLOTB);
  WAIT_BAR(3);
  qkt(pA0,pA1,Kbase,qr,zero16,r32,hi);asm volatile("s_nop 15\n\ts_nop 7":"+v"(pA0),"+v"(pA1));CMASK(pA0,pA1,0);
  START(pA0,pA1);
  _Pragma("unroll") for(int r=0;r<16;++r)pA1[r]=__builtin_amdgcn_exp2f(pA1[r]);
  WAIT_BAR(0);
  DMA_K(3,0);DMA_V(1,SLOTB);
  ROT();
  kload8(kf,kp0+sl_cur);
  WAIT_BAR(3);
  s16x4 vlo[8],vhi[8]; u32x4 pw0,pw1,pw2,pw3;
  #define PKW(P,B) cvtpk_s(P[B],P[B+1])
  #define PAF(k) __builtin_bit_cast(bf16x8,pw##k)
  #define VFR(i) (bf16x8){vlo[i][0],vlo[i][1],vlo[i][2],vlo[i][3],vhi[i][0],vhi[i][1],vhi[i][2],vhi[i][3]}
  #define PIN(x) asm volatile("":"+v"(x))
  #define MX3(a,b,c) __builtin_fmaxf(__builtin_fmaxf((a),(b)),(c))
  #define GAPA(MF,A0,A1,A2,A3,W0,W1,PW) do{ MF; sacc+=A0; sacc+=A1; sacc+=A2; sacc+=A3; PIN(sacc); W0; W1; PIN(PW); SBAR(); }while(0)
  #define EX(v) __builtin_amdgcn_exp2f(v)
  #define GAPB(MF,X,B) do{ MF; if constexpr(NOMAX){ X[B]=EX(X[B]); X[B+1]=EX(X[B+1]); } else { X[B]=EX(X[B]-mhat); X[B+1]=EX(X[B+1]-mhat); } PIN(X); SBAR(); }while(0)
  #define VRD(i) do{ vlo[i]=vtr(vp_+(((i)>>2)*4096+((i)&3)*1024)); vhi[i]=vtr(vp_+(((i)>>2)*4096+((i)&3)*1024+512)); }while(0)
  #define VRD2(i) do{ vlo[i]=vtr(vp_+((((i)>>2)+2)*4096+((i)&3)*1024)); vhi[i]=vtr(vp_+((((i)>>2)+2)*4096+((i)&3)*1024+512)); SBAR(); }while(0)
  #define KRD(G,j) do{ if(G){ kload2(kf,kp0+sl_next,j); SBAR(); } }while(0)
  #define MF32(a,b,c) __builtin_amdgcn_mfma_f32_32x32x16_bf16(a,b,c,0,0,0)
  #define STEP(C0,C1,P0,P1,t,GK,GV,GL) do{ SBAR(); \
    const lds_cptr vp_=vp0+2*sl_prev; \
    VRD(0); SBAR(); float sacc=(P0[0]+P0[1]); \
    GAPA(C0=MF32(kf[0],qr[0],zero16), P0[2],P0[3],P0[4],P0[5],     pw0[0]=PKW(P0,0), pw0[1]=PKW(P0,2), pw0); \
    VRD(4); SBAR(); GAPA(C1=MF32(kf[1],qr[0],zero16), P0[6],P0[7],P0[8],P0[9],     pw0[2]=PKW(P0,4), pw0[3]=PKW(P0,6), pw0); \
    VRD(1); SBAR(); GAPA(C0=MF32(kf[2],qr[1],C0),   P0[10],P0[11],P0[12],P0[13], pw1[0]=PKW(P0,8), pw1[1]=PKW(P0,10), pw1); \
    VRD(5); SBAR(); GAPA(C1=MF32(kf[3],qr[1],C1),   P0[14],P0[15],P1[0],P1[1],   pw1[2]=PKW(P0,12),pw1[3]=PKW(P0,14), pw1); \
    VRD(2); SBAR(); GAPA(C0=MF32(kf[4],qr[2],C0),   P1[2],P1[3],P1[4],P1[5],     pw2[0]=PKW(P1,0), pw2[1]=PKW(P1,2), pw2); \
    VRD(6); SBAR(); GAPA(C1=MF32(kf[5],qr[2],C1),   P1[6],P1[7],P1[8],P1[9],     pw2[2]=PKW(P1,4), pw2[3]=PKW(P1,6), pw2); \
    VRD(3); SBAR(); GAPA(C0=MF32(kf[6],qr[3],C0),   P1[10],P1[11],P1[12],P1[13], pw3[0]=PKW(P1,8), pw3[1]=PKW(P1,10), pw3); \
    VRD(7); SBAR(); GAPA(C1=MF32(kf[7],qr[3],C1),   P1[14],P1[15],0.f,0.f,       pw3[2]=PKW(P1,12),pw3[3]=PKW(P1,14), pw3); \
    l_reg+=sacc; \
    if(GK){DMA_K((t)+3,sl_cur);} if(GV){DMA_V((t)+1,sl_next);} \
    if constexpr(!NOMAX) \
    { float a=MX3(C0[0],C0[1],C1[0]),b=MX3(C0[2],C0[3],C1[1]); a=MX3(a,C1[2],C1[3]); \
      _Pragma("unroll") for(int r=4;r<16;r+=4){a=MX3(a,C0[r],C0[r+1]);b=MX3(b,C0[r+2],C0[r+3]);a=MX3(a,C1[r],C1[r+1]);b=MX3(b,C1[r+2],C1[r+3]);} \
      float rm=__builtin_fmaxf(a,b); { auto rr=__builtin_amdgcn_permlane32_swap(__float_as_uint(rm),__float_as_uint(rm),false,false); rm=__builtin_fmaxf(__uint_as_float(rr[0]),__uint_as_float(rr[1])); } \
      rm-=mhat; resc=false;                                 \
      if(__builtin_expect(__any(rm>(float)THRL),0)){ const float dl=__builtin_fmaxf(rm,0.f); mhat+=dl; \
        const float f=__builtin_amdgcn_exp2f(-dl); l_reg*=f; if(hi==0)wsf[r32]=f; resc=true; } } \
    SBAR(); \
    GAPB(o[0]=MF32(PAF(0),VFR(0),o[0]), C0,0);  VRD2(0); \
    GAPB(o[1]=MF32(PAF(0),VFR(4),o[1]), C0,2);  VRD2(4); \
    KRD(GL,0); GAPB(o[0]=MF32(PAF(1),VFR(1),o[0]), C0,4);  VRD2(1); \
    KRD(GL,1); GAPB(o[1]=MF32(PAF(1),VFR(5),o[1]), C0,6);  VRD2(5); \
    KRD(GL,2); GAPB(o[0]=MF32(PAF(2),VFR(2),o[0]), C0,8);  VRD2(2); \
    KRD(GL,3); GAPB(o[1]=MF32(PAF(2),VFR(6),o[1]), C0,10); VRD2(6); \
    GAPB(o[0]=MF32(PAF(3),VFR(3),o[0]), C0,12); VRD2(3); \
    GAPB(o[1]=MF32(PAF(3),VFR(7),o[1]), C0,14); VRD2(7); \
    GAPB(o[2]=MF32(PAF(0),VFR(0),o[2]), C1,0); \
    GAPB(o[3]=MF32(PAF(0),VFR(4),o[3]), C1,2); \
    GAPB(o[2]=MF32(PAF(1),VFR(1),o[2]), C1,4); \
    GAPB(o[3]=MF32(PAF(1),VFR(5),o[3]), C1,6); \
    GAPB(o[2]=MF32(PAF(2),VFR(2),o[2]), C1,8); \
    GAPB(o[3]=MF32(PAF(2),VFR(6),o[3]), C1,10); \
    GAPB(o[2]=MF32(PAF(3),VFR(3),o[2]), C1,12); \
    GAPB(o[3]=MF32(PAF(3),VFR(7),o[3]), C1,14); \
    }while(0)
  int t=1;
  for(;t+5<NT;t+=2){
    STEP(pB0,pB1,pA0,pA1,t,true,true,true);     WAIT_BAR(3); RESC(); ROT();
    STEP(pA0,pA1,pB0,pB1,t+1,true,true,true);   WAIT_BAR(3); RESC(); ROT();
  }
  #define ENDW(tt) do{ if((tt)+3<NT){WAIT_BAR(3);} else if((tt)+2<NT){WAIT_BAR(2);} else {WAIT_BAR(0);} }while(0)
  for(;t+1<NT;t+=2){
    STEP(pB0,pB1,pA0,pA1,t,(t+3<NT),(t+1<NT),(t+1<NT));       ENDW(t);   RESC(); ROT();
    STEP(pA0,pA1,pB0,pB1,t+1,(t+4<NT),(t+2<NT),(t+2<NT));     ENDW(t+1); RESC(); ROT();
  }
  STEP(pB0,pB1,pA0,pA1,NT-1,false,false,false); RESC();
  { float sacc=pB0[0]+pB0[1]; _Pragma("unroll") for(int r=2;r<16;++r)sacc+=pB0[r]; _Pragma("unroll") for(int r=0;r<16;++r)sacc+=pB1[r]; l_reg+=sacc;
    pw0=(u32x4){PKW(pB0,0),PKW(pB0,2),PKW(pB0,4),PKW(pB0,6)};pw1=(u32x4){PKW(pB0,8),PKW(pB0,10),PKW(pB0,12),PKW(pB0,14)};pw2=(u32x4){PKW(pB1,0),PKW(pB1,2),PKW(pB1,4),PKW(pB1,6)};pw3=(u32x4){PKW(pB1,8),PKW(pB1,10),PKW(pB1,12),PKW(pB1,14)};
    SBAR(); pv(o,vb0+2*sl_cur,PAF(0),PAF(1),PAF(2),PAF(3)); pv(o+2,vb0+2*sl_cur+8192,PAF(0),PAF(1),PAF(2),PAF(3)); }
  #undef PKW
  #undef PAF
  #undef VFR
  #undef PIN
  #undef MX3
  #undef GAPA
  #undef GAPB
  #undef EX
  #undef VRD
  #undef VRD2
  #undef MF32
  #undef KRD
  #undef STEP
  #undef ENDW
  {auto rr=__builtin_amdgcn_permlane32_swap(__float_as_uint(l_reg),__float_as_uint(l_reg),false,false);l_reg=__uint_as_float(rr[0])+__uint_as_float(rr[1]);}
  if(hi==0)wsf[32+r32]=l_reg;asm volatile("s_waitcnt lgkmcnt(0)":::"memory");
  float rli[16];
  #pragma unroll
  for(int r=0;r<16;++r)rli[r]=__builtin_amdgcn_rcpf(wsf[32+crow(r,hi)]);
  bf16*Ow=Ou+(long)(wid*QBLK)*OP;
  { bf16*stg=(bf16*)(shm+LDS_OST128)+wid*2048;
    #pragma unroll
    for(int hb=0;hb<2;++hb){
      #pragma unroll
      for(int r=0;r<16;++r){const int orow=crow(r,hi);
        #pragma unroll
        for(int d0=0;d0<2;++d0)stg[orow*64+d0*32+r32]=__float2bfloat16(o[2*hb+d0][r]*rli[r]);}
      asm volatile("s_waitcnt lgkmcnt(0)":::"memory");
      #pragma unroll
      for(int i=0;i<4;++i){const int row=i*8+(lane>>3),ch=lane&7; const u32x4 v=*(const u32x4*)(stg+row*64+ch*8); ATTN_STORE16(Ow+(long)row*OP+hb*64+ch*8,v);}
      asm volatile("s_waitcnt lgkmcnt(0)":::"memory"); } }
  asm volatile("s_waitcnt lgkmcnt(0)\n\ts_barrier":::"memory");
  #undef DMA_K
  #undef DMA_V
  #undef CMASK
  #undef START
  #undef RESC
  #undef ROT
}
constexpr int ATTN_LDS_BYTES=LDS_BYTES128;
#undef SBAR
#undef WAIT_BAR
}
typedef const float* const __attribute__((address_space(4)))* kin_ptr;
struct InTab { kin_ptr p; DI const float* operator[](int i) const { return (const float*)(const GAS float*)p[i]; } };
struct Frame {
    LAS unsigned char* lds; volatile LAS unsigned* MISC; gu32* ctl;
    int tid, lane, wave, vcu, G, gw, NGW, bx;
    InTab in; float* out; unsigned char* ws;
};
DI const float* modv_of(const Frame& F, int li) { return (const float*)(F.ws + WS_MODV) + (size_t)li * 9 * 6144; }
DI const float* lat_x(const Frame& F, int li) { return li == 0 ? F.in[I_X] : F.out; }
DI const float* ctx_x(const Frame& F, int li) { return li == 0 ? F.in[I_CTX] : (const float*)(F.ws + WS_XC); }

DI void phase_p0(const Frame& F) {
    LAS float* act = (LAS float*)F.lds;
    LAS float* part = (LAS float*)(F.lds + 36864);
    bool loaded = false;
    for (int u = F.bx; u < NLAYER * 96; u += F.G) {
        const int li = u / 96, n0 = (u % 96) * 64;
        if (!loaded) {
            for (int i = F.tid; i < 9 * 1024; i += 512) { const int m = i >> 10, k = i & 1023; const float c = m < 8 ? F.in[I_C][m * 1024 + k] : F.in[I_CCTX][k]; act[i] = siluf_(c); }
            loaded = true;
        }
        __syncthreads();
        float acc[9];
#pragma unroll
        for (int m = 0; m < 9; ++m) acc[m] = 0.f;
        const float* W = F.in[I_WMOD] + (size_t)li * 1024 * 6144 + n0 + F.lane;
        const int k0 = F.wave * 128;
        for (int k = k0; k < k0 + 128; k += 4) {
            float wv[4];
#pragma unroll
            for (int e = 0; e < 4; ++e) wv[e] = W[(size_t)(k + e) * 6144];
#pragma unroll
            for (int m = 0; m < 9; ++m) { const f32x4 a = *(const LAS f32x4*)(act + m * 1024 + k); acc[m] += a[0] * wv[0] + a[1] * wv[1] + a[2] * wv[2] + a[3] * wv[3]; }
        }
#pragma unroll
        for (int m = 0; m < 9; ++m) part[(F.wave * 9 + m) * 64 + F.lane] = acc[m];
        __syncthreads();
        for (int i = F.tid; i < 9 * 64; i += 512) { const int m = i >> 6, l = i & 63; float s = 0.f;
#pragma unroll
            for (int w = 0; w < 8; ++w) s += part[(w * 9 + m) * 64 + l];
            ((float*)(F.ws + WS_MODV))[((size_t)li * 9 + m) * 6144 + n0 + l] = s + F.in[I_BMOD][li * 6144 + n0 + l]; }
        __syncthreads();
    }
    if (F.bx == F.G - 1) {
        float* rope = (float*)(F.ws + WS_ROPE);
        for (int i = F.tid; i < 128 * 16; i += 512) { const int pos = i >> 4, f = i & 15; const float inv = powf(10000.f, -(float)(2 * f) / 32.f); const float ang = (float)pos * inv; float s, c; sincosf(ang, &s, &c); rope[2 * i] = c; rope[2 * i + 1] = s; }
        if (F.wave < NLAYER) {
            const int li = F.wave; const int l = F.lane;
            const float a = wave_sum(F.in[I_LQ1][li * 64 + l] * F.in[I_LK1][li * 64 + l]), b = wave_sum(F.in[I_LQ2][li * 64 + l] * F.in[I_LK2][li * 64 + l]);
            const float lam_init = 0.8f - 0.6f * expf(-0.3f * (float)li);
            if (l == 0) { float* L = (float*)(F.ws + WS_LAM) + li * 4; L[0] = expf(a) - expf(b) + lam_init; L[1] = 1.f - lam_init; }
            float mq = fabsf(F.in[I_GQN][li * 64 + l]), mk = fabsf(F.in[I_GKN][li * 64 + l]), dq = fabsf(F.in[I_DQN][li * 64 + l]), dk = fabsf(F.in[I_DKN][li * 64 + l]);
#pragma unroll
            for (int o = 1; o < 64; o <<= 1) { mq = fmaxf(mq, __shfl_xor(mq, o)); mk = fmaxf(mk, __shfl_xor(mk, o)); dq = fmaxf(dq, __shfl_xor(dq, o)); dk = fmaxf(dk, __shfl_xor(dk, o)); }
            if (l == 0) { float* L = (float*)(F.ws + WS_LAM) + li * 4; L[2] = 64.f * mq * mk * C2Q; L[3] = 64.f * dq * dk * C2Q; }
        }
    }
    { const f32x4* s = (const f32x4*)F.in[I_CTX]; f32x4* d = (f32x4*)(F.ws + WS_XC); const int n4 = NB * CTXL * DM / 4;
      for (int i = F.bx * 512 + F.tid; i < n4; i += F.G * 512) d[i] = s[i]; }
}

DI void transpose_item(const float* W, int ldw, int k0, int n0, bf16* WT, int ldd, int drow0, LAS float* scr, int lane) {
#pragma unroll 8
    for (int i = 0; i < 32; ++i) { const int kk = 2 * i + (lane >> 5); scr[kk * 33 + (lane & 31)] = W[(size_t)(k0 + kk) * ldw + n0 + (lane & 31)]; }
    LDS_WAIT(); asm volatile("" ::: "memory");
    const int c = lane & 7;
#pragma unroll
    for (int j = 0; j < 4; ++j) { const int n = (lane >> 3) + 8 * j; const LAS float* s = scr + (8 * c) * 33 + n;
        v4u o; o.x = pk2(s[0 * 33], s[1 * 33]); o.y = pk2(s[2 * 33], s[3 * 33]); o.z = pk2(s[4 * 33], s[5 * 33]); o.w = pk2(s[6 * 33], s[7 * 33]);
        *(v4u*)(WT + (size_t)(drow0 + n) * ldd + k0 + 8 * c) = o; }
    LDS_WAIT(); asm volatile("" ::: "memory");
}
DI void phase_wx(const Frame& F, int li) {
    LAS float* scr = (LAS float*)(F.lds + F.wave * 16384);
    unsigned char* wm = F.ws + WS_WMIX; unsigned char* we = F.ws + WS_WEXP;
    constexpr int I_IN = 16 * 136, I_G = 3 * 16 * 32, I_B = 3 * 8 * 32, I_O = 16 * 32, I_E = 16 * 16 * 32;
    constexpr int NITEMS = I_IN + I_G + I_B + I_O + 3 * I_E;
    for (int it = F.gw; it < NITEMS; it += F.NGW) {
        int r = it;
        if (r < I_IN) { const int kb = r / 136, nb = r % 136, n0 = nb * 32, pn = n0 >> 8, wi = n0 & 255, wc = wi >> 6, bj = (wi >> 5) & 1;
            transpose_item(F.in[I_WIN] + (size_t)li * 1024 * INCOLS, INCOLS, kb * 64, n0, (bf16*)(wm + WM_WIN), 1024, pn * 256 + bj * 128 + wc * 32, scr, F.lane); continue; } r -= I_IN;
        if (r < I_G) { const int i = r / 512, q = r % 512, kb = q / 32, nb = q % 32;
            transpose_item(F.in[I_WMG] + ((size_t)li * 3 + i) * 1024 * 1024, 1024, kb * 64, nb * 32, (bf16*)(wm + WM_WG), 1024, i * 1024 + nb * 32, scr, F.lane); continue; } r -= I_G;
        if (r < I_B) { const int i = r / 256, q = r % 256, kb = q / 32, nb = q % 32;
            transpose_item(F.in[I_WBR] + ((size_t)li * 3 + i) * 512 * 1024, 1024, kb * 64, nb * 32, (bf16*)(wm + WM_WB) + (size_t)i * 1024 * 512, 512, nb * 32, scr, F.lane); continue; } r -= I_B;
        if (r < I_O) { const int kb = r / 32, nb = r % 32;
            transpose_item(F.in[I_WOUT] + (size_t)li * 1024 * 1024, 1024, kb * 64, nb * 32, (bf16*)(wm + WM_WO), 1024, nb * 32, scr, F.lane); continue; } r -= I_O;
        { const int which = r / I_E, q = r % I_E, e = q / 512, q2 = q % 512, kb = q2 / 32, nb = q2 % 32, n0 = nb * 32;
          const size_t eo = ((size_t)li * NEXP + e) * 1024 * 1024;
          if (which == 0)      transpose_item(F.in[I_WEG] + eo, 1024, kb * 64, n0, (bf16*)(we + WE_GU) + (size_t)e * 2048 * 1024, 1024, (n0 >> 7) * 256 + (n0 & 127), scr, F.lane);
          else if (which == 1) transpose_item(F.in[I_WEU] + eo, 1024, kb * 64, n0, (bf16*)(we + WE_GU) + (size_t)e * 2048 * 1024, 1024, (n0 >> 7) * 256 + 128 + (n0 & 127), scr, F.lane);
          else                 transpose_item(F.in[I_WED] + eo, 1024, kb * 64, n0, (bf16*)(we + WE_D) + (size_t)e * 1024 * 1024, 1024, n0, scr, F.lane); }
    }
}

template <int WHICH> DI void phase_norm(const Frame& F, int li) {
    const float* nw = F.in[WHICH == 0 ? I_N1W : I_N2W] + li * 1024; const float* mv = modv_of(F, li);
    const float* xl = lat_x(F, li); const float* xc = ctx_x(F, li);
    const bf16* YO = (const bf16*)(F.ws + WS_G);
    bf16* H = (bf16*)(F.ws + WS_H);
    f32x4 nwv[4];
#pragma unroll
    for (int j = 0; j < 4; ++j) nwv[j] = *(const f32x4*)(nw + 4 * F.lane + 256 * j);
    const float* g1b = mv + 2048 + 4 * F.lane;
#define NORM_ROWPTR(row_, b_, t_, lat_, xr_) const int b_ = (row_) / TPB, t_ = (row_) - b_ * TPB; const bool lat_ = t_ < SEQ; \
        const float* xr_ = (lat_ ? xl + ((size_t)b_ * SEQ + t_) * DM : xc + ((size_t)b_ * CTXL + (t_ - SEQ)) * DM) + 4 * F.lane;
    f32x4 s1v[4], s0v[4], g1v[4]; int mi_prev = -1;
    f32x4 vn[4]; v2u yn[4];
    if (F.gw < MROWS) { NORM_ROWPTR(F.gw, b_, t_, lat_, xr_);
#pragma unroll
        for (int j = 0; j < 4; ++j) { vn[j] = *(const f32x4*)(xr_ + 256 * j); if (WHICH == 1) yn[j] = *(const v2u*)(YO + (size_t)F.gw * DM + 4 * F.lane + 256 * j); } }
    for (int row = F.gw; row < MROWS; row += F.NGW) {
        const int b = row / TPB, t = row - b * TPB; const bool lat = t < SEQ; const int mi = lat ? b : 8;
        const float* sh = mv + mi * 6144 + (WHICH == 0 ? 0 : 3072); const float* sc = sh + 1024;
        f32x4 v[4]; v2u y[4];
#pragma unroll
        for (int j = 0; j < 4; ++j) { v[j] = vn[j]; if (WHICH == 1) y[j] = yn[j]; }
        { const int nrow = row + F.NGW;
          if (nrow < MROWS) { NORM_ROWPTR(nrow, b_, t_, lat_, xr_);
#pragma unroll
              for (int j = 0; j < 4; ++j) { vn[j] = *(const f32x4*)(xr_ + 256 * j); if (WHICH == 1) yn[j] = *(const v2u*)(YO + (size_t)nrow * DM + 4 * F.lane + 256 * j); } } }
        if (mi != mi_prev) { mi_prev = mi;
#pragma unroll
            for (int j = 0; j < 4; ++j) { s1v[j] = *(const f32x4*)(sc + 4 * F.lane + 256 * j); s0v[j] = *(const f32x4*)(sh + 4 * F.lane + 256 * j); if (WHICH == 1) g1v[j] = *(const f32x4*)(g1b + mi * 6144 + 256 * j); } }
        float ss = 0.f;
        if (WHICH == 1) {
            float* xo = (lat ? F.out + ((size_t)b * SEQ + t) * DM : (float*)(F.ws + WS_XC) + ((size_t)b * CTXL + (t - SEQ)) * DM) + 4 * F.lane;
#pragma unroll
            for (int j = 0; j < 4; ++j) { const f32x4 g1 = g1v[j];
                v[j][0] += g1[0] * bflo(y[j].x); v[j][1] += g1[1] * bfhi(y[j].x); v[j][2] += g1[2] * bflo(y[j].y); v[j][3] += g1[3] * bfhi(y[j].y);
                *(f32x4*)(xo + 256 * j) = v[j]; }
        }
#pragma unroll
        for (int j = 0; j < 4; ++j) ss += (v[j][0] * v[j][0] + v[j][1] * v[j][1]) + (v[j][2] * v[j][2] + v[j][3] * v[j][3]);
        const float rstd = rsqrtf(wave_sum(ss) * (1.f / DM) + EPSN);
#pragma unroll
        for (int j = 0; j < 4; ++j) {
            const f32x4 s1 = s1v[j] + 1.f, s0 = s0v[j];
            v[j] = (v[j] * rstd * nwv[j]) * s1 + s0;
            v2u o; o.x = pk2(v[j][0], v[j][1]); o.y = pk2(v[j][2], v[j][3]);
            *(v2u*)(H + (size_t)row * DM + 4 * F.lane + 256 * j) = o;
        }
    }
#undef NORM_ROWPTR
}

template <int WHICH> DI void phase_side(const Frame& F, int li, LAS unsigned char* lds_w) {
    LAS bf16* wh = (LAS bf16*)lds_w; LAS bf16* wlo = wh + 16 * 1032;
    { const float* W = WHICH == 0 ? F.in[I_WIN] + (size_t)li * 1024 * INCOLS + NPROJ : F.in[I_WRT] + (size_t)li * 1024 * 16; const int ldw = WHICH == 0 ? INCOLS : 16;
      for (int i = F.tid; i < 16384; i += 512) { const int k = i >> 4, j = i & 15; const float w = W[(size_t)k * ldw + j]; const unsigned hi = f2bf(w); const float rem = w - bf2f((unsigned short)hi);
          wh[j * 1032 + k] = (bf16)hi; wlo[j * 1032 + k] = (bf16)f2bf(rem); } }
    __syncthreads();
    const bf16* H = (const bf16*)(F.ws + WS_H);
    const int r = F.lane & 15, q = F.lane >> 4, e = r;
    const float dtb = (WHICH == 0 && e >= 8) ? F.in[I_DTB][li * 8 + (e - 8)] : 0.f, nal = (WHICH == 0 && e >= 8) ? -__expf(F.in[I_ALOG][li * 8 + (e - 8)]) : 0.f;
    const int nfull = (MROWS / 16) / F.NGW * F.NGW, ntail = MROWS - nfull * 16;
#define SIDE_HP(u_) (H + (size_t)((u_) < nfull ? (u_) * 16 + r : nfull * 16 + ((u_) - nfull)) * DM + 8 * q)
    bf16x8 fa[2][16];
    if (F.gw < nfull + ntail) { const bf16* hp0 = SIDE_HP(F.gw);
#pragma unroll
        for (int s2 = 0; s2 < 16; ++s2) fa[0][s2] = *(const bf16x8*)(hp0 + 32 * s2); }
    for (int u = F.gw; u < nfull + ntail; u += F.NGW) {
        const bool full = u < nfull; const int row0 = full ? u * 16 : nfull * 16 + (u - nfull);
        const bf16* hp = SIDE_HP(u);
        f32x4 acc = {0.f, 0.f, 0.f, 0.f};
#pragma unroll
        for (int hb = 0; hb < 2; ++hb) {
            if (hb == 0) {
#pragma unroll
                for (int s2 = 0; s2 < 16; ++s2) fa[1][s2] = *(const bf16x8*)(hp + 32 * (16 + s2));
            } else if (u + F.NGW < nfull + ntail) { const bf16* hpn = SIDE_HP(u + F.NGW);
#pragma unroll
                for (int s2 = 0; s2 < 16; ++s2) fa[0][s2] = *(const bf16x8*)(hpn + 32 * s2);
            }
            __builtin_amdgcn_sched_barrier(0);
#pragma unroll
            for (int s2 = 0; s2 < 16; ++s2) { const int sk = 16 * hb + s2;
                const bf16x8 bh = *(const LAS bf16x8*)(wh + r * 1032 + 32 * sk + 8 * q), bl = *(const LAS bf16x8*)(wlo + r * 1032 + 32 * sk + 8 * q);
                acc = MFMA16(fa[hb][s2], bh, acc); acc = MFMA16(fa[hb][s2], bl, acc); }
            __builtin_amdgcn_sched_barrier(0);
        }
#pragma unroll
        for (int jj = 0; jj < 4; ++jj) {
            const bool wr = full || (q == 0 && jj == 0); const int row = full ? row0 + 4 * q + jj : row0; const float val = acc[jj];
            if (WHICH == 0) { float o;
                if (e < 8) o = sigmoidf_(val);
                else { const float xx = val + dtb; const float ex = __expf(xx); const float sp = xx > 15.f ? xx : (xx < -15.f ? ex : __logf(1.f + ex)); o = nal * sp; }
                if (wr) ((float*)(F.ws + WS_GDNG))[(size_t)row * 16 + e] = o;
            } else {
                float m = val; m = fmaxf(m, __shfl_xor(m, 1)); m = fmaxf(m, __shfl_xor(m, 2)); m = fmaxf(m, __shfl_xor(m, 4)); m = fmaxf(m, __shfl_xor(m, 8));
                const float ex = __expf(val - m); const float p = ex / sum16(ex);
                const int b = row / TPB, t = row - b * TPB; float* A = (float*)(F.ws + WS_AFF);
                if (wr) { if (t < SEQ) A[((size_t)b * 16 + e) * SEQ + t] = p; else A[(size_t)NB * 16 * SEQ + ((size_t)b * 16 + e) * CTXL + (t - SEQ)] = p; }
            }
        }
    }
#undef SIDE_HP
}

DI void phase_cv(const Frame& F, int li) {
    const bf16* P = (const bf16*)(F.ws + WS_CPRE); bf16* O = (bf16*)(F.ws + WS_POST);
    const float* cw = F.in[I_CONVW] + (size_t)li * 3 * 1536;
    float w[3][3][8];
#pragma unroll
    for (int tp = 0; tp < 3; ++tp)
#pragma unroll
        for (int g = 0; g < 3; ++g) { const f32x4 a = *(const f32x4*)(cw + tp * 1536 + g * 512 + 8 * F.lane), b = *(const f32x4*)(cw + tp * 1536 + g * 512 + 8 * F.lane + 4);
#pragma unroll
            for (int e = 0; e < 4; ++e) { w[tp][g][e] = a[e]; w[tp][g][4 + e] = b[e]; } }
#define CV_LOAD(dst, row_) do { const int t_ = (row_) % TPB; const bool hp_ = (t_ != 0) && (t_ != SEQ), hn_ = (t_ != SEQ - 1) && (t_ != TPB - 1); \
        _Pragma("unroll") for (int g = 0; g < 3; ++g) _Pragma("unroll") for (int tp = 0; tp < 3; ++tp) { const bool ok = tp == 1 || (tp == 0 ? hp_ : hn_); dst[g][tp] = (v4u){0u, 0u, 0u, 0u}; \
            if (ok) dst[g][tp] = *(const v4u*)(P + (size_t)((row_) + tp - 1) * 1536 + g * 512 + 8 * F.lane); } } while (0)
    v4u xnx[3][3];
    if (F.gw < MROWS) CV_LOAD(xnx, F.gw);
    for (int row = F.gw; row < MROWS; row += F.NGW) {
        v4u xin[3][3];
#pragma unroll
        for (int g = 0; g < 3; ++g)
#pragma unroll
            for (int tp = 0; tp < 3; ++tp) xin[g][tp] = xnx[g][tp];
        if (row + F.NGW < MROWS) CV_LOAD(xnx, row + F.NGW);
#pragma unroll
        for (int g = 0; g < 3; ++g) {
            float a[8];
#pragma unroll
            for (int e = 0; e < 8; ++e) a[e] = 0.f;
#pragma unroll
            for (int tp = 0; tp < 3; ++tp) { const v4u x = xin[g][tp];
                a[0] += w[tp][g][0] * bflo(x.x); a[1] += w[tp][g][1] * bfhi(x.x); a[2] += w[tp][g][2] * bflo(x.y); a[3] += w[tp][g][3] * bfhi(x.y);
                a[4] += w[tp][g][4] * bflo(x.z); a[5] += w[tp][g][5] * bfhi(x.z); a[6] += w[tp][g][6] * bflo(x.w); a[7] += w[tp][g][7] * bfhi(x.w);
            }
            float ss = 0.f;
#pragma unroll
            for (int e = 0; e < 8; ++e) { a[e] = siluf_(a[e]); ss += a[e] * a[e]; }
            if (g < 2) { ss = sum16(ss); const float r = rsqrtf(ss + EPSN) * (g == 0 ? 0.08838834764831845f : 1.f);
#pragma unroll
                for (int e = 0; e < 8; ++e) a[e] *= r; }
            v4u o; o.x = pk2(a[0], a[1]); o.y = pk2(a[2], a[3]); o.z = pk2(a[4], a[5]); o.w = pk2(a[6], a[7]);
            *(v4u*)(O + (size_t)row * 1536 + g * 512 + 8 * F.lane) = o;
        }
    }
#undef CV_LOAD
}

DI void phase_gf(const Frame& F, int li) {
    const bf16* O0 = (const bf16*)(F.ws + WS_CPRE); const bf16* O1 = O0 + (size_t)MROWS * 512; const bf16* Z = (const bf16*)(F.ws + WS_Z); bf16* Y = (bf16*)(F.ws + WS_YG);
    const float* gw = F.in[I_GNW] + li * 128 + 8 * (F.lane & 15);
    const f32x4 w0 = *(const f32x4*)gw, w1 = *(const f32x4*)(gw + 4);
    v4u na = {0u, 0u, 0u, 0u}, nb = na, nz = na;
    if (F.gw < MROWS) { const size_t o = (size_t)F.gw * 512 + 8 * F.lane; na = *(const v4u*)(O0 + o); nb = *(const v4u*)(O1 + o); nz = *(const v4u*)(Z + o); }
    for (int row = F.gw; row < MROWS; row += F.NGW) {
        const size_t o = (size_t)row * 512 + 8 * F.lane;
        const v4u a = na, b = nb, z = nz;
        if (row + F.NGW < MROWS) { const size_t o2 = (size_t)(row + F.NGW) * 512 + 8 * F.lane; na = *(const v4u*)(O0 + o2); nb = *(const v4u*)(O1 + o2); nz = *(const v4u*)(Z + o2); }
        float v[8] = {bflo(a.x) + bflo(b.x), bfhi(a.x) + bfhi(b.x), bflo(a.y) + bflo(b.y), bfhi(a.y) + bfhi(b.y), bflo(a.z) + bflo(b.z), bfhi(a.z) + bfhi(b.z), bflo(a.w) + bflo(b.w), bfhi(a.w) + bfhi(b.w)};
        const float zz[8] = {bflo(z.x), bfhi(z.x), bflo(z.y), bfhi(z.y), bflo(z.z), bfhi(z.z), bflo(z.w), bfhi(z.w)};
        float ss = 0.f;
#pragma unroll
        for (int e = 0; e < 8; ++e) ss += v[e] * v[e];
        const float r = rsqrtf(sum16(ss) * (1.f / 128.f) + EPSN);
#pragma unroll
        for (int e = 0; e < 8; ++e) v[e] = v[e] * r * (e < 4 ? w0[e] : w1[e - 4]) * siluf_(zz[e]);
        v4u ov; ov.x = pk2(v[0], v[1]); ov.y = pk2(v[2], v[3]); ov.z = pk2(v[4], v[5]); ov.w = pk2(v[6], v[7]);
        *(v4u*)(Y + o) = ov;
    }
}

DI void phase_bf(const Frame& F, int li) {
    const bf16* OB = (const bf16*)(F.ws + WS_OB); bf16* Y = (bf16*)(F.ws + WS_YB);
    const float lam = ((const float*)(F.ws + WS_LAM))[li * 4], oml = ((const float*)(F.ws + WS_LAM))[li * 4 + 1];
    const float* sw = F.in[I_SUBLN] + li * 128 + 8 * (F.lane & 15);
    const f32x4 w0 = *(const f32x4*)sw, w1 = *(const f32x4*)(sw + 4);
    const int h = F.lane >> 4, e0 = (F.lane & 15) * 8;
    v4u na = {0u, 0u, 0u, 0u}, nb = na;
    if (F.gw < MROWS) { const bf16* p = OB + (size_t)F.gw * 1024 + h * 256 + e0; na = *(const v4u*)p; nb = *(const v4u*)(p + 128); }
    for (int row = F.gw; row < MROWS; row += F.NGW) {
        const v4u a = na, b = nb;
        if (row + F.NGW < MROWS) { const bf16* p = OB + (size_t)(row + F.NGW) * 1024 + h * 256 + e0; na = *(const v4u*)p; nb = *(const v4u*)(p + 128); }
        float v[8] = {bflo(a.x) - lam * bflo(b.x), bfhi(a.x) - lam * bfhi(b.x), bflo(a.y) - lam * bflo(b.y), bfhi(a.y) - lam * bfhi(b.y),
                      bflo(a.z) - lam * bflo(b.z), bfhi(a.z) - lam * bfhi(b.z), bflo(a.w) - lam * bflo(b.w), bfhi(a.w) - lam * bfhi(b.w)};
        float ss = 0.f;
#pragma unroll
        for (int e = 0; e < 8; ++e) ss += v[e] * v[e];
        const float r = rsqrtf(sum16(ss) * (1.f / 128.f) + EPSN) * oml;
#pragma unroll
        for (int e = 0; e < 8; ++e) v[e] = v[e] * r * (e < 4 ? w0[e] : w1[e - 4]);
        v4u ov; ov.x = pk2(v[0], v[1]); ov.y = pk2(v[2], v[3]); ov.z = pk2(v[4], v[5]); ov.w = pk2(v[6], v[7]);
        *(v4u*)(Y + (size_t)row * 512 + 8 * F.lane) = ov;
    }
}

DI void phase_ga(const Frame& F, int nslot) {
    const int* idx = (const int*)(F.ws + WS_IDX); const bf16* H = (const bf16*)(F.ws + WS_H); bf16* X = (bf16*)(F.ws + WS_XIN);
    for (int r0 = F.gw; r0 < nslot; r0 += 4 * F.NGW) {
        v4u a[4], b[4]; int src[4];
#pragma unroll
        for (int u = 0; u < 4; ++u) { const int r = r0 + u * F.NGW; src[u] = r < nslot ? __builtin_amdgcn_readfirstlane(idx[r]) : 0; }
#pragma unroll
        for (int u = 0; u < 4; ++u) { a[u] = *(const v4u*)(H + (size_t)src[u] * DM + 8 * F.lane); b[u] = *(const v4u*)(H + (size_t)src[u] * DM + 512 + 8 * F.lane); }
#pragma unroll
        for (int u = 0; u < 4; ++u) { const int r = r0 + u * F.NGW; if (r < nslot) { *(v4u*)(X + (size_t)r * DM + 8 * F.lane) = a[u]; *(v4u*)(X + (size_t)r * DM + 512 + 8 * F.lane) = b[u]; } }
    }
}

DI void phase_cb(const Frame& F, int li) {
    const int* inv = (const int*)(F.ws + WS_INV); const bf16* Y = (const bf16*)(F.ws + WS_XIN);
    const bool last = li == NLAYER - 1;
#define CB_ROW(row_, b_, t_, lat_, xr_) const int b_ = (row_) / TPB, t_ = (row_) - b_ * TPB; const bool lat_ = t_ < SEQ; \
        float* xr_ = (lat_ ? F.out + ((size_t)b_ * SEQ + t_) * DM : (float*)(F.ws + WS_XC) + ((size_t)b_ * CTXL + (t_ - SEQ)) * DM) + 4 * F.lane;
    f32x4 vn[4]; int invn = -1;
    if (F.gw < MROWS) { CB_ROW(F.gw, b_, t_, lat_, xr_);
#pragma unroll
        for (int j = 0; j < 4; ++j) vn[j] = *(const f32x4*)(xr_ + 256 * j);
        if (F.lane < NEXP) invn = inv[((size_t)b_ * NEXP + F.lane) * TPB + t_]; }
    for (int row = F.gw; row < MROWS; row += F.NGW) {
        CB_ROW(row, b, t, lat, xr);
        f32x4 v[4]; int myinv = invn;
#pragma unroll
        for (int j = 0; j < 4; ++j) v[j] = vn[j];
        { const int nrow = row + F.NGW; invn = -1;
          if (nrow < MROWS) { CB_ROW(nrow, b_, t_, lat_, xr_);
#pragma unroll
              for (int j = 0; j < 4; ++j) vn[j] = *(const f32x4*)(xr_ + 256 * j);
              if (F.lane < NEXP) invn = inv[((size_t)b_ * NEXP + F.lane) * TPB + t_]; } }
        if (!lat && last) continue;
        unsigned long long m = __ballot(myinv >= 0);
        while (m) {
            const int e0 = __ffsll((long long)m) - 1; m &= m - 1;
            const int s0 = __builtin_amdgcn_readlane(myinv, e0);
            int s1 = -1; if (m) { const int e1 = __ffsll((long long)m) - 1; m &= m - 1; s1 = __builtin_amdgcn_readlane(myinv, e1); }
            v2u y0[4], y1[4];
#pragma unroll
            for (int j = 0; j < 4; ++j) y0[j] = *(const v2u*)(Y + (size_t)s0 * DM + 4 * F.lane + 256 * j);
            if (s1 >= 0) {
#pragma unroll
                for (int j = 0; j < 4; ++j) y1[j] = *(const v2u*)(Y + (size_t)s1 * DM + 4 * F.lane + 256 * j);
            } else {
#pragma unroll
                for (int j = 0; j < 4; ++j) y1[j] = (v2u){0u, 0u};
            }
#pragma unroll
            for (int j = 0; j < 4; ++j) { v[j][0] += bflo(y0[j].x); v[j][1] += bfhi(y0[j].x); v[j][2] += bflo(y0[j].y); v[j][3] += bfhi(y0[j].y); }
#pragma unroll
            for (int j = 0; j < 4; ++j) { v[j][0] += bflo(y1[j].x); v[j][1] += bfhi(y1[j].x); v[j][2] += bflo(y1[j].y); v[j][3] += bfhi(y1[j].y); }
        }
#pragma unroll
        for (int j = 0; j < 4; ++j) *(f32x4*)(xr + 256 * j) = v[j];
    }
#undef CB_ROW
}
typedef float f32x16 __attribute__((ext_vector_type(16)));
DI int crow32(int r, int hi) { return (r & 3) + 8 * (r >> 2) + 4 * hi; }

DI void phase_cl(const Frame& F) {
    LAS float* Am = (LAS float*)(F.lds + F.wave * 16384);
    LAS float* gcv = (LAS float*)(F.lds + LDS_XTRA + F.wave * 512);
    LAS float* btv = gcv + 64;
    const bf16* P = (const bf16*)(F.ws + WS_POST); const float* GG = (const float*)(F.ws + WS_GDNG);
    const int L = F.lane, r = L & 31, hh = L >> 5;
    for (int unit = F.gw; unit < NB * NCHUNK * 8; unit += F.NGW) {
        const int dir = unit & 1, h = (unit >> 1) & 3, bc = unit >> 3; const size_t row0 = (size_t)bc * 64;
        unsigned char* tq = F.ws + WS_TQ + (size_t)unit * 16384; float* gcb = (float*)(F.ws + WS_GCB) + (size_t)unit * 128;
        const int io = dir ? 63 - L : L;
        const float g = GG[(row0 + io) * 16 + 8 + dir * 4 + h], beta = GG[(row0 + io) * 16 + dir * 4 + h];
        float gc = g;
#pragma unroll
        for (int o = 1; o < 64; o <<= 1) { const float t = __shfl_up(gc, o); if (L >= o) gc += t; }
        gcv[L] = gc; btv[L] = beta; gcb[io] = gc; gcb[64 + io] = beta;
        bf16x8 kf[2][8], qf[2][8];
#pragma unroll
        for (int rb = 0; rb < 2; ++rb) { const int ir = 32 * rb + r, orr = dir ? 63 - ir : ir; const bf16* pr = P + (row0 + orr) * 1536 + h * 128 + 8 * hh;
#pragma unroll
            for (int s = 0; s < 8; ++s) { kf[rb][s] = *(const bf16x8*)(pr + 512 + 16 * s); qf[rb][s] = *(const bf16x8*)(pr + 16 * s); } }
        LDS_WAIT();
        LAS float* Amb = Am + hh * 256 + r; const LAS float* gch = gcv + 4 * hh; const LAS float* bth = btv + 4 * hh; const LAS float* gcr = gcv + r;
#pragma unroll
        for (int tt = 0; tt < 3; ++tt) { const int ta = tt == 1 ? 0 : 1, tb = tt == 2 ? 1 : 0;
            f32x16 x = {};
#pragma unroll
            for (int s = 0; s < 8; ++s) x = MFMA32(kf[ta][s], kf[tb][s], x);
            const float gcj = gcr[32 * tb];
#pragma unroll
            for (int q = 0; q < 16; ++q) { const int ci = 32 * ta + (q & 3) + 8 * (q >> 2); Amb[ci * 64 + 32 * tb] = bth[ci] * x[q] * __expf(fminf(gch[ci] - gcj, 0.f)); }
            asm volatile("" ::: "memory"); }
        const int sg = dir ? -1 : 1;
        bf16* qkb = (bf16*)(tq + 8192) + (dir ? (63 - 4 * hh) * 64 + (63 - r) : 4 * hh * 64 + r);
#pragma unroll
        for (int tt = 0; tt < 4; ++tt) { const int ta = tt >> 1, tb = tt & 1;
            f32x16 x = {};
            if (!(ta == 0 && tb == 1)) {
#pragma unroll
                for (int s = 0; s < 8; ++s) x = MFMA32(qf[ta][s], kf[tb][s], x);
            }
            const float gcj = gcr[32 * tb]; const int jj = 32 * tb + r;
#pragma unroll
            for (int q = 0; q < 16; ++q) { const int ci = 32 * ta + (q & 3) + 8 * (q >> 2);
                const float val = jj <= ci + 4 * hh ? x[q] * __expf(gch[ci] - gcj) : 0.f; qkb[sg * (ci * 64 + 32 * tb)] = (bf16)f2bf(val); }
            asm volatile("" ::: "memory"); }
        LDS_WAIT(); asm volatile("" ::: "memory");
        float T[64];
#pragma unroll
        for (int i = 0; i < 64; ++i) {
            f32x4 rb[16];
#pragma unroll
            for (int j4 = 0; j4 < (i + 3) / 4; ++j4) rb[j4] = *(const LAS f32x4*)(Am + i * 64 + 4 * j4);
            asm volatile("s_waitcnt lgkmcnt(0)" ::: "memory");
            float a4[4] = {(i == L) ? 1.f : 0.f, 0.f, 0.f, 0.f};
#pragma unroll
            for (int j4 = 0; j4 < (i + 3) / 4; ++j4) {
#pragma unroll
                for (int e = 0; e < 4; ++e) if (4 * j4 + e < i) a4[e] -= rb[j4][e] * T[4 * j4 + e]; }
            T[i] = (a4[0] + a4[1]) + (a4[2] + a4[3]);
        }
        bf16* tpb = (bf16*)tq + (dir ? 63 * 64 + 63 - L : L);
#pragma unroll
        for (int i = 0; i < 64; ++i) tpb[sg * (i * 64)] = (bf16)f2bf(T[i]);
        LDS_WAIT(); asm volatile("" ::: "memory");
    }
}

constexpr int SC_KR = 0, SC_KT = 17408, SC_QR = 35840, SC_VR = 53248, SC_TR = 58368, SC_QK = 67584, SC_VEC = 76800, SC_ST = 77824, SC_RT = 86528, SC_VN = 91136, SC_VS = 95744, SC_END = 100352;
DI v2u pack4(float a, float b, float c, float d) { v2u w; w.x = pk2(a, b); w.y = pk2(c, d); return w; }
DI void phase_sc(const Frame& F) {
    LAS unsigned char* S = F.lds;
    const bf16* P = (const bf16*)(F.ws + WS_POST); bf16* OD = (bf16*)(F.ws + WS_CPRE);
    const int tid = F.tid, w = F.wave, l15 = F.lane & 15, quad = F.lane >> 4;
    for (int unit = F.vcu; unit < 256; unit += F.G) {
        const int sl = unit & 3, dir = (unit >> 2) & 1, h = (unit >> 3) & 3, b = unit >> 5;
        __syncthreads();
        for (int i = tid; i < 8704 / 4; i += 512) ((LAS unsigned*)(S + SC_ST))[i] = 0u;
        f32x4 Sacc[2] = {{0.f, 0.f, 0.f, 0.f}, {0.f, 0.f, 0.f, 0.f}};
        v4u rk[2][2], qfr[2][4], rv[2], rt[2], rqk[2], rvec[2];
        const int last_i = dir ? 0 : 63;
#define SC_CHUNK(n) ((n) < 4 ? (dir ? 131 - (n) : 128 + (n)) : (dir ? 131 - (n) : (n) - 4))
#define SC_LOAD(n, Q) do { const int ch_ = SC_CHUNK(n); const size_t r0_ = ((size_t)b * NCHUNK + ch_) * 64; const size_t u_ = ((((size_t)b * NCHUNK + ch_) * 4 + h) * 2 + dir); \
        _Pragma("unroll") for (int i_ = 0; i_ < 2; ++i_) { const int v_ = tid + 512 * i_, rr_ = v_ >> 4, c_ = v_ & 15; const bf16* p_ = P + (r0_ + rr_) * 1536 + h * 128 + c_ * 8; rk[Q][i_] = *(const v4u*)(p_ + 512); } \
        if (tid < 256) rv[Q] = *(const v4u*)(P + (r0_ + (tid >> 2)) * 1536 + 1024 + h * 128 + sl * 32 + (tid & 3) * 8); \
        rt[Q] = *(const v4u*)(F.ws + WS_TQ + u_ * 16384 + (size_t)tid * 16); rqk[Q] = *(const v4u*)(F.ws + WS_TQ + u_ * 16384 + 8192 + (size_t)tid * 16); \
        if (tid < 32) rvec[Q] = *(const v4u*)((const float*)(F.ws + WS_GCB) + u_ * 128 + tid * 4); } while (0)
#define SC_WRITE(Q) do { \
        _Pragma("unroll") for (int i_ = 0; i_ < 2; ++i_) { const int v_ = tid + 512 * i_, rr_ = v_ >> 4, c_ = v_ & 15; \
            *(LAS v4u*)(S + SC_KR + rr_ * 272 + c_ * 16) = rk[Q][i_]; } \
        if (tid < 256) *(LAS v4u*)(S + SC_VR + (tid >> 2) * 80 + (tid & 3) * 16) = rv[Q]; \
        *(LAS v4u*)(S + SC_TR + (tid >> 3) * 144 + (tid & 7) * 16) = rt[Q]; *(LAS v4u*)(S + SC_QK + (tid >> 3) * 144 + (tid & 7) * 16) = rqk[Q]; \
        if (tid < 32) *(LAS v4u*)(S + SC_VEC + tid * 16) = rvec[Q]; } while (0)
        const int ttq = w >> 1;
#define SC_LDQ(n, Q) do { const bf16* p_ = P + (((size_t)b * NCHUNK + SC_CHUNK(n)) * 64 + 16 * ttq + l15) * 1536 + h * 128 + 8 * quad; _Pragma("unroll") for (int s_ = 0; s_ < 4; ++s_) qfr[Q][s_] = *(const v4u*)(p_ + 32 * s_); } while (0)
        SC_LOAD(0, 0); SC_LDQ(0, 0); VM_WAIT(); SC_WRITE(0); SC_LOAD(1, 1); SC_LDQ(1, 1); LDS_WAIT(); __syncthreads();
        const LAS float* gcs = (const LAS float*)(S + SC_VEC); const LAS float* bts = gcs + 64;
        for (int n2 = 0; n2 < NCHUNK; n2 += 2) {
#pragma unroll
          for (int QS = 0; QS < 2; ++QS) { const int n = n2 + QS;
            if (n + 2 < NCHUNK) SC_LOAD(n + 2, QS);
            const size_t row0 = ((size_t)b * NCHUNK + SC_CHUNK(n)) * 64;
            const float gcl = gcs[last_i];
            const int tr = w >> 1, tc = w & 1, dvt = w & 1, tt = w >> 1;
            f32x4 ks = {0.f, 0.f, 0.f, 0.f}, os = {0.f, 0.f, 0.f, 0.f};
            { bf16x8 fa[4], fb[4], gb[4];
#pragma unroll
              for (int s = 0; s < 4; ++s) { fa[s] = *(const LAS bf16x8*)(S + SC_KR + (16 * tr + l15) * 272 + (32 * s + 8 * quad) * 2); fb[s] = *(const LAS bf16x8*)(S + SC_ST + (16 * tc + l15) * 272 + (32 * s + 8 * quad) * 2);
                  gb[s] = __builtin_bit_cast(bf16x8, qfr[QS][s]); }
              __builtin_amdgcn_sched_barrier(0);
#pragma unroll
              for (int s = 0; s < 4; ++s) { ks = MFMA16(fa[s], fb[s], ks); os = MFMA16(fb[s], gb[s], os); }
              __builtin_amdgcn_sched_barrier(0); }
            if (n + 2 < NCHUNK) SC_LDQ(n + 2, QS);
            { float rr[4];
#pragma unroll
              for (int jj = 0; jj < 4; ++jj) { const int tok = 16 * tr + 4 * quad + jj; const float vv = bf2f(*(const LAS unsigned short*)(S + SC_VR + tok * 80 + (16 * tc + l15) * 2));
                  rr[jj] = bts[tok] * (vv - __expf(gcs[tok]) * ks[jj]); }
              *(LAS v2u*)(S + SC_RT + (16 * tc + l15) * 144 + (16 * tr + 4 * quad) * 2) = pack4(rr[0], rr[1], rr[2], rr[3]); }
            LDS_WAIT(); __syncthreads();
            f32x4 vn = {0.f, 0.f, 0.f, 0.f};
            { bf16x8 fa[2], fb[2];
#pragma unroll
              for (int s = 0; s < 2; ++s) { fa[s] = *(const LAS bf16x8*)(S + SC_TR + (16 * tr + l15) * 144 + (32 * s + 8 * quad) * 2); fb[s] = *(const LAS bf16x8*)(S + SC_RT + (16 * tc + l15) * 144 + (32 * s + 8 * quad) * 2); }
              __builtin_amdgcn_sched_barrier(0);
#pragma unroll
              for (int s = 0; s < 2; ++s) vn = MFMA16(fa[s], fb[s], vn);
              __builtin_amdgcn_sched_barrier(0); }
            { float sc[4];
#pragma unroll
              for (int jj = 0; jj < 4; ++jj) sc[jj] = vn[jj] * __expf(gcl - gcs[16 * tr + 4 * quad + jj]);
              *(LAS v2u*)(S + SC_VN + (16 * tc + l15) * 144 + (16 * tr + 4 * quad) * 2) = pack4(vn[0], vn[1], vn[2], vn[3]);
              *(LAS v2u*)(S + SC_VS + (16 * tc + l15) * 144 + (16 * tr + 4 * quad) * 2) = pack4(sc[0], sc[1], sc[2], sc[3]); }
            LDS_WAIT(); __syncthreads();
            { const float eg = __expf(gcs[16 * tt + l15]); f32x4 oa = os * eg;
              bf16x8 fa[2], fb[2];
#pragma unroll
              for (int s = 0; s < 2; ++s) { fa[s] = *(const LAS bf16x8*)(S + SC_VN + (16 * dvt + l15) * 144 + (32 * s + 8 * quad) * 2); fb[s] = *(const LAS bf16x8*)(S + SC_QK + (16 * tt + l15) * 144 + (32 * s + 8 * quad) * 2); }
              __builtin_amdgcn_sched_barrier(0);
#pragma unroll
              for (int s = 0; s < 2; ++s) oa = MFMA16(fa[s], fb[s], oa);
              *(v2u*)(OD + ((size_t)dir * MROWS + row0 + 16 * tt + l15) * 512 + h * 128 + sl * 32 + 16 * dvt + 4 * quad) = pack4(oa[0], oa[1], oa[2], oa[3]); }
            { const float gl = __expf(gcl); bf16x8 a[2];
#pragma unroll
              for (int s = 0; s < 2; ++s) {
                  typedef short v4i16_t __attribute__((ext_vector_type(4)));
                  const LAS unsigned char* tp = S + SC_KR + (32 * s + 8 * quad + (l15 >> 2)) * 272 + (16 * w + 4 * (l15 & 3)) * 2;
                  const v4i16_t lo = __builtin_amdgcn_ds_read_tr16_b64_v4i16((LAS v4i16_t*)tp), hi = __builtin_amdgcn_ds_read_tr16_b64_v4i16((LAS v4i16_t*)(tp + 4 * 272));
                  a[s] = (bf16x8){lo[0], lo[1], lo[2], lo[3], hi[0], hi[1], hi[2], hi[3]}; }
              bf16x8 vb[2][2];
#pragma unroll
              for (int d = 0; d < 2; ++d)
#pragma unroll
                  for (int s = 0; s < 2; ++s) vb[d][s] = *(const LAS bf16x8*)(S + SC_VS + (16 * d + l15) * 144 + (32 * s + 8 * quad) * 2);
              __builtin_amdgcn_sched_barrier(0);
#pragma unroll
              for (int d = 0; d < 2; ++d) { f32x4 acc = Sacc[d] * gl;
#pragma unroll
                  for (int s = 0; s < 2; ++s) acc = MFMA16(a[s], vb[d][s], acc);
                  Sacc[d] = acc; *(LAS v2u*)(S + SC_ST + (16 * d + l15) * 272 + (16 * w + 4 * quad) * 2) = pack4(acc[0], acc[1], acc[2], acc[3]); } }
            LDS_WAIT(); __syncthreads();
            if (n + 1 < NCHUNK) SC_WRITE(1 - QS);
            LDS_WAIT(); __syncthreads();
                  }
        }
#undef SC_LOAD
#undef SC_WRITE
#undef SC_LDQ
#undef SC_CHUNK
    }
}

template <int N, int K> DI void topk_unit(const Frame& F, const float* aff, int slot_base, int row_base, int inv_base) {
    constexpr int EPT = N >= 512 ? N / 512 : 1;
    LAS unsigned* hist = (LAS unsigned*)F.lds;
    LAS unsigned* ctl = hist + 256;
    LAS unsigned* wsum = ctl + 8;
    LAS unsigned* keys = hist + 1024;
    const int tid = F.tid; const bool act = tid * EPT < N;
    if (act) {
#pragma unroll 4
        for (int e = 0; e < EPT; ++e) keys[e * 512 + tid] = __builtin_bit_cast(unsigned, aff[tid * EPT + e]);
    }
    unsigned prefix = 0u, kk = K;
    for (int pass = 0; pass < 4; ++pass) {
        const int shift = 24 - 8 * pass; const unsigned himask = pass == 0 ? 0u : (0xffffffffu << (shift + 8));
        if (tid < 256) hist[tid] = 0u;
        __syncthreads();
        if (act) {
#pragma unroll 4
            for (int e = 0; e < EPT; ++e) { const unsigned key = keys[e * 512 + tid]; if ((key & himask) == prefix) __hip_atomic_fetch_add(&hist[(key >> shift) & 255u], 1u, __ATOMIC_RELAXED, __HIP_MEMORY_SCOPE_WORKGROUP); }
        }
        __syncthreads();
        if (F.wave == 0) {
            const int l = F.lane; const unsigned h0 = hist[4 * l], h1 = hist[4 * l + 1], h2 = hist[4 * l + 2], h3 = hist[4 * l + 3];
            const unsigned mine = h0 + h1 + h2 + h3; unsigned above = mine;
#pragma unroll
            for (int o = 1; o < 64; o <<= 1) { const unsigned t = __shfl_down(above, o); if (l + o < 64) above += t; }
            const unsigned excl = above - mine;
            if (excl < kk && kk <= above) {
                unsigned c = excl, d;
                if (kk <= c + h3) { d = 3; } else { c += h3; if (kk <= c + h2) { d = 2; } else { c += h2; if (kk <= c + h1) { d = 1; } else { c += h1; d = 0; } } }
                ctl[0] = prefix | ((unsigned)(4 * l + d) << shift); ctl[1] = kk - c;
            }
        }
        __syncthreads();
        prefix = ctl[0]; kk = ctl[1];
        __syncthreads();
    }
    const unsigned thr = prefix;
    unsigned ngt = 0, neq = 0;
    if (act) {
#pragma unroll 4
        for (int e = 0; e < EPT; ++e) { const unsigned key = keys[e * 512 + tid]; ngt += key > thr ? 1u : 0u; neq += key == thr ? 1u : 0u; }
    }
    unsigned sg = ngt, se = neq;
#pragma unroll
    for (int o = 1; o < 64; o <<= 1) { const unsigned a = __shfl_up(sg, o), b = __shfl_up(se, o); if (F.lane >= o) { sg += a; se += b; } }
    if (F.lane == 63) { wsum[F.wave] = sg; wsum[8 + F.wave] = se; }
    __syncthreads();
    unsigned og = sg - ngt, oe = se - neq, totg = 0;
#pragma unroll
    for (int ww = 0; ww < 8; ++ww) { const unsigned a = wsum[ww], b = wsum[8 + ww]; if (ww < F.wave) { og += a; oe += b; } totg += a; }
    int* idx = (int*)(F.ws + WS_IDX); float* wgt = (float*)(F.ws + WS_WGT); int* inv = (int*)(F.ws + WS_INV);
    if (act) {
#pragma unroll 2
        for (int e = 0; e < EPT; ++e) {
            const unsigned key = keys[e * 512 + tid];
            const int t = tid * EPT + e; int slot = -1;
            if (key > thr) slot = (int)(og++);
            else if (key == thr) { if (oe < kk) slot = (int)(totg + oe); ++oe; }
            if (slot >= 0) { idx[slot_base + slot] = row_base + t; wgt[slot_base + slot] = __builtin_bit_cast(float, key); }
            inv[inv_base + t] = slot >= 0 ? slot_base + slot : -1;
        }
    }
    __syncthreads();
}
DI void phase_tk(const Frame& F, int nunits) {
    const float* A = (const float*)(F.ws + WS_AFF);
    for (int u = F.bx; u < nunits; u += F.G) {
        if (u < NB * NEXP) { const int b = u >> 4, e = u & 15; topk_unit<SEQ, CAP_L>(F, A + (size_t)u * SEQ, (e * 8 + b) * CAP_L, b * TPB, (b * NEXP + e) * TPB); }
        else { const int v = u - NB * NEXP, b = v >> 4, e = v & 15; topk_unit<CTXL, CAP_C>(F, A + (size_t)NB * NEXP * SEQ + (size_t)v * CTXL, NSLOT_L + e * 256 + b * CAP_C, b * TPB + SEQ, (b * NEXP + e) * TPB + SEQ); }
    }
}
DI void phase_at(const Frame& F, int li) {
    typedef attn_body::bf16 abf;
    const bool need_ctx = li != NLAYER - 1;
    unsigned char* ws = F.ws;
    const float* LB = (const float*)(ws + WS_LAM) + li * 4;
    const bool fastA = __builtin_amdgcn_readfirstlane((int)(LB[2] <= 60.f)), fastB = __builtin_amdgcn_readfirstlane((int)(LB[3] <= 60.f));
    for (int i = 0;; ++i) {
        const int L = i * F.G + F.vcu; if (L >= 17 * 256) break;
        const int step = L >> 8, slot = L & 255, b = slot >> 5, j = slot & 31;
        int kind, head, q0, krow0, NT;
        if (step < 8) { kind = 0; head = step; q0 = j * 256; krow0 = 0; NT = TPB / 64; }
        else if (step < 16) { kind = 1; head = step - 8; q0 = j * 256; krow0 = 0; NT = TPB / 64; }
        else { if (!need_ctx || j >= 16) continue; if (j < 8) { kind = 0; head = j; } else { kind = 1; head = j - 8; } q0 = SEQ; krow0 = SEQ; NT = CTXL / 64; }
        const size_t qrow = (size_t)b * TPB + q0, krow = (size_t)b * TPB + krow0;
        int tid_u = F.tid; asm volatile("" : "+v"(tid_u));
        if (kind == 0) {
            abf* Q = (abf*)(ws + WS_YA) + qrow * 512 + head * 64;
            const abf* K = (const abf*)(ws + WS_KA) + krow * 128 + (head >> 2) * 64; const abf* V = (const abf*)(ws + WS_VA) + krow * 128 + (head >> 2) * 64;
            if (fastA) attn_body::attn_unit<8, true>(Q, 512, K, 128, V, 128, Q, 512, NT, (char*)F.lds, tid_u);
            else attn_body::attn_unit<8, false>(Q, 512, K, 128, V, 128, Q, 512, NT, (char*)F.lds, tid_u);
        } else {
            const int sh = head;
            const abf* Q = (const abf*)(ws + WS_QB) + qrow * 512 + sh * 64;
            const abf* K = (const abf*)(ws + WS_KB) + krow * 512 + sh * 64; const abf* V = (const abf*)(ws + WS_VB) + krow * 512 + (sh >> 1) * 128;
            abf* O = (abf*)(ws + WS_OB) + qrow * 1024 + sh * 128;
            if (fastB) attn_body::attn_unit128<8, true>(Q, 512, K, 512, V, 512, O, 1024, NT, (char*)F.lds, tid_u);
            else attn_body::attn_unit128<8, false>(Q, 512, K, 512, V, 512, O, 1024, NT, (char*)F.lds, tid_u);
        }
    }
}
constexpr int NPH = 19;
struct Args { const float* in[N_IN]; float* out; unsigned char* ws; int ph_lo, ph_hi, bar_region, pad; };
constexpr int CW_TMO = 0, CW_BAR = 4096;

__global__ void __launch_bounds__(512, 2) __attribute__((amdgpu_waves_per_eu(2, 2))) fwd_kernel(Args args) {
    extern __shared__ __attribute__((aligned(16))) unsigned char lds[];
    Frame F;
    F.lds = (LAS unsigned char*)lds; F.MISC = (volatile LAS unsigned*)(F.lds + MISC_OFF);
    F.tid = threadIdx.x; F.lane = F.tid & 63; F.wave = __builtin_amdgcn_readfirstlane(F.tid >> 6);
    F.G = gridDim.x; { const int bx = blockIdx.x; F.vcu = (F.G % 8 == 0) ? (bx % 8) * (F.G / 8) + bx / 8 : bx; }
    F.gw = F.vcu * 8 + F.wave; F.NGW = F.G * 8; F.bx = blockIdx.x;
    F.in.p = (kin_ptr)__builtin_amdgcn_kernarg_segment_ptr();
    F.out = args.out; F.ws = args.ws; F.ctl = (gu32*)(args.ws + WS_CTL);
    for (int u = F.tid; u < (LDS_BYTES - LDSCTL_OFF) / 4; u += 512) ((LAS unsigned*)(F.lds + LDSCTL_OFF))[u] = 0u;
    __syncthreads();
#if MK_ONE_LAUNCH
    XcdBarrier bar = xcd_barrier_post((unsigned*)(F.ctl + CW_BAR) + args.bar_region * XCD_BAR_WORDS, F.MISC + 8);
#define GRID_BAR() xcd_barrier(bar)
#else
#define GRID_BAR() do {} while (0)
#endif
    const int lo = args.ph_lo, hi = args.ph_hi;
#ifndef PROBE_MASK
#define PROBE_MASK 0
#endif
#ifndef PROBE_MULT
#define PROBE_MULT 4
#endif
    unsigned long long pr_acc = 0ull, pr_t0 = 0ull; (void)pr_t0;
#define PR_BEGIN(k) do { if ((PROBE_MASK >> (k)) & 1) pr_t0 = __builtin_amdgcn_s_memrealtime(); } while (0)
#define PR_END(k) do { if ((PROBE_MASK >> (k)) & 1) pr_acc += __builtin_amdgcn_s_memrealtime() - pr_t0; } while (0)
#ifndef ONLY_PH
#define ONLY_PH -1
#endif
#define IN(k) ((ONLY_PH < 0 || ONLY_PH == ((k) % NPH)) && lo <= (k) && (k) < hi)
#define SEAM(k) do { if (IN(k) && IN((k) + 1)) GRID_BAR(); } while (0)
    for (int li = 0; li < NLAYER; ++li) {
        const int p0 = li * NPH;
        const int lastl = li == NLAYER - 1;
#define PHASE_FRAME() Frame P = F; { int t_ = threadIdx.x; asm volatile("" : "+v"(t_)); P.tid = t_; P.lane = t_ & 63; \
        int z_ = 0, v_ = F.vcu, G_ = F.G, b_ = F.bx; asm volatile("" : "+s"(z_), "+s"(v_), "+s"(G_), "+s"(b_));     \
        P.in.p = (kin_ptr)__builtin_amdgcn_kernarg_segment_ptr() + z_; P.ws = args.ws + z_; P.out = args.out + z_; P.vcu = v_; P.G = G_; P.bx = b_; P.wave = __builtin_amdgcn_readfirstlane(P.tid >> 6); P.gw = v_ * 8 + P.wave; P.NGW = G_ * 8; P.ctl = (gu32*)(P.ws + WS_CTL); } \
        unsigned char* ws = P.ws; unsigned char* wm = ws + WS_WMIX; unsigned char* we = ws + WS_WEXP; (void)wm; (void)we;
        PR_BEGIN(0); if (IN(p0 + 0)) { PHASE_FRAME(); if (li == 0) phase_p0(P); phase_wx(P, li); } SEAM(p0 + 0); PR_END(0);
        PR_BEGIN(1); if (IN(p0 + 1)) { PHASE_FRAME(); phase_norm<0>(P, li); } SEAM(p0 + 1); PR_END(1);
        PR_BEGIN(2); if (IN(p0 + 2)) { PHASE_FRAME();
            pg8::Gemm g{1024, 1024, 1024}; pg8::SchedMN S; S.init(ws + WS_H, 1024, wm + WM_WIN, 1024, MROWS / 256, 8, 9, P.G, P.bx);
            pg8::EpiInProj E{ws, P.in[I_GQN] + li * 64, P.in[I_GKN] + li * 64, P.in[I_DQN] + li * 64, P.in[I_DKN] + li * 64, (const float*)(ws + WS_ROPE)};
            pg8::gemm_phase<pg8::EpiInProj, pg8::SchedMN, true, true>(P.lds, g, S, E, P.tid);
        } SEAM(p0 + 2); PR_END(2);
        PR_BEGIN(3); if (IN(p0 + 3)) { PHASE_FRAME(); phase_side<0>(P, li, P.lds); phase_cv(P, li); } SEAM(p0 + 3); PR_END(3);
        PR_BEGIN(4); if (IN(p0 + 4)) { PHASE_FRAME(); phase_cl(P); } SEAM(p0 + 4); PR_END(4);
        PR_BEGIN(5); if (IN(p0 + 5)) { PHASE_FRAME(); phase_sc(P); } SEAM(p0 + 5); PR_END(5);
        PR_BEGIN(6); if (IN(p0 + 6)) { PHASE_FRAME(); phase_gf(P, li); } SEAM(p0 + 6); PR_END(6);
        PR_BEGIN(7); if (IN(p0 + 7)) { PHASE_FRAME();
            pg8::Gemm g{1024, 1024, 1024}; pg8::SchedMN S; S.init(ws + WS_H, 1024, wm + WM_WIN, 1024, MROWS / 256, 9, 0, P.G, P.bx);
            pg8::EpiInProj E{ws, P.in[I_GQN] + li * 64, P.in[I_GKN] + li * 64, P.in[I_DQN] + li * 64, P.in[I_DKN] + li * 64, (const float*)(ws + WS_ROPE)};
            pg8::gemm_phase<pg8::EpiInProj, pg8::SchedMN, true, true>(P.lds, g, S, E, P.tid);
        } SEAM(p0 + 7); PR_END(7);
        PR_BEGIN(8); if (IN(p0 + 8)) { PHASE_FRAME(); phase_at(P, li); } SEAM(p0 + 8); PR_END(8);
        PR_BEGIN(9); if (IN(p0 + 9)) { PHASE_FRAME(); phase_bf(P, li); } SEAM(p0 + 9); PR_END(9);
        PR_BEGIN(10); if (IN(p0 + 10)) { PHASE_FRAME();
            pg8::Gemm g{1024, 1024, 1024}; pg8::SchedMN S; S.init(ws + WS_H, 1024, wm + WM_WG, 1024, lastl ? NB * SEQ / 256 : MROWS / 256, 12, 0, P.G, P.bx); S.skipctx = lastl;
            pg8::EpiBf<0> E{(pg8::bf16_t*)(ws + WS_G), 3072, nullptr};
            pg8::gemm_phase<pg8::EpiBf<0>, pg8::SchedMN, true, true>(P.lds, g, S, E, P.tid);
        } SEAM(p0 + 10); PR_END(10);
        PR_BEGIN(11); if (IN(p0 + 11)) { PHASE_FRAME();
            pg8::Gemm g{512, 512, 512}; pg8::SchedMN S; S.init(ws + WS_YA, 512, wm + WM_WB, 512, lastl ? NB * SEQ / 256 : MROWS / 256, 4, 0, P.G, P.bx); S.skipctx = lastl;
            S.NZ = 3; S.a_z = 66 * MiB; S.b_z = (size_t)1024 * 512 * 2;
            pg8::EpiMergeH E{(pg8::bf16_t*)(ws + WS_MRG), 1024, (const pg8::bf16_t*)(ws + WS_G)};
            pg8::gemm_phase<pg8::EpiMergeH, pg8::SchedMN, true, true>(P.lds, g, S, E, P.tid);
        } SEAM(p0 + 11); PR_END(11);
        PR_BEGIN(12); if (IN(p0 + 12)) { PHASE_FRAME();
            pg8::Gemm g{1024, 1024, 1024}; pg8::SchedMN S; S.init(ws + WS_MRG, 1024, wm + WM_WO, 1024, lastl ? NB * SEQ / 256 : MROWS / 256, 4, 0, P.G, P.bx); S.skipctx = lastl;
            pg8::EpiBf<2> E{(pg8::bf16_t*)(ws + WS_G), 1024, nullptr};
            pg8::gemm_phase<pg8::EpiBf<2>, pg8::SchedMN, true, true>(P.lds, g, S, E, P.tid);
        } SEAM(p0 + 12); PR_END(12);
        PR_BEGIN(13); if (IN(p0 + 13)) { PHASE_FRAME(); phase_norm<1>(P, li); } SEAM(p0 + 13); PR_END(13);
        PR_BEGIN(14); if (IN(p0 + 14)) { PHASE_FRAME(); phase_side<1>(P, li, P.lds); } SEAM(p0 + 14); PR_END(14);
        PR_BEGIN(15); if (IN(p0 + 15)) { PHASE_FRAME(); phase_tk(P, lastl ? NB * NEXP : 2 * NB * NEXP); } SEAM(p0 + 15); PR_END(15);
        PR_BEGIN(16); if (IN(p0 + 16)) { PHASE_FRAME();
            pg8::Gemm g{1024, 1024, 1024}; pg8::SchedMoeG S{(const char*)(ws + WS_H), (const char*)(we + WE_GU), (size_t)2048 * 1024 * 2, 8, (lastl ? NSLOT_L / 256 : NSLOT / 256) * 8, P.G, P.vcu, (const int*)(ws + WS_IDX)};
            pg8::EpiE1 E{(pg8::bf16_t*)(ws + WS_HID)};
            pg8::gemm_phase<pg8::EpiE1, pg8::SchedMoeG, true, true>(P.lds, g, S, E, P.tid);
        } SEAM(p0 + 16); PR_END(16);
        PR_BEGIN(17); if (IN(p0 + 17)) { PHASE_FRAME();
            pg8::Gemm g{1024, 1024, 1024}; pg8::SchedMoe S{(const char*)(ws + WS_HID), (const char*)(we + WE_D), (size_t)1024 * 1024 * 2, 4, (lastl ? NSLOT_L / 256 : NSLOT / 256) * 4, P.G, P.vcu};
            pg8::EpiE2 E{(pg8::bf16_t*)(ws + WS_XIN), (const float*)(ws + WS_WGT), modv_of(P, li)};
            pg8::gemm_phase<pg8::EpiE2, pg8::SchedMoe, true, true>(P.lds, g, S, E, P.tid);
        } SEAM(p0 + 17); PR_END(17);
        PR_BEGIN(18); if (IN(p0 + 18)) { PHASE_FRAME(); phase_cb(P, li); } SEAM(p0 + 18); PR_END(18);
    }
#undef IN
#undef SEAM
    if (PROBE_MASK != 0 && blockIdx.x == 0) { const unsigned long long t1 = __builtin_amdgcn_s_memrealtime(); while (__builtin_amdgcn_s_memrealtime() - t1 < (unsigned long long)PROBE_MULT * pr_acc) __builtin_amdgcn_s_sleep(32); }
}

extern "C" void kernel_launch(void* const* d_in, const int* in_sizes, int n_in, void* d_out, int out_size, void* d_ws, size_t ws_size, hipStream_t stream) {
    static int grid = 0;
    if (grid == 0) {
        if (n_in != N_IN || in_sizes[0] != NB * SEQ * DM || out_size != NB * SEQ * DM || ws_size < WS_END) {
            fprintf(stderr, "kernel_launch: unexpected problem: n_in %d in0 %d out %d ws %zu (need %zu)\n", n_in, n_in > 0 ? in_sizes[0] : -1, out_size, ws_size, (size_t)WS_END); grid = -1; return; }
        int dev = 0, cus = 0, per_cu = 0;
        if (hipGetDevice(&dev) != hipSuccess || hipDeviceGetAttribute(&cus, hipDeviceAttributeMultiprocessorCount, dev) != hipSuccess) { grid = -1; return; }
        if (hipFuncSetAttribute((const void*)fwd_kernel, hipFuncAttributeMaxDynamicSharedMemorySize, LDS_BYTES) != hipSuccess) { fprintf(stderr, "kernel_launch: hipFuncSetAttribute failed\n"); grid = -1; return; }
        if (hipOccupancyMaxActiveBlocksPerMultiprocessor(&per_cu, (const void*)fwd_kernel, 512, LDS_BYTES) != hipSuccess || per_cu < 1) { fprintf(stderr, "kernel_launch: occupancy query says %d\n", per_cu); }
        (void)hipGetLastError();
        grid = cus;
    }
    if (grid < 0) return;
    (void)hipMemsetAsync((char*)d_ws + WS_CTL, 0, CTL_ZERO_BYTES, stream);
    Args a{};
    for (int i = 0; i < N_IN; ++i) a.in[i] = (const float*)d_in[i];
    a.out = (float*)d_out; a.ws = (unsigned char*)d_ws; a.pad = 0;
#if MK_ONE_LAUNCH
    a.ph_lo = 0; a.ph_hi = NLAYER * NPH; a.bar_region = 0;
    hipLaunchKernelGGL(fwd_kernel, dim3(grid), dim3(512), LDS_BYTES, stream, a);
#else
    for (int p = 0; p < NLAYER * NPH; ++p) { a.ph_lo = p; a.ph_hi = p + 1; a.bar_region = 0; hipLaunchKernelGGL(fwd_kernel, dim3(grid), dim3(512), LDS_BYTES, stream, a); }
#endif
}
```

```cpp
#include <hip/hip_runtime.h>
#include <hip/hip_bf16.h>
#include <cstdio>
#include <cstdint>
#include <cmath>

#ifndef MK_ONE_LAUNCH
#define MK_ONE_LAUNCH 1
#endif
#ifndef MK_CHECK
#define MK_CHECK 0
#endif

constexpr int DM = 1024, NB = 8, SEQ = 8192, CTXL = 256, TPB = SEQ + CTXL, MROWS = NB * TPB;
constexpr int NLAYER = 2, INCOLS = 4368, NPROJ = 4352, GRIDW = 64;
constexpr int NEXP = 16, FF = 1024, CAP_L = 1024, CAP_C = 32;
constexpr int NCHUNK = TPB / 64;
constexpr float EPSN = 1e-6f;
constexpr float C2Q = 0.125f * 1.4426950408889634f;

enum { I_X = 0, I_C, I_CTX, I_CCTX, I_WMOD, I_BMOD, I_N1W, I_N2W, I_WIN, I_GQN, I_GKN, I_DQN, I_DKN, I_LQ1, I_LK1, I_LQ2, I_LK2, I_SUBLN,
       I_CONVW, I_ALOG, I_DTB, I_GNW, I_WMG, I_WBR, I_WOUT, I_WRT, I_WEG, I_WEU, I_WED, N_IN };

constexpr size_t MiB = 1u << 20;
constexpr size_t WS_CTL = 0, CTL_ZERO_BYTES = 1 * MiB;
constexpr size_t WS_MODV = 1 * MiB;
constexpr size_t WS_ROPE = 1 * MiB + 512 * 1024;
constexpr size_t WS_LAM = 1 * MiB + 768 * 1024;
constexpr size_t WS_GDNG = 2 * MiB;
constexpr size_t WS_GCB = 7 * MiB;
constexpr size_t WS_AFF = 12 * MiB;
constexpr size_t WS_IDX = 17 * MiB;
constexpr size_t WS_WGT = 18 * MiB;
constexpr size_t WS_INV = 19 * MiB;
constexpr size_t WS_XC = 24 * MiB;
constexpr size_t WS_WMIX = 32 * MiB;
constexpr size_t WM_WIN = 0, WM_WG = 9 * MiB, WM_WB = 15 * MiB, WM_WO = 18 * MiB;
constexpr size_t WS_WEXP = 56 * MiB;
constexpr size_t WE_GU = 0, WE_D = 64 * MiB;
constexpr size_t WS_H = 152 * MiB;
constexpr size_t WS_S = 284 * MiB;
constexpr size_t WS_YA = WS_S, WS_YB = WS_S + 66 * MiB, WS_YG = WS_S + 132 * MiB;
constexpr size_t WS_KA = WS_S + 198 * MiB, WS_VA = WS_KA + 17 * MiB;
constexpr size_t WS_QB = WS_S + 232 * MiB, WS_KB = WS_QB + 66 * MiB, WS_VB = WS_KB + 66 * MiB;
constexpr size_t WS_OB = WS_VB + 66 * MiB;
constexpr size_t WS_TQ = WS_S;
constexpr size_t WS_CPRE = WS_S + 198 * MiB;
constexpr size_t WS_Z = WS_CPRE + 198 * MiB;
constexpr size_t WS_POST = WS_Z + 66 * MiB;
constexpr size_t WS_G = WS_S + 198 * MiB;
constexpr size_t WS_MRG = WS_G + 396 * MiB;
constexpr size_t WS_XIN = WS_S, WS_HID = WS_S + 264 * MiB;
constexpr size_t WS_END = WS_S + 728 * MiB;
static_assert(WS_POST + 198 * MiB <= WS_END && WS_MRG + 132 * MiB <= WS_END && WS_HID + 264 * MiB <= WS_END && WS_OB + 132 * MiB <= WS_END, "ws map");
static_assert(WS_END <= 1024 * MiB, "ws map exceeds 1 GiB");
constexpr int NSLOT_L = NB * NEXP * CAP_L, NSLOT_C = NB * NEXP * CAP_C, NSLOT = NSLOT_L + NSLOT_C;

constexpr int RING_BYTES = 131072, LDSCTL_OFF = RING_BYTES, MISC_OFF = LDSCTL_OFF + 320, LDS_BYTES = 147456;
constexpr int LDS_XTRA = MISC_OFF + 128;

#define GAS __attribute__((address_space(1)))
#define LAS __attribute__((address_space(3)))
typedef unsigned short bf16;
typedef unsigned v4u __attribute__((ext_vector_type(4)));
typedef unsigned v2u __attribute__((ext_vector_type(2)));
typedef float f32x4 __attribute__((ext_vector_type(4)));
typedef float f32x2 __attribute__((ext_vector_type(2)));
typedef short bf16x8 __attribute__((ext_vector_type(8)));
typedef GAS unsigned gu32;
#define RLX_AGENT __ATOMIC_RELAXED, __HIP_MEMORY_SCOPE_AGENT
#define LDS_WAIT() asm volatile("s_waitcnt lgkmcnt(0)" ::: "memory")
#define VM_WAIT() asm volatile("s_waitcnt vmcnt(0)" ::: "memory")
#define DI __device__ __forceinline__

DI unsigned f2bf(float f) { unsigned u = __builtin_bit_cast(unsigned, f); return (u + 0x7fffu + ((u >> 16) & 1u)) >> 16; }
DI unsigned pk2(float lo, float hi) { typedef __bf16 b2 __attribute__((ext_vector_type(2))); f32x2 v = {lo, hi}; b2 b = __builtin_convertvector(v, b2); return __builtin_bit_cast(unsigned, b); }
DI float bf2f(unsigned short b) { return __builtin_bit_cast(float, (unsigned)b << 16); }
DI float bflo(unsigned w) { return __builtin_bit_cast(float, w << 16); }
DI float bfhi(unsigned w) { return __builtin_bit_cast(float, w & 0xffff0000u); }
DI float sigmoidf_(float x) { return __builtin_amdgcn_rcpf(1.f + __expf(-x)); }
DI float siluf_(float x) { return x * __builtin_amdgcn_rcpf(1.f + __expf(-x)); }
DI float wave_sum(float v) {
#pragma unroll
    for (int o = 1; o < 64; o <<= 1) v += __shfl_xor(v, o);
    return v;
}
DI float sum16(float v) { v += __shfl_xor(v, 1); v += __shfl_xor(v, 2); v += __shfl_xor(v, 4); v += __shfl_xor(v, 8); return v; }
DI float reduce16(const float (&v)[16], int lane) {
    float a[8], b[4], c[2], d;
    const bool b5 = lane & 32, b4 = lane & 16, b3 = lane & 8, b2 = lane & 4;
#pragma unroll
    for (int i = 0; i < 8; ++i) { const float keep = b5 ? v[i + 8] : v[i], send = b5 ? v[i] : v[i + 8]; a[i] = keep + __shfl_xor(send, 32); }
#pragma unroll
    for (int i = 0; i < 4; ++i) { const float keep = b4 ? a[i + 4] : a[i], send = b4 ? a[i] : a[i + 4]; b[i] = keep + __shfl_xor(send, 16); }
#pragma unroll
    for (int i = 0; i < 2; ++i) { const float keep = b3 ? b[i + 2] : b[i], send = b3 ? b[i] : b[i + 2]; c[i] = keep + __shfl_xor(send, 8); }
    { const float keep = b2 ? c[1] : c[0], send = b2 ? c[0] : c[1]; d = keep + __shfl_xor(send, 4); }
    d += __shfl_xor(d, 2); d += __shfl_xor(d, 1);
    return d;
}

DI float max_b2345(float m) { m = fmaxf(m, __shfl_xor(m, 4)); m = fmaxf(m, __shfl_xor(m, 8)); m = fmaxf(m, __shfl_xor(m, 16)); m = fmaxf(m, __shfl_xor(m, 32)); return m; }
DI float sum_b2345(float s) { s += __shfl_xor(s, 4); s += __shfl_xor(s, 8); s += __shfl_xor(s, 16); s += __shfl_xor(s, 32); return s; }

#define MFMA32(a, b, c) __builtin_amdgcn_mfma_f32_32x32x16_bf16((a), (b), (c), 0, 0, 0)
#define MFMA16(a, b, c) __builtin_amdgcn_mfma_f32_16x16x32_bf16((a), (b), (c), 0, 0, 0)
#define XB_TMO      128
#define XB_XCNT(j)  (256  + 64 * (j))
#define XB_XSUB(j)  (1280 + 64 * (j))
#define XB_XGEN(j)  (2304 + 64 * (j))
#define XB_TOP      3328
#define XB_TOPGEN   3392
#define XCD_BAR_WORDS 3456
#define XB_SPIN_CAP (1u << 22)
DI unsigned xb_ld(unsigned* p)              { return __hip_atomic_load(p, __ATOMIC_RELAXED, __HIP_MEMORY_SCOPE_AGENT); }
DI unsigned xb_add(unsigned* p, unsigned v) { return __hip_atomic_fetch_add(p, v, __ATOMIC_RELAXED, __HIP_MEMORY_SCOPE_AGENT); }
DI unsigned xb_xcc_id() { return (unsigned)__builtin_amdgcn_s_getreg((3 << 11) | 20) & 0xFu; }
#define XB_SPIN(cond, bar) do { unsigned _sp = 0; while (cond) { __builtin_amdgcn_s_sleep(1); \
    if ((++_sp & 255u) == 0u) { if (xb_ld(&(bar)[XB_TMO])) break; if (_sp > XB_SPIN_CAP) { atomicAdd(&(bar)[XB_TMO], 1u); break; } } } } while (0)
struct XcdBarrier { unsigned* bar; unsigned x; volatile LAS unsigned* st; };
DI XcdBarrier xcd_barrier_post(unsigned* bar, volatile LAS unsigned* st) {
    XcdBarrier b; b.bar = bar; b.x = xb_xcc_id(); b.st = st;
    if (threadIdx.x == 0) (void)xb_add(&bar[XB_XCNT(b.x)], 1u);
    return b;
}
DI void xcd_barrier_complete(unsigned* bar, unsigned x, unsigned& nloc, unsigned& nx) {
    const unsigned G = gridDim.x * gridDim.y * gridDim.z;
    unsigned sum, cnt, mine, sp = 0u;
    for (;;) {
        sum = 0u; cnt = 0u; mine = 0u;
#pragma unroll
        for (unsigned j = 0; j < 16; ++j) { const unsigned c = xb_ld(&bar[XB_XCNT(j)]); sum += c; cnt += (c > 0u) ? 1u : 0u; mine = (j == x) ? c : mine; }
        if (sum == G) break;
        __builtin_amdgcn_s_sleep(1);
        if ((++sp & 255u) == 0u) { if (xb_ld(&bar[XB_TMO])) break; if (sp > XB_SPIN_CAP) { atomicAdd(&bar[XB_TMO], 1u); break; } }
    }
    nloc = mine > 0u ? mine : 1u; nx = cnt > 0u ? cnt : 1u;
}
DI void xcd_barrier(const XcdBarrier& b) {
    asm volatile("s_waitcnt vmcnt(0)" ::: "memory");
    __syncthreads();
    if (threadIdx.x == 0) {
        unsigned* bar = b.bar;
        __builtin_amdgcn_s_waitcnt(0);
        unsigned nloc = b.st[0], nx = b.st[1];
        if (nloc == 0u) { xcd_barrier_complete(bar, b.x, nloc, nx); b.st[0] = nloc; b.st[1] = nx; }
        const unsigned old = xb_add(&bar[XB_XSUB(b.x)], 1u);
        const unsigned gen = old / nloc;
        if (old + 1u == (gen + 1u) * nloc) {
            __builtin_amdgcn_fence(__ATOMIC_RELEASE, "agent");
            asm volatile("s_waitcnt vmcnt(0)" ::: "memory");
            const unsigned og = xb_add(&bar[XB_TOP], 1u);
            const unsigned tg = og / nx;
            if (og + 1u == (tg + 1u) * nx) xb_add(&bar[XB_TOPGEN], 1u);
            else XB_SPIN(xb_ld(&bar[XB_TOPGEN]) == tg, bar);
            __builtin_amdgcn_fence(__ATOMIC_ACQUIRE, "agent");
            xb_add(&bar[XB_XGEN(b.x)], 1u);
            asm volatile("s_waitcnt vmcnt(0)" ::: "memory");
        } else {
            XB_SPIN(xb_ld(&bar[XB_XGEN(b.x)]) == gen, bar);
            __builtin_amdgcn_fence(__ATOMIC_ACQUIRE, "agent");
            asm volatile("s_waitcnt vmcnt(0)" ::: "memory");
        }
    }
    __syncthreads();
}
namespace pg8 {
#define PG8_LAS __attribute__((address_space(3)))
typedef unsigned short bf16_t;
typedef short bf16x8 __attribute__((ext_vector_type(8)));
typedef float f32x4 __attribute__((ext_vector_type(4)));
typedef unsigned u32x4 __attribute__((ext_vector_type(4)));
constexpr int BM = 256, BK = 64, HALF = 128, HTB = HALF * BK * 2  , STAGE_BYTES = 8 * HTB, NXCD = 8, WGM = 8;

__host__ __device__ __forceinline__ int lds_byte(int r, int c) { const int st = (r >> 4) * 2 + (c >> 5), rr = r & 15, cc = c & 31, ob = rr * 64 + cc * 2; return st * 1024 + (ob ^ (((ob >> 9) & 1) << 5)); }
__host__ __device__ __forceinline__ void stage_rc(int b, int& R, int& C) { const int st = b / 1024, sb = b % 1024, swz = sb ^ (((sb >> 9) & 1) << 5); R = (st >> 1) * 16 + swz / 64; C = (st & 1) * 32 + (swz % 64) / 2; }
__host__ __device__ __forceinline__ int perm32(int rho) { const int n = rho >> 4, i = rho & 15; return 8 * (i >> 2) + 4 * n + (i & 3); }

struct Unit { int pm, pn, z; };
struct Gemm { int lda, ldb, K; unsigned* scr; };

__device__ __forceinline__ unsigned cvt_pk_bf16(float lo, float hi) { typedef __bf16 b2_t __attribute__((ext_vector_type(2))); typedef float f2_t __attribute__((ext_vector_type(2))); f2_t v = {lo, hi}; b2_t b = __builtin_convertvector(v, b2_t); return __builtin_bit_cast(unsigned, b); }
typedef float f32x2 __attribute__((ext_vector_type(2)));
template <class Epi, class Sched, bool ALIGN_EPI = false, bool SP2 = false>
__device__ __forceinline__ void gemm_phase(PG8_LAS unsigned char* lds, const Gemm g, const Sched& S, const Epi& E, const int tid  ) {
    const int wid = __builtin_amdgcn_readfirstlane(tid >> 6), lane = tid & 63, wr = wid >> 2, wc = wid & 3, fr = lane & 15, fq = lane >> 4;
    const int K = g.K, nt = K / BK;
    unsigned voffA, voffB;
    { int R, C; stage_rc(tid * 16, R, C); const int Rb = Epi::PERM ? ((R & ~31) + perm32(R & 31)) : R; voffA = (unsigned)(R * g.lda + C) * 2u; voffB = (unsigned)(Rb * g.ldb + C) * 2u; }
    const size_t pstepA = (size_t)64 * g.lda * 2, pstepB = (size_t)64 * g.ldb * 2;
    constexpr bool GATHER = Sched::GATHER;
    unsigned gA[2][2][2];
#define PG8_GOFF(u_, w_) do { if constexpr (GATHER) { _Pragma("unroll") for (int _h = 0; _h < 2; ++_h) _Pragma("unroll") for (int _i = 0; _i < 2; ++_i) { int R_, C_; stage_rc(tid * 16 + _i * 8192, R_, C_); \
        gA[w_][_h][_i] = (unsigned)S.row_of((u_).pm * BM + _h * HALF + R_) * (unsigned)(g.lda * 2) + (unsigned)(C_ * 2); } } } while (0)
    const size_t kstep = (size_t)(BK * 2);
    const size_t hstepA = (size_t)HALF * g.lda * 2, hstepB = (size_t)HALF * g.ldb * 2;
    const unsigned ldsw = (unsigned)wid * 1024u;
    const int aoff = lds_byte(wr * 64 + fr, fq * 8), boff = lds_byte(wc * 32 + fr, fq * 8);
#define PG8_SA(b, h) (((b) * 2 + (h)) * HTB)
#define PG8_SB(b, h) ((4 + (b) * 2 + (h)) * HTB)
#define PG8_STAGE2(bufoff, gbase, voff) do { _Pragma("unroll") for (int _i = 0; _i < 2; ++_i) \
        __builtin_amdgcn_global_load_lds((const unsigned*)((const char*)(gbase) + (voff)[_i]), (PG8_LAS unsigned*)(lds + (bufoff) + ldsw + _i * 8192), 16, 0, 0); } while (0)
#define PG8_STAGE1(bufoff, gbase, voff, pstep) do { _Pragma("unroll") for (int _i = 0; _i < 2; ++_i) \
        __builtin_amdgcn_global_load_lds((const unsigned*)((const char*)(gbase) + _i * (pstep) + (voff)), (PG8_LAS unsigned*)(lds + (bufoff) + ldsw + _i * 8192), 16, 0, 0); } while (0)
#define PG8_STAGE(bufoff, gbase, voffB_) PG8_STAGE1(bufoff, gbase, voffB, pstepB)
#define PG8_STAGE_A(bufoff, ptr, h, un) do { if constexpr (GATHER) { const bool _n = (un); unsigned _v[2] = {_n ? gA[1][h][0] : gA[0][h][0], _n ? gA[1][h][1] : gA[0][h][1]}; PG8_STAGE2(bufoff, ptr, _v); } \
        else { PG8_STAGE1(bufoff, (ptr) + (h) * hstepA, voffA, pstepA); } } while (0)
#define PG8_LDA(dst, b, h) do { _Pragma("unroll") for (int m = 0; m < 4; ++m) _Pragma("unroll") for (int k = 0; k < 2; ++k) dst[m][k] = *(const PG8_LAS bf16x8*)(lds + PG8_SA(b, h) + aoff + m * 2048 + k * 1024); } while (0)
#define PG8_LDB(dst, b, h) do { _Pragma("unroll") for (int n = 0; n < 2; ++n) _Pragma("unroll") for (int k = 0; k < 2; ++k) dst[n][k] = *(const PG8_LAS bf16x8*)(lds + PG8_SB(b, h) + boff + n * 2048 + k * 1024); } while (0)
#define PG8_MMA(ai, bj, At, Bt) do { __builtin_amdgcn_s_setprio(1); _Pragma("unroll") for (int m = 0; m < 4; ++m) _Pragma("unroll") for (int n = 0; n < 2; ++n) _Pragma("unroll") for (int k = 0; k < 2; ++k) \
        acc[ai][bj][m][n] = __builtin_amdgcn_mfma_f32_16x16x32_bf16(Bt[n][k], At[m][k], acc[ai][bj][m][n], 0, 0, 0); __builtin_amdgcn_s_setprio(0); } while (0)
#define PG8_WAIT_V(n) asm volatile("s_waitcnt vmcnt(" #n ")" ::: "memory")
#define PG8_WAIT_L(n) asm volatile("s_waitcnt lgkmcnt(" #n ")" ::: "memory")
#define PG8_BAR __builtin_amdgcn_s_barrier()
#define PG8_SCHED __builtin_amdgcn_sched_barrier(0)
    Unit cur, nxt; int ui = 0;
    if (!S.next(0, cur)) return;
    f32x4 acc[2][2][4][2];
#pragma unroll
    for (int a = 0; a < 2; ++a)
#pragma unroll
        for (int b = 0; b < 2; ++b)
#pragma unroll
            for (int m = 0; m < 4; ++m)
#pragma unroll
                for (int n = 0; n < 2; ++n) acc[a][b][m][n] = (f32x4){0.f, 0.f, 0.f, 0.f};
    bf16x8 At[4][2], B0[2][2], B1[2][2];
    const char* cA = S.a_ptr(cur); const char* cB = S.b_ptr(cur);
    S.a_ready(cur); PG8_GOFF(cur, 0);
    if constexpr (SP2) {
        PG8_STAGE(PG8_SB(0, 0), cB, voffB); PG8_STAGE(PG8_SB(0, 1), cB + hstepB, voffB); PG8_STAGE_A(PG8_SA(0, 0), cA, 0, false); PG8_STAGE_A(PG8_SA(0, 1), cA, 1, false);
        if (wr == 1) PG8_BAR;
        PG8_WAIT_V(2); PG8_BAR;
        PG8_STAGE(PG8_SB(1, 0), cB + kstep, voffB); PG8_STAGE_A(PG8_SA(1, 0), cA + kstep, 0, false); PG8_STAGE(PG8_SB(1, 1), cB + hstepB + kstep, voffB);
        PG8_WAIT_V(6); PG8_BAR;
    } else {
        PG8_STAGE(PG8_SB(0, 0), cB, voffB); PG8_STAGE1(PG8_SA(0, 0), cA, voffA, pstepA); PG8_STAGE(PG8_SB(0, 1), cB + hstepB, voffB); PG8_STAGE1(PG8_SA(0, 1), cA + hstepA, voffA, pstepA);
        if (wr == 1) PG8_BAR;
        PG8_WAIT_V(4); PG8_BAR;
        PG8_STAGE(PG8_SB(1, 0), cB + kstep, voffB); PG8_STAGE1(PG8_SA(1, 0), cA + kstep, voffA, pstepA); PG8_STAGE(PG8_SB(1, 1), cB + hstepB + kstep, voffB);
        PG8_WAIT_V(6); PG8_BAR;
    }
    for (;;) {
        const bool has_next = S.next(ui + 1, nxt); if (has_next) PG8_GOFF(nxt, 1);
        const char* nA = has_next ? S.a_ptr(nxt) : cA; const char* nB = has_next ? S.b_ptr(nxt) : cB;
        for (int t = 0; t < nt; t += 2) {
            const bool last = (t == nt - 2);
            const char* a1 = cA + (size_t)(t + 1) * kstep;
            const char* a2 = last ? nA : cA + (size_t)(t + 2) * kstep; const char* b2 = last ? nB : cB + (size_t)(t + 2) * kstep;
            const char* a3 = a2 + kstep; const char* b3 = b2 + kstep;
            if (last && has_next) S.a_ready(nxt);
            if constexpr (SP2) {
            PG8_LDB(B0, 0, 0); PG8_LDB(B1, 0, 1); PG8_SCHED; PG8_LDA(At, 0, 0); PG8_STAGE_A(PG8_SA(1, 1), a1, 1, false);
            PG8_WAIT_V(8); PG8_WAIT_L(0); PG8_BAR; PG8_MMA(0, 0, At, B0); PG8_MMA(0, 1, At, B1); PG8_BAR; PG8_SCHED;
            PG8_LDA(At, 0, 1); PG8_STAGE(PG8_SB(0, 0), b2, voffB); PG8_STAGE(PG8_SB(0, 1), b2 + hstepB, voffB); PG8_STAGE_A(PG8_SA(0, 0), a2, 0, last && has_next);
            PG8_WAIT_V(8); PG8_WAIT_L(0); PG8_BAR; PG8_MMA(1, 0, At, B0); PG8_MMA(1, 1, At, B1); PG8_BAR; PG8_SCHED;
            PG8_LDB(B0, 1, 0); PG8_LDB(B1, 1, 1); PG8_SCHED; PG8_LDA(At, 1, 0); PG8_STAGE_A(PG8_SA(0, 1), a2, 1, last && has_next);
            PG8_WAIT_V(8); PG8_WAIT_L(0); PG8_BAR; PG8_MMA(0, 0, At, B0); PG8_MMA(0, 1, At, B1); PG8_BAR; PG8_SCHED;
            PG8_LDA(At, 1, 1); PG8_STAGE(PG8_SB(1, 0), b3, voffB); PG8_STAGE(PG8_SB(1, 1), b3 + hstepB, voffB); PG8_STAGE_A(PG8_SA(1, 0), a3, 0, last && has_next);
            PG8_WAIT_V(8); PG8_WAIT_L(0); PG8_BAR; PG8_MMA(1, 0, At, B0); PG8_MMA(1, 1, At, B1); PG8_BAR; PG8_SCHED;
            } else {
            PG8_LDB(B0, 0, 0); PG8_SCHED; PG8_LDA(At, 0, 0); PG8_STAGE1(PG8_SA(1, 1), a1 + hstepA, voffA, pstepA);
            PG8_WAIT_L(8); PG8_BAR; PG8_WAIT_L(0); PG8_MMA(0, 0, At, B0); PG8_BAR; PG8_SCHED;
            PG8_LDB(B1, 0, 1); PG8_STAGE(PG8_SB(0, 0), b2, voffB);
            PG8_BAR; PG8_WAIT_L(0); PG8_MMA(0, 1, At, B1); PG8_BAR;
            PG8_LDA(At, 0, 1); PG8_STAGE1(PG8_SA(0, 0), a2, voffA, pstepA);
            PG8_BAR; PG8_WAIT_L(0); PG8_MMA(1, 0, At, B0); PG8_BAR; PG8_SCHED;
            PG8_STAGE(PG8_SB(0, 1), b2 + hstepB, voffB);
            PG8_WAIT_V(6); PG8_BAR; PG8_MMA(1, 1, At, B1); PG8_BAR;
            PG8_LDB(B0, 1, 0); PG8_SCHED; PG8_LDA(At, 1, 0); PG8_STAGE1(PG8_SA(0, 1), a2 + hstepA, voffA, pstepA);
            PG8_WAIT_L(8); PG8_BAR; PG8_WAIT_L(0); PG8_MMA(0, 0, At, B0); PG8_BAR; PG8_SCHED;
            PG8_LDB(B1, 1, 1); PG8_STAGE(PG8_SB(1, 0), b3, voffB);
            PG8_BAR; PG8_WAIT_L(0); PG8_MMA(0, 1, At, B1); PG8_BAR;
            PG8_LDA(At, 1, 1); PG8_STAGE1(PG8_SA(1, 0), a3, voffA, pstepA);
            PG8_BAR; PG8_WAIT_L(0); PG8_MMA(1, 0, At, B0); PG8_BAR; PG8_SCHED;
            PG8_STAGE(PG8_SB(1, 1), b3 + hstepB, voffB);
            PG8_WAIT_V(6); PG8_BAR; PG8_MMA(1, 1, At, B1); PG8_BAR;
            }
        }
        if constexpr (ALIGN_EPI) { if (wr == 0) PG8_BAR; }
        bool keep = false;
        if constexpr (!Epi::AFTER_DRAIN) { if constexpr (Epi::INPLACE) keep = E.inplace(acc, cur, wr, wc, fr, fq); else E(acc, cur, wr, wc, fr, fq); S.done(cur); }
        if (!has_next) break;
        if (!keep)
#pragma unroll
        for (int a = 0; a < 2; ++a)
#pragma unroll
            for (int b = 0; b < 2; ++b)
#pragma unroll
                for (int m = 0; m < 4; ++m)
#pragma unroll
                    for (int n = 0; n < 2; ++n) acc[a][b][m][n] = (f32x4){0.f, 0.f, 0.f, 0.f};
        cur = nxt; cA = nA; cB = nB; ++ui;
        if constexpr (GATHER) { _Pragma("unroll") for (int _h = 0; _h < 2; ++_h) _Pragma("unroll") for (int _i = 0; _i < 2; ++_i) gA[0][_h][_i] = gA[1][_h][_i]; }
        if constexpr (ALIGN_EPI) { if (wr == 1) PG8_BAR; }
    }
    PG8_WAIT_V(0);
    if constexpr (!ALIGN_EPI) { if (wr == 0) PG8_BAR; }
    PG8_BAR;
    if constexpr (Epi::AFTER_DRAIN) { E.fused(acc, cur, wr, wc, fr, fq, lds, wid, lane); S.done(cur); }
#undef PG8_SA
#undef PG8_SB
#undef PG8_STAGE
#undef PG8_STAGE_A
#undef PG8_GOFF
#undef PG8_LDA
#undef PG8_LDB
#undef PG8_MMA
#undef PG8_WAIT_V
#undef PG8_WAIT_L
#undef PG8_BAR
#undef PG8_SCHED
}
}
namespace pg8 {
struct SchedMN {
    static constexpr bool GATHER = false; DI int row_of(int r) const { return r; }
    const char* A; const char* B; size_t a_tile, b_tile, a_z, b_z;
    int nM, nN, nwg, G, c, NZ, pn0, skipctx;
    DI void init(const void* A_, size_t lda, const void* B_, size_t ldb, int nM_, int nN_, int pn0_, int G_, int c_) {
        A = (const char*)A_; B = (const char*)B_; a_tile = 256 * lda * 2; b_tile = 256 * ldb * 2; a_z = 0; b_z = 0; nM = nM_; nN = nN_; nwg = nM * nN; G = G_; c = c_; NZ = 1; pn0 = pn0_; skipctx = 0; }
    DI bool next(int i, Unit& u) const {
        const int ti = i / NZ; u.z = i - ti * NZ;
        const long L = (long)ti * G + c; if (L >= nwg) return false;
        int wgid = (int)L; { const int q = nwg / NXCD, r = nwg % NXCD, xcd = wgid % NXCD, off = wgid / NXCD; wgid = (xcd < r ? xcd * (q + 1) : r * (q + 1) + (xcd - r) * q) + off; }
        const int nig = WGM * nN, gid = wgid / nig, fm = gid * WGM, gsz = (nM - fm) < WGM ? (nM - fm) : WGM;
        u.pm = fm + ((wgid % nig) % gsz); u.pn = pn0 + (wgid % nig) / gsz; if (skipctx) u.pm += u.pm >> 5; return true;
    }
    DI const char* a_ptr(const Unit& u) const { return A + (size_t)u.pm * a_tile + (size_t)u.z * a_z; }
    DI const char* b_ptr(const Unit& u) const { return B + (size_t)u.pn * b_tile + (size_t)u.z * b_z; }
    DI void a_ready(const Unit&) const {}
    DI void done(const Unit&) const {}
};
struct SchedMoe {
    static constexpr bool GATHER = false; DI int row_of(int r) const { return r; }
    const char* A; const char* B; size_t b_exp; int nN, ntot, G, c;
    DI bool next(int i, Unit& u) const { const long L = (long)i * G + c; if (L >= ntot) return false; u.pm = (int)(L / nN); u.pn = (int)(L % nN); u.z = u.pm < 512 ? (u.pm >> 5) : (u.pm - 512); return true; }
    DI const char* a_ptr(const Unit& u) const { return A + (size_t)u.pm * (256 * 1024 * 2); }
    DI const char* b_ptr(const Unit& u) const { return B + (size_t)u.z * b_exp + (size_t)u.pn * (256 * 1024 * 2); }
    DI void a_ready(const Unit&) const {}
    DI void done(const Unit&) const {}
};

struct SchedMoeG {
    static constexpr bool GATHER = true;
    const char* A; const char* B; size_t b_exp; int nN, ntot, G, c; const int* idx;
    DI int row_of(int r) const { return idx[r]; }
    DI bool next(int i, Unit& u) const { const long L = (long)i * G + c; if (L >= ntot) return false; u.pm = (int)(L / nN); u.pn = (int)(L % nN); u.z = u.pm < 512 ? (u.pm >> 5) : (u.pm - 512); return true; }
    DI const char* a_ptr(const Unit&) const { return A; }
    DI const char* b_ptr(const Unit& u) const { return B + (size_t)u.z * b_exp + (size_t)u.pn * (256 * 1024 * 2); }
    DI void a_ready(const Unit&) const {}
    DI void done(const Unit&) const {}
};

struct EpiInProj {
    static constexpr bool PERM = false, AFTER_DRAIN = false, INPLACE = false;
    unsigned char* ws; const float *gqn, *gkn, *dqn, *dkn; const float* rope;
    DI void operator()(const f32x4 (&acc)[2][2][4][2], const Unit& u, int wr, int wc, int fr, int fq) const {
        const int pn = u.pn;
        bf16_t* dst; int pitch, col0; const float* nw = nullptr; float scale = 1.f;
        if (pn < 2)       { dst = (bf16_t*)(ws + WS_YA); pitch = 512; col0 = (pn * 4 + wc) * 64; nw = gqn; scale = C2Q; }
        else if (pn == 2) { if (wc < 2) { dst = (bf16_t*)(ws + WS_KA); pitch = 128; col0 = wc * 64; nw = gkn; } else { dst = (bf16_t*)(ws + WS_VA); pitch = 128; col0 = (wc - 2) * 64; } }
        else if (pn < 5)  { dst = (bf16_t*)(ws + WS_QB); pitch = 512; col0 = ((pn - 3) * 4 + wc) * 64; nw = dqn; scale = C2Q; }
        else if (pn < 7)  { dst = (bf16_t*)(ws + WS_KB); pitch = 512; col0 = ((pn - 5) * 4 + wc) * 64; nw = dkn; }
        else if (pn < 9)  { dst = (bf16_t*)(ws + WS_VB); pitch = 512; col0 = (pn - 7) * 256 + wc * 64; }
        else if (pn < 15) { dst = (bf16_t*)(ws + WS_CPRE); pitch = 1536; col0 = (pn - 9) * 256 + wc * 64; }
        else              { dst = (bf16_t*)(ws + WS_Z); pitch = 512; col0 = (pn - 15) * 256 + wc * 64; }
        f32x4 w4[2][2];
        if (nw) {
#pragma unroll
            for (int bj = 0; bj < 2; ++bj)
#pragma unroll
                for (int n = 0; n < 2; ++n) w4[bj][n] = *(const f32x4*)(nw + 32 * bj + 16 * n + 4 * fq);
        }
#pragma unroll
        for (int aim = 0; aim < 4; ++aim) { const int ai = aim >> 1, mb = (aim & 1) * 2;
            f32x4 rt[4][2][2];
            if (nw) {
#pragma unroll
                for (int m = mb; m < mb + 2; ++m) { const int row = u.pm * BM + ai * HALF + wr * 64 + m * 16 + fr, t = row % TPB, tc = t < SEQ ? t : 0;
#pragma unroll
                    for (int bj = 0; bj < 2; ++bj) { const int pos = bj == 0 ? (tc >> 6) : (tc & 63);
                        rt[m][bj][0] = *(const f32x4*)(rope + (pos * 16 + 4 * fq) * 2); rt[m][bj][1] = *(const f32x4*)(rope + (pos * 16 + 4 * fq) * 2 + 4); } }
            }
#pragma unroll
            for (int m = mb; m < mb + 2; ++m) {
                const int row = u.pm * BM + ai * HALF + wr * 64 + m * 16 + fr;
                f32x4 v[2][2];
#pragma unroll
                for (int bj = 0; bj < 2; ++bj)
#pragma unroll
                    for (int n = 0; n < 2; ++n) v[bj][n] = acc[ai][bj][m][n];
                if (nw) {
                    float ss = 0.f;
#pragma unroll
                    for (int bj = 0; bj < 2; ++bj)
#pragma unroll
                        for (int n = 0; n < 2; ++n) ss += (v[bj][n][0] * v[bj][n][0] + v[bj][n][1] * v[bj][n][1]) + (v[bj][n][2] * v[bj][n][2] + v[bj][n][3] * v[bj][n][3]);
                    ss += __shfl_xor(ss, 16); ss += __shfl_xor(ss, 32);
                    const float rstd = rsqrtf(ss * (1.f / 64.f) + EPSN);
#pragma unroll
                    for (int bj = 0; bj < 2; ++bj)
#pragma unroll
                        for (int n = 0; n < 2; ++n) v[bj][n] = v[bj][n] * rstd * w4[bj][n];
                    const int t = row % TPB;
                    if (t < SEQ) {
#pragma unroll
                        for (int bj = 0; bj < 2; ++bj) {
                            const f32x4 cs0 = rt[m][bj][0], cs1 = rt[m][bj][1];
                            const float c[4] = {cs0[0], cs0[2], cs1[0], cs1[2]}, s[4] = {cs0[1], cs0[3], cs1[1], cs1[3]};
#pragma unroll
                            for (int e = 0; e < 4; ++e) { const float x1 = v[bj][0][e], x2 = v[bj][1][e]; v[bj][0][e] = x1 * c[e] - x2 * s[e]; v[bj][1][e] = x2 * c[e] + x1 * s[e]; }
                        }
                    }
                }
                bf16_t* rp = dst + (size_t)row * pitch + col0 + 4 * fq;
#pragma unroll
                for (int bj = 0; bj < 2; ++bj)
#pragma unroll
                    for (int n = 0; n < 2; ++n) { const f32x4 o = v[bj][n] * scale; v2u w; w.x = cvt_pk_bf16(o[0], o[1]); w.y = cvt_pk_bf16(o[2], o[3]); *(v2u*)(rp + 32 * bj + 16 * n) = w; }
            }
        }
    }
};

template <int MODE> struct EpiBf {
    static constexpr bool PERM = true, AFTER_DRAIN = false, INPLACE = false;
    bf16_t* O; int ldc; const bf16_t* Gt;
    DI void operator()(const f32x4 (&acc)[2][2][4][2], const Unit& u, int wr, int wc, int fr, int fq) const {
        const int row0 = u.pm * BM + wr * 64 + fr, col0 = u.pn * BM + wc * 32 + 8 * fq;
#pragma unroll
        for (int ai = 0; ai < 2; ++ai) {
            u32x4 gv[4][2], pv[4][2];
            if (MODE == 1) {
#pragma unroll
                for (int m = 0; m < 4; ++m)
#pragma unroll
                    for (int bj = 0; bj < 2; ++bj) { const size_t row = (size_t)(row0 + ai * HALF + m * 16);
                        gv[m][bj] = *(const u32x4*)(Gt + row * 3072 + u.z * 1024 + col0 + bj * HALF);
                        pv[m][bj] = (u32x4){0u, 0u, 0u, 0u}; if (u.z > 0) pv[m][bj] = *(const u32x4*)(O + row * ldc + col0 + bj * HALF); }
            }
#pragma unroll
            for (int m = 0; m < 4; ++m) { const size_t row = (size_t)(row0 + ai * HALF + m * 16);
#pragma unroll
                for (int bj = 0; bj < 2; ++bj) { f32x4 v0 = acc[ai][bj][m][0], v1 = acc[ai][bj][m][1]; bf16_t* op = O + row * ldc + col0 + bj * HALF;
                    if (MODE == 0) {
                        unsigned lo = 0u, hi = 0u;
#pragma unroll
                        for (int e = 0; e < 4; ++e) { lo = __builtin_amdgcn_cvt_pk_u8_f32(sigmoidf_(v0[e]) * 255.f, e, lo); hi = __builtin_amdgcn_cvt_pk_u8_f32(sigmoidf_(v1[e]) * 255.f, e, hi); }
                        v2u w8; w8.x = lo; w8.y = hi; *(v2u*)((unsigned char*)O + row * 3072 + col0 + bj * HALF) = w8;
                        continue;
                    } else if (MODE == 1) {
                        const u32x4 g = gv[m][bj], p = pv[m][bj];
                        v0[0] = v0[0] * bflo(g.x) + bflo(p.x); v0[1] = v0[1] * bfhi(g.x) + bfhi(p.x); v0[2] = v0[2] * bflo(g.y) + bflo(p.y); v0[3] = v0[3] * bfhi(g.y) + bfhi(p.y);
                        v1[0] = v1[0] * bflo(g.z) + bflo(p.z); v1[1] = v1[1] * bfhi(g.z) + bfhi(p.z); v1[2] = v1[2] * bflo(g.w) + bflo(p.w); v1[3] = v1[3] * bfhi(g.w) + bfhi(p.w);
                    }
                    u32x4 w; w.x = cvt_pk_bf16(v0[0], v0[1]); w.y = cvt_pk_bf16(v0[2], v0[3]); w.z = cvt_pk_bf16(v1[0], v1[1]); w.w = cvt_pk_bf16(v1[2], v1[3]);
                    *(u32x4*)op = w; } }
        }
    }
};

struct EpiMergeH {
    static constexpr bool PERM = true, AFTER_DRAIN = false, INPLACE = true;
    bf16_t* O; int ldc; const bf16_t* Gt;
    DI bool inplace(f32x4 (&acc)[2][2][4][2], const Unit& u, int wr, int wc, int fr, int fq) const {
        const int row0 = u.pm * BM + wr * 64 + fr, col0 = u.pn * BM + wc * 32 + 8 * fq, z = u.z;
        const unsigned char* G8 = (const unsigned char*)Gt;
#define MH_G(w_, k_) fmaxf((float)(((w_) >> (8 * (k_))) & 0xffu) * (1.f / 255.f), 1e-4f)
        if (z < 2) {
#pragma unroll
            for (int ai = 0; ai < 2; ++ai) {
                v2u ga[4][2], gb[4][2];
#pragma unroll
                for (int m = 0; m < 4; ++m)
#pragma unroll
                    for (int bj = 0; bj < 2; ++bj) { const unsigned char* gp = G8 + (size_t)(row0 + ai * HALF + m * 16) * 3072 + z * 1024 + col0 + bj * HALF; ga[m][bj] = *(const v2u*)gp; gb[m][bj] = *(const v2u*)(gp + 1024); }
#pragma unroll
                for (int m = 0; m < 4; ++m)
#pragma unroll
                    for (int bj = 0; bj < 2; ++bj) { const v2u a = ga[m][bj], b = gb[m][bj];
#pragma unroll
                        for (int k = 0; k < 4; ++k) { acc[ai][bj][m][0][k] *= MH_G(a.x, k) * __builtin_amdgcn_rcpf(MH_G(b.x, k)); acc[ai][bj][m][1][k] *= MH_G(a.y, k) * __builtin_amdgcn_rcpf(MH_G(b.y, k)); } }
            }
            return true;
        }
#pragma unroll
        for (int ai = 0; ai < 2; ++ai) {
            v2u ga[4][2];
#pragma unroll
            for (int m = 0; m < 4; ++m)
#pragma unroll
                for (int bj = 0; bj < 2; ++bj) ga[m][bj] = *(const v2u*)(G8 + (size_t)(row0 + ai * HALF + m * 16) * 3072 + 2 * 1024 + col0 + bj * HALF);
#pragma unroll
            for (int m = 0; m < 4; ++m)
#pragma unroll
                for (int bj = 0; bj < 2; ++bj) { const v2u a = ga[m][bj]; const f32x4 v0 = acc[ai][bj][m][0], v1 = acc[ai][bj][m][1];
                    u32x4 w; w.x = cvt_pk_bf16(v0[0] * MH_G(a.x, 0), v0[1] * MH_G(a.x, 1)); w.y = cvt_pk_bf16(v0[2] * MH_G(a.x, 2), v0[3] * MH_G(a.x, 3));
                    w.z = cvt_pk_bf16(v1[0] * MH_G(a.y, 0), v1[1] * MH_G(a.y, 1)); w.w = cvt_pk_bf16(v1[2] * MH_G(a.y, 2), v1[3] * MH_G(a.y, 3));
                    *(u32x4*)(O + (size_t)(row0 + ai * HALF + m * 16) * ldc + col0 + bj * HALF) = w; }
        }
        return false;
#undef MH_G
    }
};

struct EpiE1 {
    static constexpr bool PERM = true, AFTER_DRAIN = false, INPLACE = false;
    bf16_t* H;
    DI void operator()(const f32x4 (&acc)[2][2][4][2], const Unit& u, int wr, int wc, int fr, int fq) const {
        const int row0 = u.pm * BM + wr * 64 + fr, col0 = u.pn * HALF + wc * 32 + 8 * fq;
#pragma unroll
        for (int ai = 0; ai < 2; ++ai)
#pragma unroll
            for (int m = 0; m < 4; ++m) { const size_t row = (size_t)(row0 + ai * HALF + m * 16);
                f32x4 g0 = acc[ai][0][m][0], g1 = acc[ai][0][m][1]; const f32x4 u0 = acc[ai][1][m][0], u1 = acc[ai][1][m][1];
#pragma unroll
                for (int e = 0; e < 4; ++e) { g0[e] = siluf_(g0[e]) * u0[e]; g1[e] = siluf_(g1[e]) * u1[e]; }
                u32x4 w; w.x = cvt_pk_bf16(g0[0], g0[1]); w.y = cvt_pk_bf16(g0[2], g0[3]); w.z = cvt_pk_bf16(g1[0], g1[1]); w.w = cvt_pk_bf16(g1[2], g1[3]);
                *(u32x4*)(H + row * FF + col0) = w; }
    }
};
struct EpiE2 {
    static constexpr bool PERM = true, AFTER_DRAIN = false, INPLACE = false;
    bf16_t* Y; const float* wgt; const float* modv;
    DI void operator()(const f32x4 (&acc)[2][2][4][2], const Unit& u, int wr, int wc, int fr, int fq) const {
        const int row0 = u.pm * BM + wr * 64 + fr, col0 = u.pn * BM + wc * 32 + 8 * fq;
        const int mi = u.pm < NSLOT_L / 256 ? ((u.pm >> 2) & 7) : 8; const float* g2 = modv + mi * 6144 + 5120 + col0;
        f32x4 ga[2], gb[2]; float tw[2][4];
#pragma unroll
        for (int bj = 0; bj < 2; ++bj) { ga[bj] = *(const f32x4*)(g2 + bj * HALF); gb[bj] = *(const f32x4*)(g2 + bj * HALF + 4); }
#pragma unroll
        for (int ai = 0; ai < 2; ++ai)
#pragma unroll
            for (int m = 0; m < 4; ++m) tw[ai][m] = wgt[row0 + ai * HALF + m * 16];
#pragma unroll
        for (int ai = 0; ai < 2; ++ai)
#pragma unroll
            for (int m = 0; m < 4; ++m) { const int row = row0 + ai * HALF + m * 16;
#pragma unroll
                for (int bj = 0; bj < 2; ++bj) { const int c = col0 + bj * HALF;
                    const f32x4 v0 = acc[ai][bj][m][0] * ga[bj] * tw[ai][m], v1 = acc[ai][bj][m][1] * gb[bj] * tw[ai][m];
                    u32x4 w; w.x = cvt_pk_bf16(v0[0], v0[1]); w.y = cvt_pk_bf16(v0[2], v0[3]); w.z = cvt_pk_bf16(v1[0], v1[1]); w.w = cvt_pk_bf16(v1[2], v1[3]);
                    *(u32x4*)(Y + (size_t)row * DM + c) = w; } }
    }
};
}
namespace attn_body {
using bf16=__hip_bfloat16;
using bf16x8=__attribute__((ext_vector_type(8)))short;
using s16x4=__attribute__((ext_vector_type(4)))short;
using f32x16=__attribute__((ext_vector_type(16)))float;
using u32x4=__attribute__((ext_vector_type(4)))unsigned;
constexpr int D=64;
constexpr int NW=8,QBLK=32,QB=QBLK*NW,KVBLK=64;
constexpr int ATTN_UNIT_ROWS=QB;
__device__ __forceinline__ int crow(int r,int hi){return (r&3)+8*(r>>2)+4*hi;}
#define SBAR() __builtin_amdgcn_sched_barrier(0)
constexpr int NSLOT=3, SLOTB=8192;
constexpr int LDS_K=0, LDS_V=NSLOT*SLOTB, LDS_WS=2*NSLOT*SLOTB, LDS_OST=LDS_WS+NW*64*4, LDS_BYTES=LDS_OST+NW*4096;
__device__ __forceinline__ void glds16(const void*gsrc,unsigned lds_dst){unsigned keep;
  asm volatile("s_mov_b32 %0, m0\n\ts_mov_b32 m0, %2\n\ts_nop 0\n\tglobal_load_lds_dwordx4 %1, off\n\ts_mov_b32 m0, %0":"=&s"(keep):"v"(gsrc),"s"(lds_dst):"memory");}
__device__ __forceinline__ float max3f(float a,float b,float c){float r;asm("v_max3_f32 %0, %1, %2, %3":"=v"(r):"v"(a),"v"(b),"v"(c));return r;}
__device__ __forceinline__ float max2f(float a,float b){float r;asm("v_max_f32_e32 %0, %1, %2":"=v"(r):"v"(a),"v"(b));return r;}
__device__ __forceinline__ float fadd_s(float a,float b){float r;asm("v_add_f32_e32 %0, %1, %2":"=v"(r):"v"(a),"v"(b));return r;}
__device__ __forceinline__ float fsub_s(float a,float b){float r;asm("v_sub_f32_e32 %0, %1, %2":"=v"(r):"v"(a),"v"(b));return r;}
typedef float f32x2_t __attribute__((ext_vector_type(2))); typedef __bf16 bf16x2_t __attribute__((ext_vector_type(2)));
__device__ __forceinline__ unsigned cvtpk_s(float lo,float hi){f32x2_t v={lo,hi};bf16x2_t b=__builtin_convertvector(v,bf16x2_t);return __builtin_bit_cast(unsigned,b);}
#define WAIT_BAR(N) asm volatile("s_waitcnt vmcnt(" #N ") lgkmcnt(0)\n\ts_barrier":::"memory")

__device__ __forceinline__ void qkt(f32x16&p0,f32x16&p1,const char*Kslot,const bf16x8*qr,const f32x16&negm,int r32,int hi){
  const char*kb=Kslot+hi*1024+r32*16;
  #pragma unroll
  for(int d0=0;d0<4;++d0){
    const bf16x8 b0=*reinterpret_cast<const bf16x8*>(kb+d0*2048);
    const bf16x8 b1=*reinterpret_cast<const bf16x8*>(kb+d0*2048+512);
    if(d0==0){p0=__builtin_amdgcn_mfma_f32_32x32x16_bf16(b0,qr[0],negm,0,0,0);p1=__builtin_amdgcn_mfma_f32_32x32x16_bf16(b1,qr[0],negm,0,0,0);}
    else{p0=__builtin_amdgcn_mfma_f32_32x32x16_bf16(b0,qr[d0],p0,0,0,0);p1=__builtin_amdgcn_mfma_f32_32x32x16_bf16(b1,qr[d0],p1,0,0,0);}}
}
typedef __attribute__((address_space(3))) const char* lds_cptr;
typedef short v4i16_t __attribute__((ext_vector_type(4)));
__device__ __forceinline__ void kload8(bf16x8*kf,lds_cptr kp){
  kf[0]=*(const __attribute__((address_space(3))) bf16x8*)(kp);      kf[1]=*(const __attribute__((address_space(3))) bf16x8*)(kp+512);
  kf[2]=*(const __attribute__((address_space(3))) bf16x8*)(kp+2048); kf[3]=*(const __attribute__((address_space(3))) bf16x8*)(kp+2560);
  kf[4]=*(const __attribute__((address_space(3))) bf16x8*)(kp+4096); kf[5]=*(const __attribute__((address_space(3))) bf16x8*)(kp+4608);
  kf[6]=*(const __attribute__((address_space(3))) bf16x8*)(kp+6144); kf[7]=*(const __attribute__((address_space(3))) bf16x8*)(kp+6656);
}
__device__ __forceinline__ void kload2(bf16x8*kf,lds_cptr kp,int j){ kf[2*j]=*(const __attribute__((address_space(3))) bf16x8*)(kp+j*2048); kf[2*j+1]=*(const __attribute__((address_space(3))) bf16x8*)(kp+j*2048+512); }
__device__ __forceinline__ s16x4 vtr(lds_cptr p){ return __builtin_bit_cast(s16x4,__builtin_amdgcn_ds_read_tr16_b64_v4i16((__attribute__((address_space(3))) v4i16_t*)p)); }
__device__ __forceinline__ float rowmax(const f32x16&p0,const f32x16&p1){
  float a=max3f(p0[0],p0[1],p1[0]),b=max3f(p0[2],p0[3],p1[1]);a=max3f(a,p1[2],p1[3]);
  #pragma unroll
  for(int r=4;r<16;r+=4){a=max3f(a,p0[r],p0[r+1]);b=max3f(b,p0[r+2],p0[r+3]);a=max3f(a,p1[r],p1[r+1]);b=max3f(b,p1[r+2],p1[r+3]);}
  const float m=max2f(a,b);
  auto rr=__builtin_amdgcn_permlane32_swap(__float_as_uint(m),__float_as_uint(m),false,false);
  return max2f(__uint_as_float(rr[0]),__uint_as_float(rr[1]));
}
__device__ __forceinline__ void pv(f32x16*o,int vb,bf16x8 pa0,bf16x8 pa1,bf16x8 pa2,bf16x8 pa3){
  #pragma unroll
  for(int d0=0;d0<2;++d0){s16x4 lo[4],hi[4];
    #pragma unroll
    for(int ks=0;ks<4;++ks){
      asm volatile("ds_read_b64_tr_b16 %0,%1 offset:%c2":"=&v"(lo[ks]):"v"(vb),"i"(d0*4096+ks*1024):"memory");
      asm volatile("ds_read_b64_tr_b16 %0,%1 offset:%c2":"=&v"(hi[ks]):"v"(vb),"i"(d0*4096+ks*1024+512):"memory");}
    asm volatile("s_waitcnt lgkmcnt(0)":::"memory");SBAR();
    #define PK(k) (bf16x8){lo[k][0],lo[k][1],lo[k][2],lo[k][3],hi[k][0],hi[k][1],hi[k][2],hi[k][3]}
    o[d0]=__builtin_amdgcn_mfma_f32_32x32x16_bf16(pa0,PK(0),o[d0],0,0,0);
    o[d0]=__builtin_amdgcn_mfma_f32_32x32x16_bf16(pa1,PK(1),o[d0],0,0,0);
    o[d0]=__builtin_amdgcn_mfma_f32_32x32x16_bf16(pa2,PK(2),o[d0],0,0,0);
    o[d0]=__builtin_amdgcn_mfma_f32_32x32x16_bf16(pa3,PK(3),o[d0],0,0,0);
    #undef PK
  }
}

#ifndef ATTN_STORE16
#define ATTN_STORE16(p,v) (*(u32x4*)(p)=(v))
#endif
template<int THRL,bool NOMAX> __device__ __forceinline__ void attn_unit(const bf16*Qu,int QP,const bf16*__restrict__ Kh,int KP,const bf16*__restrict__ Vh,int VP,bf16*Ou,int OP,int NT,char*shm,const int tid){
  const int lane=tid&63,r32=lane&31,hi=lane>>5; const int wid=__builtin_amdgcn_readfirstlane(tid>>6);
  const bf16*Qw=Qu+(long)(wid*QBLK)*QP;
  const unsigned lds0=(unsigned)(uintptr_t)shm;
  float*wsf=(float*)(shm+LDS_WS)+wid*64;
  const bf16*ksrc=Kh+(long)lane*KP+wid*8;
  const bf16*vsrc=Vh+(long)(16*(wid&3)+(lane>>2))*VP+(wid>>2)*32+(lane&3)*8;
  const unsigned kdst=lds0+LDS_K+wid*1024, vdst=lds0+LDS_V+wid*1024;
  #define DMA_K(t,slot) glds16(ksrc+(long)(t)*KVBLK*KP,(unsigned)__builtin_amdgcn_readfirstlane(kdst+(slot)))
  #define DMA_V(t,slot) glds16(vsrc+(long)(t)*KVBLK*VP,(unsigned)__builtin_amdgcn_readfirstlane(vdst+(slot)))
  const int vb0=(int)(lds0+LDS_V)+((lane>>4)&1)*32+(lane&3)*8+(4*hi+((lane&15)>>2))*64;
  const char*Kbase=shm+LDS_K; bf16x8 kf[8];
  const lds_cptr shm3=(lds_cptr)shm; const lds_cptr kp0=shm3+LDS_K+hi*1024+r32*16; const lds_cptr vp0=shm3+LDS_V+((lane>>4)&1)*32+(lane&3)*8+(4*hi+((lane&15)>>2))*64;
  DMA_K(0,0);DMA_V(0,0);DMA_K(1,SLOTB);
  bf16x8 qr[4];
  #pragma unroll
  for(int d0=0;d0<4;++d0)qr[d0]=*reinterpret_cast<const bf16x8*>(&Qw[(long)r32*QP+d0*16+hi*8]);
  float mhat=0.f,l_reg=0.f;f32x16 o[2];o[0]=f32x16{};o[1]=f32x16{};f32x16 negm=f32x16{};asm volatile("":"+v"(negm));
  #define CMASK(P0,P1,t) do{}while(0)
  bool resc=false;
  #define START(P0,P1) do{ resc=false; if constexpr(!NOMAX){ const float rm=rowmax(P0,P1); \
    { const float dl=rm; mhat=fadd_s(mhat,dl); \
      _Pragma("unroll") for(int r=0;r<16;++r){P0[r]=fsub_s(P0[r],dl);P1[r]=fsub_s(P1[r],dl);} \
      _Pragma("unroll") for(int r=0;r<16;++r)negm[r]=-mhat; asm volatile("":"+v"(negm)); } } \
    _Pragma("unroll") for(int r=0;r<16;++r)P0[r]=__builtin_amdgcn_exp2f(P0[r]); }while(0)
  #define RESC() do{ if(resc){ asm volatile("s_waitcnt lgkmcnt(0)":::"memory"); \
      _Pragma("unroll") for(int d_=0;d_<2;++d_) _Pragma("unroll") for(int r=0;r<16;++r)o[d_][r]*=wsf[crow(r,hi)]; } }while(0)
  f32x16 pA0,pA1,pB0,pB1;
  int sl_prev=0,sl_cur=0,sl_next=SLOTB;
  #define ROT() do{sl_prev=sl_cur;sl_cur=sl_next;sl_next=(sl_next==(NSLOT-1)*SLOTB)?0:sl_next+SLOTB;}while(0)
  DMA_K(2,2*SLOTB);
  WAIT_BAR(3);
  qkt(pA0,pA1,Kbase,qr,negm,r32,hi);asm volatile("s_nop 15\n\ts_nop 7":"+v"(pA0),"+v"(pA1));CMASK(pA0,pA1,0);
  START(pA0,pA1);
  _Pragma("unroll") for(int r=0;r<16;++r)pA1[r]=__builtin_amdgcn_exp2f(pA1[r]);
  WAIT_BAR(0);
  DMA_K(3,0);DMA_V(1,SLOTB);
  ROT();
  kload8(kf,kp0+sl_cur);
  WAIT_BAR(2);
  s16x4 vlo[8],vhi[8]; u32x4 pw0,pw1,pw2,pw3;
  #define PKW(P,B) cvtpk_s(P[B],P[B+1])
  #define PAF(k) __builtin_bit_cast(bf16x8,pw##k)
  #define VFR(i) (bf16x8){vlo[i][0],vlo[i][1],vlo[i][2],vlo[i][3],vhi[i][0],vhi[i][1],vhi[i][2],vhi[i][3]}
  #define PIN(x) asm volatile("":"+v"(x))
  #define MX3(a,b,c) __builtin_fmaxf(__builtin_fmaxf((a),(b)),(c))
  #define GAPA(MF,A0,A1,A2,A3,W0,W1,PW) do{ MF; sacc+=A0; sacc+=A1; sacc+=A2; sacc+=A3; PIN(sacc); W0; W1; PIN(PW); SBAR(); }while(0)
  #define EX(v) __builtin_amdgcn_exp2f(v)
  #define GAPB(MF,X,B) do{ MF; X[B]=EX(X[B]); X[B+1]=EX(X[B+1]); X[B+2]=EX(X[B+2]); X[B+3]=EX(X[B+3]); PIN(X); SBAR(); }while(0)
  #define VRD(i) do{ vlo[i]=vtr(vp_+(((i)>>2)*4096+((i)&3)*1024)); vhi[i]=vtr(vp_+(((i)>>2)*4096+((i)&3)*1024+512)); }while(0)
  #define KRD(G,j) do{ if(G){ kload2(kf,kp0+sl_next,j); SBAR(); } }while(0)
  #define NEGM_OP (NOMAX?f32x16{}:negm)
  #define STEP(C0,C1,P0,P1,t,GK,GV,GL) do{ SBAR(); \
    const lds_cptr vp_=vp0+sl_prev; \
    VRD(0); SBAR(); float sacc=(P0[0]+P0[1]); \
    GAPA(C0=__builtin_amdgcn_mfma_f32_32x32x16_bf16(kf[0],qr[0],NEGM_OP,0,0,0), P0[2],P0[3],P0[4],P0[5],     pw0[0]=PKW(P0,0), pw0[1]=PKW(P0,2), pw0); \
    VRD(4); SBAR(); GAPA(C1=__builtin_amdgcn_mfma_f32_32x32x16_bf16(kf[1],qr[0],NEGM_OP,0,0,0), P0[6],P0[7],P0[8],P0[9],     pw0[2]=PKW(P0,4), pw0[3]=PKW(P0,6), pw0); \
    VRD(1); SBAR(); GAPA(C0=__builtin_amdgcn_mfma_f32_32x32x16_bf16(kf[2],qr[1],C0,0,0,0),   P0[10],P0[11],P0[12],P0[13], pw1[0]=PKW(P0,8), pw1[1]=PKW(P0,10), pw1); \
    VRD(5); SBAR(); GAPA(C1=__builtin_amdgcn_mfma_f32_32x32x16_bf16(kf[3],qr[1],C1,0,0,0),   P0[14],P0[15],P1[0],P1[1],   pw1[2]=PKW(P0,12),pw1[3]=PKW(P0,14), pw1); \
    VRD(2); SBAR(); GAPA(C0=__builtin_amdgcn_mfma_f32_32x32x16_bf16(kf[4],qr[2],C0,0,0,0),   P1[2],P1[3],P1[4],P1[5],     pw2[0]=PKW(P1,0), pw2[1]=PKW(P1,2), pw2); \
    VRD(6); SBAR(); GAPA(C1=__builtin_amdgcn_mfma_f32_32x32x16_bf16(kf[5],qr[2],C1,0,0,0),   P1[6],P1[7],P1[8],P1[9],     pw2[2]=PKW(P1,4), pw2[3]=PKW(P1,6), pw2); \
    VRD(3); SBAR(); GAPA(C0=__builtin_amdgcn_mfma_f32_32x32x16_bf16(kf[6],qr[3],C0,0,0,0),   P1[10],P1[11],P1[12],P1[13], pw3[0]=PKW(P1,8), pw3[1]=PKW(P1,10), pw3); \
    VRD(7); SBAR(); GAPA(C1=__builtin_amdgcn_mfma_f32_32x32x16_bf16(kf[7],qr[3],C1,0,0,0),   P1[14],P1[15],0.f,0.f,       pw3[2]=PKW(P1,12),pw3[3]=PKW(P1,14), pw3); \
    l_reg+=sacc; \
    if(GK){DMA_K((t)+3,sl_cur);} if(GV){DMA_V((t)+1,sl_next);} \
    if constexpr(!NOMAX) \
    { float a=MX3(C0[0],C0[1],C1[0]),b=MX3(C0[2],C0[3],C1[1]); a=MX3(a,C1[2],C1[3]); \
      _Pragma("unroll") for(int r=4;r<16;r+=4){a=MX3(a,C0[r],C0[r+1]);b=MX3(b,C0[r+2],C0[r+3]);a=MX3(a,C1[r],C1[r+1]);b=MX3(b,C1[r+2],C1[r+3]);} \
      float rm=__builtin_fmaxf(a,b); { auto rr=__builtin_amdgcn_permlane32_swap(__float_as_uint(rm),__float_as_uint(rm),false,false); rm=__builtin_fmaxf(__uint_as_float(rr[0]),__uint_as_float(rr[1])); } \
      resc=false; \
      if(__builtin_expect(__any(rm>(float)THRL),0)){ const float dl=__builtin_fmaxf(rm,0.f); mhat+=dl; \
        _Pragma("unroll") for(int r=0;r<16;++r){C0[r]-=dl;C1[r]-=dl;} \
        _Pragma("unroll") for(int r=0;r<16;++r)negm[r]=-mhat; asm volatile("":"+v"(negm)); \
        const float f=__builtin_amdgcn_exp2f(-dl); l_reg*=f; if(hi==0)wsf[r32]=f; resc=true; } } \
    SBAR(); \
    GAPB(o[0]=__builtin_amdgcn_mfma_f32_32x32x16_bf16(PAF(0),VFR(0),o[0],0,0,0), C0,0); \
    GAPB(o[1]=__builtin_amdgcn_mfma_f32_32x32x16_bf16(PAF(0),VFR(4),o[1],0,0,0), C0,4); \
    KRD(GL,0); GAPB(o[0]=__builtin_amdgcn_mfma_f32_32x32x16_bf16(PAF(1),VFR(1),o[0],0,0,0), C0,8); \
    KRD(GL,1); GAPB(o[1]=__builtin_amdgcn_mfma_f32_32x32x16_bf16(PAF(1),VFR(5),o[1],0,0,0), C0,12); \
    KRD(GL,2); GAPB(o[0]=__builtin_amdgcn_mfma_f32_32x32x16_bf16(PAF(2),VFR(2),o[0],0,0,0), C1,0); \
    KRD(GL,3); GAPB(o[1]=__builtin_amdgcn_mfma_f32_32x32x16_bf16(PAF(2),VFR(6),o[1],0,0,0), C1,4); \
    GAPB(o[0]=__builtin_amdgcn_mfma_f32_32x32x16_bf16(PAF(3),VFR(3),o[0],0,0,0), C1,8); \
    GAPB(o[1]=__builtin_amdgcn_mfma_f32_32x32x16_bf16(PAF(3),VFR(7),o[1],0,0,0), C1,12); \
    }while(0)
  int t=1;
  for(;t+5<NT;t+=2){
    STEP(pB0,pB1,pA0,pA1,t,true,true,true);     WAIT_BAR(2); RESC(); ROT();
    STEP(pA0,pA1,pB0,pB1,t+1,true,true,true);   WAIT_BAR(2); RESC(); ROT();
  }
  #define ENDW(tt) do{ if((tt)+3<NT){WAIT_BAR(2);} else if((tt)+2<NT){WAIT_BAR(1);} else {WAIT_BAR(0);} }while(0)
  for(;t+1<NT;t+=2){
    STEP(pB0,pB1,pA0,pA1,t,(t+3<NT),(t+1<NT),(t+1<NT));       ENDW(t);   RESC(); ROT();
    STEP(pA0,pA1,pB0,pB1,t+1,(t+4<NT),(t+2<NT),(t+2<NT));     ENDW(t+1); RESC(); ROT();
  }
  STEP(pB0,pB1,pA0,pA1,NT-1,false,false,false); RESC();
  { float sacc=pB0[0]+pB0[1]; _Pragma("unroll") for(int r=2;r<16;++r)sacc+=pB0[r]; _Pragma("unroll") for(int r=0;r<16;++r)sacc+=pB1[r]; l_reg+=sacc;
    pw0=(u32x4){PKW(pB0,0),PKW(pB0,2),PKW(pB0,4),PKW(pB0,6)};pw1=(u32x4){PKW(pB0,8),PKW(pB0,10),PKW(pB0,12),PKW(pB0,14)};pw2=(u32x4){PKW(pB1,0),PKW(pB1,2),PKW(pB1,4),PKW(pB1,6)};pw3=(u32x4){PKW(pB1,8),PKW(pB1,10),PKW(pB1,12),PKW(pB1,14)};
    SBAR(); pv(o,vb0+sl_cur,PAF(0),PAF(1),PAF(2),PAF(3)); }
  #undef PKW
  #undef PAF
  #undef VFR
  #undef PIN
  #undef MX3
  #undef GAPA
  #undef GAPB
  #undef EX
  #undef VRD
  #undef KRD
  #undef STEP
  #undef ENDW
  #ifdef NEGM_OP
  #undef NEGM_OP
  #endif
  {auto rr=__builtin_amdgcn_permlane32_swap(__float_as_uint(l_reg),__float_as_uint(l_reg),false,false);l_reg=__uint_as_float(rr[0])+__uint_as_float(rr[1]);}
  if(hi==0)wsf[32+r32]=l_reg;asm volatile("s_waitcnt lgkmcnt(0)":::"memory");
  float rli[16];
  #pragma unroll
  for(int r=0;r<16;++r)rli[r]=__builtin_amdgcn_rcpf(wsf[32+crow(r,hi)]);
  bf16*Ow=Ou+(long)(wid*QBLK)*OP;
  { bf16*stg=(bf16*)(shm+LDS_OST)+wid*2048;
    #pragma unroll
    for(int r=0;r<16;++r){const int orow=crow(r,hi);
      #pragma unroll
      for(int d0=0;d0<2;++d0)stg[orow*64+d0*32+r32]=__float2bfloat16(o[d0][r]*rli[r]);}
    asm volatile("s_waitcnt lgkmcnt(0)":::"memory");
    #pragma unroll
    for(int i=0;i<4;++i){const int row=i*8+(lane>>3),ch=lane&7; const u32x4 v=*(const u32x4*)(stg+row*64+ch*8); ATTN_STORE16(Ow+(long)row*OP+ch*8,v);} }
  asm volatile("s_waitcnt lgkmcnt(0)\n\ts_barrier":::"memory");
  #undef DMA_K
  #undef DMA_V
  #undef CMASK
  #undef START
  #undef RESC
  #undef ROT
}
constexpr int LDS_WS128=LDS_V+NSLOT*2*SLOTB, LDS_OST128=LDS_WS128+NW*64*4, LDS_BYTES128=LDS_OST128+NW*4096;
template<int THRL,bool NOMAX> __device__ __forceinline__ void attn_unit128(const bf16*Qu,int QP,const bf16*__restrict__ Kh,int KP,const bf16*__restrict__ Vh,int VP,bf16*Ou,int OP,int NT,char*shm,const int tid){
  const int lane=tid&63,r32=lane&31,hi=lane>>5; const int wid=__builtin_amdgcn_readfirstlane(tid>>6);
  const bf16*Qw=Qu+(long)(wid*QBLK)*QP;
  const unsigned lds0=(unsigned)(uintptr_t)shm;
  float*wsf=(float*)(shm+LDS_WS128)+wid*64;
  const bf16*ksrc=Kh+(long)lane*KP+wid*8;
  const bf16*vsrc=Vh+(long)(16*(wid&3)+(lane>>2))*VP+(wid>>2)*32+(lane&3)*8;
  const unsigned kdst=lds0+LDS_K+wid*1024, vdst=lds0+LDS_V+wid*1024;
  #define DMA_K(t,slot) glds16(ksrc+(long)(t)*KVBLK*KP,(unsigned)__builtin_amdgcn_readfirstlane(kdst+(slot)))
  #define DMA_V(t,slot) do{ glds16(vsrc+(long)(t)*KVBLK*VP,(unsigned)__builtin_amdgcn_readfirstlane(vdst+2*(slot))); glds16(vsrc+64+(long)(t)*KVBLK*VP,(unsigned)__builtin_amdgcn_readfirstlane(vdst+2*(slot)+8192)); }while(0)
  const int vb0=(int)(lds0+LDS_V)+((lane>>4)&1)*32+(lane&3)*8+(4*hi+((lane&15)>>2))*64;
  const char*Kbase=shm+LDS_K; bf16x8 kf[8];
  const lds_cptr shm3=(lds_cptr)shm; const lds_cptr kp0=shm3+LDS_K+hi*1024+r32*16; const lds_cptr vp0=shm3+LDS_V+((lane>>4)&1)*32+(lane&3)*8+(4*hi+((lane&15)>>2))*64;
  DMA_K(0,0);DMA_V(0,0);DMA_K(1,SLOTB);
  bf16x8 qr[4];
  #pragma unroll
  for(int d0=0;d0<4;++d0)qr[d0]=*reinterpret_cast<const bf16x8*>(&Qw[(long)r32*QP+d0*16+hi*8]);
  float mhat=0.f,l_reg=0.f;f32x16 o[4];o[0]=f32x16{};o[1]=f32x16{};o[2]=f32x16{};o[3]=f32x16{};const f32x16 zero16=f32x16{};
  #define CMASK(P0,P1,t) do{}while(0)
  bool resc=false;
  #define START(P0,P1) do{ resc=false; if constexpr(!NOMAX){ const float rm=rowmax(P0,P1); \
    { const float dl=rm; mhat=fadd_s(mhat,dl); \
      _Pragma("unroll") for(int r=0;r<16;++r){P0[r]=fsub_s(P0[r],dl);P1[r]=fsub_s(P1[r],dl);} } } \
    _Pragma("unroll") for(int r=0;r<16;++r)P0[r]=__builtin_amdgcn_exp2f(P0[r]); }while(0)
  #define RESC() do{ if(resc){ asm volatile("s_waitcnt lgkmcnt(0)":::"memory"); \
      _Pragma("unroll") for(int d_=0;d_<4;++d_) _Pragma("unroll") for(int r=0;r<16;++r)o[d_][r]*=wsf[crow(r,hi)]; } }while(0)
  f32x16 pA0,pA1,pB0,pB1;
  int sl_prev=0,sl_cur=0,sl_next=SLOTB;
  #define ROT() do{sl_prev=sl_cur;sl_cur=sl_next;sl_next=(sl_next==(NSLOT-1)*SLOTB)?0:sl_next+SLOTB;}while(0)
  DMA_K(2,2*SLOTB);
  WAIT_BAR(3);
  qkt(pA0,pA1,Kbase,qr,zero16,r32,hi);asm volatile("s_nop 15\n\ts_nop 7":"+v"(pA0),"+v"(pA1));CMASK(pA0,pA1,0);
  START(pA0,pA1);
  _Pragma("unroll") for(int r=0;r<16;++r)pA1[r]=__builtin_amdgcn_exp2f(pA1[r]);
  WAIT_BAR(0);
  DMA_K(3,0);DMA_V(1,SLOTB);
  ROT();
  kload8(kf,kp0+sl_cur);
  WAIT_BAR(3);
  s16x4 vlo[8],vhi[8]; u32x4 pw0,pw1,pw2,pw3;
  #define PKW(P,B) cvtpk_s(P[B],P[B+1])
  #define PAF(k) __builtin_bit_cast(bf16x8,pw##k)
  #define VFR(i) (bf16x8){vlo[i][0],vlo[i][1],vlo[i][2],vlo[i][3],vhi[i][0],vhi[i][1],vhi[i][2],vhi[i][3]}
  #define PIN(x) asm volatile("":"+v"(x))
  #define MX3(a,b,c) __builtin_fmaxf(__builtin_fmaxf((a),(b)),(c))
  #define GAPA(MF,A0,A1,A2,A3,W0,W1,PW) do{ MF; sacc+=A0; sacc+=A1; sacc+=A2; sacc+=A3; PIN(sacc); W0; W1; PIN(PW); SBAR(); }while(0)
  #define EX(v) __builtin_amdgcn_exp2f(v)
  #define GAPB(MF,X,B) do{ MF; if constexpr(NOMAX){ X[B]=EX(X[B]); X[B+1]=EX(X[B+1]); } else { X[B]=EX(X[B]-mhat); X[B+1]=EX(X[B+1]-mhat); } PIN(X); SBAR(); }while(0)
  #define VRD(i) do{ vlo[i]=vtr(vp_+(((i)>>2)*4096+((i)&3)*1024)); vhi[i]=vtr(vp_+(((i)>>2)*4096+((i)&3)*1024+512)); }while(0)
  #define VRD2(i) do{ vlo[i]=vtr(vp_+((((i)>>2)+2)*4096+((i)&3)*1024)); vhi[i]=vtr(vp_+((((i)>>2)+2)*4096+((i)&3)*1024+512)); SBAR(); }while(0)
  #define KRD(G,j) do{ if(G){ kload2(kf,kp0+sl_next,j); SBAR(); } }while(0)
  #define MF32(a,b,c) __builtin_amdgcn_mfma_f32_32x32x16_bf16(a,b,c,0,0,0)
  #define STEP(C0,C1,P0,P1,t,GK,GV,GL) do{ SBAR(); \
    const lds_cptr vp_=vp0+2*sl_prev; \
    VRD(0); SBAR(); float sacc=(P0[0]+P0[1]); \
    GAPA(C0=MF32(kf[0],qr[0],zero16), P0[2],P0[3],P0[4],P0[5],     pw0[0]=PKW(P0,0), pw0[1]=PKW(P0,2), pw0); \
    VRD(4); SBAR(); GAPA(C1=MF32(kf[1],qr[0],zero16), P0[6],P0[7],P0[8],P0[9],     pw0[2]=PKW(P0,4), pw0[3]=PKW(P0,6), pw0); \
    VRD(1); SBAR(); GAPA(C0=MF32(kf[2],qr[1],C0),   P0[10],P0[11],P0[12],P0[13], pw1[0]=PKW(P0,8), pw1[1]=PKW(P0,10), pw1); \
    VRD(5); SBAR(); GAPA(C1=MF32(kf[3],qr[1],C1),   P0[14],P0[15],P1[0],P1[1],   pw1[2]=PKW(P0,12),pw1[3]=PKW(P0,14), pw1); \
    VRD(2); SBAR(); GAPA(C0=MF32(kf[4],qr[2],C0),   P1[2],P1[3],P1[4],P1[5],     pw2[0]=PKW(P1,0), pw2[1]=PKW(P1,2), pw2); \
    VRD(6); SBAR(); GAPA(C1=MF32(kf[5],qr[2],C1),   P1[6],P1[7],P1[8],P1[9],     pw2[2]=PKW(P1,4), pw2[3]=PKW(P1,6), pw2); \
    VRD(3); SBAR(); GAPA(C0=MF32(kf[6],qr[3],C0),   P1[10],P1[11],P1[12],P1[13], pw3[0]=PKW(P1,8), pw3[1]=PKW(P1,10), pw3); \
    VRD(7); SBAR(); GAPA(C1=MF32(kf[7],qr[3],C1),   P1[14],P1[15],0.f,0.f,       pw3[2]=PKW(P1,12),pw3[3]=PKW(P1,14), pw3); \
    l_reg+=sacc; \
    if(GK){DMA_K((t)+3,sl_cur);} if(GV){DMA_V((t)+1,sl_next);} \
    if constexpr(!NOMAX) \
    { float a=MX3(C0[0],C0[1],C1[0]),b=MX3(C0[2],C0[3],C1[1]); a=MX3(a,C1[2],C1[3]); \
      _Pragma("unroll") for(int r=4;r<16;r+=4){a=MX3(a,C0[r],C0[r+1]);b=MX3(b,C0[r+2],C0[r+3]);a=MX3(a,C1[r],C1[r+1]);b=MX3(b,C1[r+2],C1[r+3]);} \
      float rm=__builtin_fmaxf(a,b); { auto rr=__builtin_amdgcn_permlane32_swap(__float_as_uint(rm),__float_as_uint(rm),false,false); rm=__builtin_fmaxf(__uint_as_float(rr[0]),__uint_as_float(rr[1])); } \
      rm-=mhat; resc=false;                                 \
      if(__builtin_expect(__any(rm>(float)THRL),0)){ const float dl=__builtin_fmaxf(rm,0.f); mhat+=dl; \
        const float f=__builtin_amdgcn_exp2f(-dl); l_reg*=f; if(hi==0)wsf[r32]=f; resc=true; } } \
    SBAR(); \
    GAPB(o[0]=MF32(PAF(0),VFR(0),o[0]), C0,0);  VRD2(0); \
    GAPB(o[1]=MF32(PAF(0),VFR(4),o[1]), C0,2);  VRD2(4); \
    KRD(GL,0); GAPB(o[0]=MF32(PAF(1),VFR(1),o[0]), C0,4);  VRD2(1); \
    KRD(GL,1); GAPB(o[1]=MF32(PAF(1),VFR(5),o[1]), C0,6);  VRD2(5); \
    KRD(GL,2); GAPB(o[0]=MF32(PAF(2),VFR(2),o[0]), C0,8);  VRD2(2); \
    KRD(GL,3); GAPB(o[1]=MF32(PAF(2),VFR(6),o[1]), C0,10); VRD2(6); \
    GAPB(o[0]=MF32(PAF(3),VFR(3),o[0]), C0,12); VRD2(3); \
    GAPB(o[1]=MF32(PAF(3),VFR(7),o[1]), C0,14); VRD2(7); \
    GAPB(o[2]=MF32(PAF(0),VFR(0),o[2]), C1,0); \
    GAPB(o[3]=MF32(PAF(0),VFR(4),o[3]), C1,2); \
    GAPB(o[2]=MF32(PAF(1),VFR(1),o[2]), C1,4); \
    GAPB(o[3]=MF32(PAF(1),VFR(5),o[3]), C1,6); \
    GAPB(o[2]=MF32(PAF(2),VFR(2),o[2]), C1,8); \
    GAPB(o[3]=MF32(PAF(2),VFR(6),o[3]), C1,10); \
    GAPB(o[2]=MF32(PAF(3),VFR(3),o[2]), C1,12); \
    GAPB(o[3]=MF32(PAF(3),VFR(7),o[3]), C1,14); \
    }while(0)
  int t=1;
  for(;t+5<NT;t+=2){
    STEP(pB0,pB1,pA0,pA1,t,true,true,true);     WAIT_BAR(3); RESC(); ROT();
    STEP(pA0,pA1,pB0,pB1,t+1,true,true,true);   WAIT_BAR(3); RESC(); ROT();
  }
  #define ENDW(tt) do{ if((tt)+3<NT){WAIT_BAR(3);} else if((tt)+2<NT){WAIT_BAR(2);} else {WAIT_BAR(0);} }while(0)
  for(;t+1<NT;t+=2){
    STEP(pB0,pB1,pA0,pA1,t,(t+3<NT),(t+1<NT),(t+1<NT));       ENDW(t);   RESC(); ROT();
    STEP(pA0,pA1,pB0,pB1,t+1,(t+4<NT),(t+2<NT),(t+2<NT));     ENDW(t+1); RESC(); ROT();
  }
  STEP(pB0,pB1,pA0,pA1,NT-1,false,false,false); RESC();
  { float sacc=pB0[0]+pB0[1]; _Pragma("unroll") for(int r=2;r<16;++r)sacc+=pB0[r]; _Pragma("unroll") for(int r=0;r<16;++r)sacc+=pB1[r]; l_reg+=sacc;
    pw0=(u32x4){PKW(pB0,0),PKW(pB0,2),PKW(pB0,4),PKW(pB0,6)};pw1=(u32x4){PKW(pB0,8),PKW(pB0,10),PKW(pB0,12),PKW(pB0,14)};pw2=(u32x4){PKW(pB1,0),PKW(pB1,2),PKW(pB1,4),PKW(pB1,6)};pw3=(u32x4){PKW(pB1,8),PKW(pB1,10),PKW(pB1,12),PKW(pB1,14)};
    SBAR(); pv(o,vb0+2*sl_cur,PAF(0),PAF(1),PAF(2),PAF(3)); pv(o+2,vb0+2*sl_cur+8192,PAF(0),PAF(1),PAF(2),PAF(3)); }
  #undef PKW
  #undef PAF
  #undef VFR
  #undef PIN
  #undef MX3
  #undef GAPA
  #undef GAPB
  #undef EX
  #undef VRD
  #undef VRD2
  #undef MF32
  #undef KRD
  #undef STEP
  #undef ENDW
  {auto rr=__builtin_amdgcn_permlane32_swap(__float_as_uint(l_reg),__float_as_uint(l_reg),false,false);l_reg=__uint_as_float(rr[0])+__uint_as_float(rr[1]);}
  if(hi==0)wsf[32+r32]=l_reg;asm volatile("s_waitcnt lgkmcnt(0)":::"memory");
  float rli[16];
  #pragma unroll
  for(int r=0;r<16;++r)rli[r]=__builtin_amdgcn_rcpf(wsf[32+crow(r,hi)]);
  bf16*Ow=Ou+(long)(wid*QBLK)*OP;
  { bf16*stg=(bf16*)(shm+LDS_OST128)+wid*2048;
    #pragma unroll
    for(int hb=0;hb<2;++hb){
      #pragma unroll
      for(int r=0;r<16;++r){const int orow=crow(r,hi);
        #pragma unroll
        for(int d0=0;d0<2;++d0)stg[orow*64+d0*32+r32]=__float2bfloat16(o[2*hb+d0][r]*rli[r]);}
      asm volatile("s_waitcnt lgkmcnt(0)":::"memory");
      #pragma unroll
      for(int i=0;i<4;++i){const int row=i*8+(lane>>3),ch=lane&7; const u32x4 v=*(const u32x4*)(stg+row*64+ch*8); ATTN_STORE16(Ow+(long)row*OP+hb*64+ch*8,v);}
      asm volatile("s_waitcnt lgkmcnt(0)":::"memory"); } }
  asm volatile("s_waitcnt lgkmcnt(0)\n\ts_barrier":::"memory");
  #undef DMA_K
  #undef DMA_V
  #undef CMASK
  #undef START
  #undef RESC
  #undef ROT
}
constexpr int ATTN_LDS_BYTES=LDS_BYTES128;
#undef SBAR
#undef WAIT_BAR
}
typedef const float* const __attribute__((address_space(4)))* kin_ptr;
struct InTab { kin_ptr p; DI const float* operator[](int i) const { return (const float*)(const GAS float*)p[i]; } };
struct Frame {
    LAS unsigned char* lds; volatile LAS unsigned* MISC; gu32* ctl;
    int tid, lane, wave, vcu, G, gw, NGW, bx;
    InTab in; float* out; unsigned char* ws;
};
DI const float* modv_of(const Frame& F, int li) { return (const float*)(F.ws + WS_MODV) + (size_t)li * 9 * 6144; }
DI const float* lat_x(const Frame& F, int li) { return li == 0 ? F.in[I_X] : F.out; }
DI const float* ctx_x(const Frame& F, int li) { return li == 0 ? F.in[I_CTX] : (const float*)(F.ws + WS_XC); }

DI void phase_p0(const Frame& F) {
    LAS float* act = (LAS float*)F.lds;
    LAS float* part = (LAS float*)(F.lds + 36864);
    bool loaded = false;
    for (int u = F.bx; u < NLAYER * 96; u += F.G) {
        const int li = u / 96, n0 = (u % 96) * 64;
        if (!loaded) {
            for (int i = F.tid; i < 9 * 1024; i += 512) { const int m = i >> 10, k = i & 1023; const float c = m < 8 ? F.in[I_C][m * 1024 + k] : F.in[I_CCTX][k]; act[i] = siluf_(c); }
            loaded = true;
        }
        __syncthreads();
        float acc[9];
#pragma unroll
        for (int m = 0; m < 9; ++m) acc[m] = 0.f;
        const float* W = F.in[I_WMOD] + (size_t)li * 1024 * 6144 + n0 + F.lane;
        const int k0 = F.wave * 128;
        for (int k = k0; k < k0 + 128; k += 4) {
            float wv[4];
#pragma unroll
            for (int e = 0; e < 4; ++e) wv[e] = W[(size_t)(k + e) * 6144];
#pragma unroll
            for (int m = 0; m < 9; ++m) { const f32x4 a = *(const LAS f32x4*)(act + m * 1024 + k); acc[m] += a[0] * wv[0] + a[1] * wv[1] + a[2] * wv[2] + a[3] * wv[3]; }
        }
#pragma unroll
        for (int m = 0; m < 9; ++m) part[(F.wave * 9 + m) * 64 + F.lane] = acc[m];
        __syncthreads();
        for (int i = F.tid; i < 9 * 64; i += 512) { const int m = i >> 6, l = i & 63; float s = 0.f;
#pragma unroll
            for (int w = 0; w < 8; ++w) s += part[(w * 9 + m) * 64 + l];
            ((float*)(F.ws + WS_MODV))[((size_t)li * 9 + m) * 6144 + n0 + l] = s + F.in[I_BMOD][li * 6144 + n0 + l]; }
        __syncthreads();
    }
    if (F.bx == F.G - 1) {
        float* rope = (float*)(F.ws + WS_ROPE);
        for (int i = F.tid; i < 128 * 16; i += 512) { const int pos = i >> 4, f = i & 15; const float inv = powf(10000.f, -(float)(2 * f) / 32.f); const float ang = (float)pos * inv; float s, c; sincosf(ang, &s, &c); rope[2 * i] = c; rope[2 * i + 1] = s; }
        if (F.wave < NLAYER) {
            const int li = F.wave; const int l = F.lane;
            const float a = wave_sum(F.in[I_LQ1][li * 64 + l] * F.in[I_LK1][li * 64 + l]), b = wave_sum(F.in[I_LQ2][li * 64 + l] * F.in[I_LK2][li * 64 + l]);
            const float lam_init = 0.8f - 0.6f * expf(-0.3f * (float)li);
            if (l == 0) { float* L = (float*)(F.ws + WS_LAM) + li * 4; L[0] = expf(a) - expf(b) + lam_init; L[1] = 1.f - lam_init; }
            float mq = fabsf(F.in[I_GQN][li * 64 + l]), mk = fabsf(F.in[I_GKN][li * 64 + l]), dq = fabsf(F.in[I_DQN][li * 64 + l]), dk = fabsf(F.in[I_DKN][li * 64 + l]);
#pragma unroll
            for (int o = 1; o < 64; o <<= 1) { mq = fmaxf(mq, __shfl_xor(mq, o)); mk = fmaxf(mk, __shfl_xor(mk, o)); dq = fmaxf(dq, __shfl_xor(dq, o)); dk = fmaxf(dk, __shfl_xor(dk, o)); }
            if (l == 0) { float* L = (float*)(F.ws + WS_LAM) + li * 4; L[2] = 64.f * mq * mk * C2Q; L[3] = 64.f * dq * dk * C2Q; }
        }
    }
    { const f32x4* s = (const f32x4*)F.in[I_CTX]; f32x4* d = (f32x4*)(F.ws + WS_XC); const int n4 = NB * CTXL * DM / 4;
      for (int i = F.bx * 512 + F.tid; i < n4; i += F.G * 512) d[i] = s[i]; }
}

DI void transpose_item(const float* W, int ldw, int k0, int n0, bf16* WT, int ldd, int drow0, LAS float* scr, int lane) {
#pragma unroll 8
    for (int i = 0; i < 32; ++i) { const int kk = 2 * i + (lane >> 5); scr[kk * 33 + (lane & 31)] = W[(size_t)(k0 + kk) * ldw + n0 + (lane & 31)]; }
    LDS_WAIT(); asm volatile("" ::: "memory");
    const int c = lane & 7;
#pragma unroll
    for (int j = 0; j < 4; ++j) { const int n = (lane >> 3) + 8 * j; const LAS float* s = scr + (8 * c) * 33 + n;
        v4u o; o.x = pk2(s[0 * 33], s[1 * 33]); o.y = pk2(s[2 * 33], s[3 * 33]); o.z = pk2(s[4 * 33], s[5 * 33]); o.w = pk2(s[6 * 33], s[7 * 33]);
        *(v4u*)(WT + (size_t)(drow0 + n) * ldd + k0 + 8 * c) = o; }
    LDS_WAIT(); asm volatile("" ::: "memory");
}
DI void phase_wx(const Frame& F, int li) {
    LAS float* scr = (LAS float*)(F.lds + F.wave * 16384);
    unsigned char* wm = F.ws + WS_WMIX; unsigned char* we = F.ws + WS_WEXP;
    constexpr int I_IN = 16 * 136, I_G = 3 * 16 * 32, I_B = 3 * 8 * 32, I_O = 16 * 32, I_E = 16 * 16 * 32;
    constexpr int NITEMS = I_IN + I_G + I_B + I_O + 3 * I_E;
    for (int it = F.gw; it < NITEMS; it += F.NGW) {
        int r = it;
        if (r < I_IN) { const int kb = r / 136, nb = r % 136, n0 = nb * 32, pn = n0 >> 8, wi = n0 & 255, wc = wi >> 6, bj = (wi >> 5) & 1;
            transpose_item(F.in[I_WIN] + (size_t)li * 1024 * INCOLS, INCOLS, kb * 64, n0, (bf16*)(wm + WM_WIN), 1024, pn * 256 + bj * 128 + wc * 32, scr, F.lane); continue; } r -= I_IN;
        if (r < I_G) { const int i = r / 512, q = r % 512, kb = q / 32, nb = q % 32;
            transpose_item(F.in[I_WMG] + ((size_t)li * 3 + i) * 1024 * 1024, 1024, kb * 64, nb * 32, (bf16*)(wm + WM_WG), 1024, i * 1024 + nb * 32, scr, F.lane); continue; } r -= I_G;
        if (r < I_B) { const int i = r / 256, q = r % 256, kb = q / 32, nb = q % 32;
            transpose_item(F.in[I_WBR] + ((size_t)li * 3 + i) * 512 * 1024, 1024, kb * 64, nb * 32, (bf16*)(wm + WM_WB) + (size_t)i * 1024 * 512, 512, nb * 32, scr, F.lane); continue; } r -= I_B;
        if (r < I_O) { const int kb = r / 32, nb = r % 32;
            transpose_item(F.in[I_WOUT] + (size_t)li * 1024 * 1024, 1024, kb * 64, nb * 32, (bf16*)(wm + WM_WO), 1024, nb * 32, scr, F.lane); continue; } r -= I_O;
        { const int which = r / I_E, q = r % I_E, e = q / 512, q2 = q % 512, kb = q2 / 32, nb = q2 % 32, n0 = nb * 32;
          const size_t eo = ((size_t)li * NEXP + e) * 1024 * 1024;
          if (which == 0)      transpose_item(F.in[I_WEG] + eo, 1024, kb * 64, n0, (bf16*)(we + WE_GU) + (size_t)e * 2048 * 1024, 1024, (n0 >> 7) * 256 + (n0 & 127), scr, F.lane);
          else if (which == 1) transpose_item(F.in[I_WEU] + eo, 1024, kb * 64, n0, (bf16*)(we + WE_GU) + (size_t)e * 2048 * 1024, 1024, (n0 >> 7) * 256 + 128 + (n0 & 127), scr, F.lane);
          else                 transpose_item(F.in[I_WED] + eo, 1024, kb * 64, n0, (bf16*)(we + WE_D) + (size_t)e * 1024 * 1024, 1024, n0, scr, F.lane); }
    }
}

template <int WHICH> DI void phase_norm(const Frame& F, int li) {
    const float* nw = F.in[WHICH == 0 ? I_N1W : I_N2W] + li * 1024; const float* mv = modv_of(F, li);
    const float* xl = lat_x(F, li); const float* xc = ctx_x(F, li);
    const bf16* YO = (const bf16*)(F.ws + WS_G);
    bf16* H = (bf16*)(F.ws + WS_H);
    f32x4 nwv[4];
#pragma unroll
    for (int j = 0; j < 4; ++j) nwv[j] = *(const f32x4*)(nw + 4 * F.lane + 256 * j);
    const float* g1b = mv + 2048 + 4 * F.lane;
#define NORM_ROWPTR(row_, b_, t_, lat_, xr_) const int b_ = (row_) / TPB, t_ = (row_) - b_ * TPB; const bool lat_ = t_ < SEQ; \
        const float* xr_ = (lat_ ? xl + ((size_t)b_ * SEQ + t_) * DM : xc + ((size_t)b_ * CTXL + (t_ - SEQ)) * DM) + 4 * F.lane;
    f32x4 s1v[4], s0v[4], g1v[4]; int mi_prev = -1;
    f32x4 vn[4]; v2u yn[4];
    if (F.gw < MROWS) { NORM_ROWPTR(F.gw, b_, t_, lat_, xr_);
#pragma unroll
        for (int j = 0; j < 4; ++j) { vn[j] = *(const f32x4*)(xr_ + 256 * j); if (WHICH == 1) yn[j] = *(const v2u*)(YO + (size_t)F.gw * DM + 4 * F.lane + 256 * j); } }
    for (int row = F.gw; row < MROWS; row += F.NGW) {
        const int b = row / TPB, t = row - b * TPB; const bool lat = t < SEQ; const int mi = lat ? b : 8;
        const float* sh = mv + mi * 6144 + (WHICH == 0 ? 0 : 3072); const float* sc = sh + 1024;
        f32x4 v[4]; v2u y[4];
#pragma unroll
        for (int j = 0; j < 4; ++j) { v[j] = vn[j]; if (WHICH == 1) y[j] = yn[j]; }
        { const int nrow = row + F.NGW;
          if (nrow < MROWS) { NORM_ROWPTR(nrow, b_, t_, lat_, xr_);
#pragma unroll
              for (int j = 0; j < 4; ++j) { vn[j] = *(const f32x4*)(xr_ + 256 * j); if (WHICH == 1) yn[j] = *(const v2u*)(YO + (size_t)nrow * DM + 4 * F.lane + 256 * j); } } }
        if (mi != mi_prev) { mi_prev = mi;
#pragma unroll
            for (int j = 0; j < 4; ++j) { s1v[j] = *(const f32x4*)(sc + 4 * F.lane + 256 * j); s0v[j] = *(const f32x4*)(sh + 4 * F.lane + 256 * j); if (WHICH == 1) g1v[j] = *(const f32x4*)(g1b + mi * 6144 + 256 * j); } }
        float ss = 0.f;
        if (WHICH == 1) {
            float* xo = (lat ? F.out + ((size_t)b * SEQ + t) * DM : (float*)(F.ws + WS_XC) + ((size_t)b * CTXL + (t - SEQ)) * DM) + 4 * F.lane;
#pragma unroll
            for (int j = 0; j < 4; ++j) { const f32x4 g1 = g1v[j];
                v[j][0] += g1[0] * bflo(y[j].x); v[j][1] += g1[1] * bfhi(y[j].x); v[j][2] += g1[2] * bflo(y[j].y); v[j][3] += g1[3] * bfhi(y[j].y);
                *(f32x4*)(xo + 256 * j) = v[j]; }
        }
#pragma unroll
        for (int j = 0; j < 4; ++j) ss += (v[j][0] * v[j][0] + v[j][1] * v[j][1]) + (v[j][2] * v[j][2] + v[j][3] * v[j][3]);
        const float rstd = rsqrtf(wave_sum(ss) * (1.f / DM) + EPSN);
#pragma unroll
        for (int j = 0; j < 4; ++j) {
            const f32x4 s1 = s1v[j] + 1.f, s0 = s0v[j];
            v[j] = (v[j] * rstd * nwv[j]) * s1 + s0;
            v2u o; o.x = pk2(v[j][0], v[j][1]); o.y = pk2(v[j][2], v[j][3]);
            *(v2u*)(H + (size_t)row * DM + 4 * F.lane + 256 * j) = o;
        }
    }
#undef NORM_ROWPTR
}

template <int WHICH> DI void phase_side(const Frame& F, int li, LAS unsigned char* lds_w) {
    LAS bf16* wh = (LAS bf16*)lds_w; LAS bf16* wlo = wh + 16 * 1032;
    { const float* W = WHICH == 0 ? F.in[I_WIN] + (size_t)li * 1024 * INCOLS + NPROJ : F.in[I_WRT] + (size_t)li * 1024 * 16; const int ldw = WHICH == 0 ? INCOLS : 16;
      for (int i = F.tid; i < 16384; i += 512) { const int k = i >> 4, j = i & 15; const float w = W[(size_t)k * ldw + j]; const unsigned hi = f2bf(w); const float rem = w - bf2f((unsigned short)hi);
          wh[j * 1032 + k] = (bf16)hi; wlo[j * 1032 + k] = (bf16)f2bf(rem); } }
    __syncthreads();
    const bf16* H = (const bf16*)(F.ws + WS_H);
    const int r = F.lane & 15, q = F.lane >> 4, e = r;
    const float dtb = (WHICH == 0 && e >= 8) ? F.in[I_DTB][li * 8 + (e - 8)] : 0.f, nal = (WHICH == 0 && e >= 8) ? -__expf(F.in[I_ALOG][li * 8 + (e - 8)]) : 0.f;
    const int nfull = (MROWS / 16) / F.NGW * F.NGW, ntail = MROWS - nfull * 16;
#define SIDE_HP(u_) (H + (size_t)((u_) < nfull ? (u_) * 16 + r : nfull * 16 + ((u_) - nfull)) * DM + 8 * q)
    bf16x8 fa[2][16];
    if (F.gw < nfull + ntail) { const bf16* hp0 = SIDE_HP(F.gw);
#pragma unroll
        for (int s2 = 0; s2 < 16; ++s2) fa[0][s2] = *(const bf16x8*)(hp0 + 32 * s2); }
    for (int u = F.gw; u < nfull + ntail; u += F.NGW) {
        const bool full = u < nfull; const int row0 = full ? u * 16 : nfull * 16 + (u - nfull);
        const bf16* hp = SIDE_HP(u);
        f32x4 acc = {0.f, 0.f, 0.f, 0.f};
#pragma unroll
        for (int hb = 0; hb < 2; ++hb) {
            if (hb == 0) {
#pragma unroll
                for (int s2 = 0; s2 < 16; ++s2) fa[1][s2] = *(const bf16x8*)(hp + 32 * (16 + s2));
            } else if (u + F.NGW < nfull + ntail) { const bf16* hpn = SIDE_HP(u + F.NGW);
#pragma unroll
                for (int s2 = 0; s2 < 16; ++s2) fa[0][s2] = *(const bf16x8*)(hpn + 32 * s2);
            }
            __builtin_amdgcn_sched_barrier(0);
#pragma unroll
            for (int s2 = 0; s2 < 16; ++s2) { const int sk = 16 * hb + s2;
                const bf16x8 bh = *(const LAS bf16x8*)(wh + r * 1032 + 32 * sk + 8 * q), bl = *(const LAS bf16x8*)(wlo + r * 1032 + 32 * sk + 8 * q);
                acc = MFMA16(fa[hb][s2], bh, acc); acc = MFMA16(fa[hb][s2], bl, acc); }
            __builtin_amdgcn_sched_barrier(0);
        }
#pragma unroll
        for (int jj = 0; jj < 4; ++jj) {
            const bool wr = full || (q == 0 && jj == 0); const int row = full ? row0 + 4 * q + jj : row0; const float val = acc[jj];
            if (WHICH == 0) { float o;
                if (e < 8) o = sigmoidf_(val);
                else { const float xx = val + dtb; const float ex = __expf(xx); const float sp = xx > 15.f ? xx : (xx < -15.f ? ex : __logf(1.f + ex)); o = nal * sp; }
                if (wr) ((float*)(F.ws + WS_GDNG))[(size_t)row * 16 + e] = o;
            } else {
                float m = val; m = fmaxf(m, __shfl_xor(m, 1)); m = fmaxf(m, __shfl_xor(m, 2)); m = fmaxf(m, __shfl_xor(m, 4)); m = fmaxf(m, __shfl_xor(m, 8));
                const float ex = __expf(val - m); const float p = ex / sum16(ex);
                const int b = row / TPB, t = row - b * TPB; float* A = (float*)(F.ws + WS_AFF);
                if (wr) { if (t < SEQ) A[((size_t)b * 16 + e) * SEQ + t] = p; else A[(size_t)NB * 16 * SEQ + ((size_t)b * 16 + e) * CTXL + (t - SEQ)] = p; }
            }
        }
    }
#undef SIDE_HP
}

DI void phase_cv(const Frame& F, int li) {
    const bf16* P = (const bf16*)(F.ws + WS_CPRE); bf16* O = (bf16*)(F.ws + WS_POST);
    const float* cw = F.in[I_CONVW] + (size_t)li * 3 * 1536;
    float w[3][3][8];
#pragma unroll
    for (int tp = 0; tp < 3; ++tp)
#pragma unroll
        for (int g = 0; g < 3; ++g) { const f32x4 a = *(const f32x4*)(cw + tp * 1536 + g * 512 + 8 * F.lane), b = *(const f32x4*)(cw + tp * 1536 + g * 512 + 8 * F.lane + 4);
#pragma unroll
            for (int e = 0; e < 4; ++e) { w[tp][g][e] = a[e]; w[tp][g][4 + e] = b[e]; } }
#define CV_LOAD(dst, row_) do { const int t_ = (row_) % TPB; const bool hp_ = (t_ != 0) && (t_ != SEQ), hn_ = (t_ != SEQ - 1) && (t_ != TPB - 1); \
        _Pragma("unroll") for (int g = 0; g < 3; ++g) _Pragma("unroll") for (int tp = 0; tp < 3; ++tp) { const bool ok = tp == 1 || (tp == 0 ? hp_ : hn_); dst[g][tp] = (v4u){0u, 0u, 0u, 0u}; \
            if (ok) dst[g][tp] = *(const v4u*)(P + (size_t)((row_) + tp - 1) * 1536 + g * 512 + 8 * F.lane); } } while (0)
    v4u xnx[3][3];
    if (F.gw < MROWS) CV_LOAD(xnx, F.gw);
    for (int row = F.gw; row < MROWS; row += F.NGW) {
        v4u xin[3][3];
#pragma unroll
        for (int g = 0; g < 3; ++g)
#pragma unroll
            for (int tp = 0; tp < 3; ++tp) xin[g][tp] = xnx[g][tp];
        if (row + F.NGW < MROWS) CV_LOAD(xnx, row + F.NGW);
#pragma unroll
        for (int g = 0; g < 3; ++g) {
            float a[8];
#pragma unroll
            for (int e = 0; e < 8; ++e) a[e] = 0.f;
#pragma unroll
            for (int tp = 0; tp < 3; ++tp) { const v4u x = xin[g][tp];
                a[0] += w[tp][g][0] * bflo(x.x); a[1] += w[tp][g][1] * bfhi(x.x); a[2] += w[tp][g][2] * bflo(x.y); a[3] += w[tp][g][3] * bfhi(x.y);
                a[4] += w[tp][g][4] * bflo(x.z); a[5] += w[tp][g][5] * bfhi(x.z); a[6] += w[tp][g][6] * bflo(x.w); a[7] += w[tp][g][7] * bfhi(x.w);
            }
            float ss = 0.f;
#pragma unroll
            for (int e = 0; e < 8; ++e) { a[e] = siluf_(a[e]); ss += a[e] * a[e]; }
            if (g < 2) { ss = sum16(ss); const float r = rsqrtf(ss + EPSN) * (g == 0 ? 0.08838834764831845f : 1.f);
#pragma unroll
                for (int e = 0; e < 8; ++e) a[e] *= r; }
            v4u o; o.x = pk2(a[0], a[1]); o.y = pk2(a[2], a[3]); o.z = pk2(a[4], a[5]); o.w = pk2(a[6], a[7]);
            *(v4u*)(O + (size_t)row * 1536 + g * 512 + 8 * F.lane) = o;
        }
    }
#undef CV_LOAD
}

DI void phase_gf(const Frame& F, int li) {
    const bf16* O0 = (const bf16*)(F.ws + WS_CPRE); const bf16* O1 = O0 + (size_t)MROWS * 512; const bf16* Z = (const bf16*)(F.ws + WS_Z); bf16* Y = (bf16*)(F.ws + WS_YG);
    const float* gw = F.in[I_GNW] + li * 128 + 8 * (F.lane & 15);
    const f32x4 w0 = *(const f32x4*)gw, w1 = *(const f32x4*)(gw + 4);
    v4u na = {0u, 0u, 0u, 0u}, nb = na, nz = na;
    if (F.gw < MROWS) { const size_t o = (size_t)F.gw * 512 + 8 * F.lane; na = *(const v4u*)(O0 + o); nb = *(const v4u*)(O1 + o); nz = *(const v4u*)(Z + o); }
    for (int row = F.gw; row < MROWS; row += F.NGW) {
        const size_t o = (size_t)row * 512 + 8 * F.lane;
        const v4u a = na, b = nb, z = nz;
        if (row + F.NGW < MROWS) { const size_t o2 = (size_t)(row + F.NGW) * 512 + 8 * F.lane; na = *(const v4u*)(O0 + o2); nb = *(const v4u*)(O1 + o2); nz = *(const v4u*)(Z + o2); }
        float v[8] = {bflo(a.x) + bflo(b.x), bfhi(a.x) + bfhi(b.x), bflo(a.y) + bflo(b.y), bfhi(a.y) + bfhi(b.y), bflo(a.z) + bflo(b.z), bfhi(a.z) + bfhi(b.z), bflo(a.w) + bflo(b.w), bfhi(a.w) + bfhi(b.w)};
        const float zz[8] = {bflo(z.x), bfhi(z.x), bflo(z.y), bfhi(z.y), bflo(z.z), bfhi(z.z), bflo(z.w), bfhi(z.w)};
        float ss = 0.f;
#pragma unroll
        for (int e = 0; e < 8; ++e) ss += v[e] * v[e];
        const float r = rsqrtf(sum16(ss) * (1.f / 128.f) + EPSN);
#pragma unroll
        for (int e = 0; e < 8; ++e) v[e] = v[e] * r * (e < 4 ? w0[e] : w1[e - 4]) * siluf_(zz[e]);
        v4u ov; ov.x = pk2(v[0], v[1]); ov.y = pk2(v[2], v[3]); ov.z = pk2(v[4], v[5]); ov.w = pk2(v[6], v[7]);
        *(v4u*)(Y + o) = ov;
    }
}

DI void phase_bf(const Frame& F, int li) {
    const bf16* OB = (const bf16*)(F.ws + WS_OB); bf16* Y = (bf16*)(F.ws + WS_YB);
    const float lam = ((const float*)(F.ws + WS_LAM))[li * 4], oml = ((const float*)(F.ws + WS_LAM))[li * 4 + 1];
    const float* sw = F.in[I_SUBLN] + li * 128 + 8 * (F.lane & 15);
    const f32x4 w0 = *(const f32x4*)sw, w1 = *(const f32x4*)(sw + 4);
    const int h = F.lane >> 4, e0 = (F.lane & 15) * 8;
    v4u na = {0u, 0u, 0u, 0u}, nb = na;
    if (F.gw < MROWS) { const bf16* p = OB + (size_t)F.gw * 1024 + h * 256 + e0; na = *(const v4u*)p; nb = *(const v4u*)(p + 128); }
    for (int row = F.gw; row < MROWS; row += F.NGW) {
        const v4u a = na, b = nb;
        if (row + F.NGW < MROWS) { const bf16* p = OB + (size_t)(row + F.NGW) * 1024 + h * 256 + e0; na = *(const v4u*)p; nb = *(const v4u*)(p + 128); }
        float v[8] = {bflo(a.x) - lam * bflo(b.x), bfhi(a.x) - lam * bfhi(b.x), bflo(a.y) - lam * bflo(b.y), bfhi(a.y) - lam * bfhi(b.y),
                      bflo(a.z) - lam * bflo(b.z), bfhi(a.z) - lam * bfhi(b.z), bflo(a.w) - lam * bflo(b.w), bfhi(a.w) - lam * bfhi(b.w)};
        float ss = 0.f;
#pragma unroll
        for (int e = 0; e < 8; ++e) ss += v[e] * v[e];
        const float r = rsqrtf(sum16(ss) * (1.f / 128.f) + EPSN) * oml;
#pragma unroll
        for (int e = 0; e < 8; ++e) v[e] = v[e] * r * (e < 4 ? w0[e] : w1[e - 4]);
        v4u ov; ov.x = pk2(v[0], v[1]); ov.y = pk2(v[2], v[3]); ov.z = pk2(v[4], v[5]); ov.w = pk2(v[6], v[7]);
        *(v4u*)(Y + (size_t)row * 512 + 8 * F.lane) = ov;
    }
}

DI void phase_ga(const Frame& F, int nslot) {
    const int* idx = (const int*)(F.ws + WS_IDX); const bf16* H = (const bf16*)(F.ws + WS_H); bf16* X = (bf16*)(F.ws + WS_XIN);
    for (int r0 = F.gw; r0 < nslot; r0 += 4 * F.NGW) {
        v4u a[4], b[4]; int src[4];
#pragma unroll
        for (int u = 0; u < 4; ++u) { const int r = r0 + u * F.NGW; src[u] = r < nslot ? __builtin_amdgcn_readfirstlane(idx[r]) : 0; }
#pragma unroll
        for (int u = 0; u < 4; ++u) { a[u] = *(const v4u*)(H + (size_t)src[u] * DM + 8 * F.lane); b[u] = *(const v4u*)(H + (size_t)src[u] * DM + 512 + 8 * F.lane); }
#pragma unroll
        for (int u = 0; u < 4; ++u) { const int r = r0 + u * F.NGW; if (r < nslot) { *(v4u*)(X + (size_t)r * DM + 8 * F.lane) = a[u]; *(v4u*)(X + (size_t)r * DM + 512 + 8 * F.lane) = b[u]; } }
    }
}

DI void phase_cb(const Frame& F, int li) {
    const int* inv = (const int*)(F.ws + WS_INV); const bf16* Y = (const bf16*)(F.ws + WS_XIN);
    const bool last = li == NLAYER - 1;
#define CB_ROW(row_, b_, t_, lat_, xr_) const int b_ = (row_) / TPB, t_ = (row_) - b_ * TPB; const bool lat_ = t_ < SEQ; \
        float* xr_ = (lat_ ? F.out + ((size_t)b_ * SEQ + t_) * DM : (float*)(F.ws + WS_XC) + ((size_t)b_ * CTXL + (t_ - SEQ)) * DM) + 4 * F.lane;
    const float* nw = F.in[I_N1W] + (last ? 0 : (li + 1) * 1024); const float* mv = modv_of(F, last ? li : li + 1);
    bf16* H = (bf16*)(F.ws + WS_H);
    f32x4 nwv[4], s1v[4], s0v[4]; int mi_prev = -1;
    if (!last) {
#pragma unroll
        for (int j = 0; j < 4; ++j) nwv[j] = *(const f32x4*)(nw + 4 * F.lane + 256 * j); }
    f32x4 vn[4]; int invn = -1;
    if (F.gw < MROWS) { CB_ROW(F.gw, b_, t_, lat_, xr_);
#pragma unroll
        for (int j = 0; j < 4; ++j) vn[j] = *(const f32x4*)(xr_ + 256 * j);
        if (F.lane < NEXP) invn = inv[((size_t)b_ * NEXP + F.lane) * TPB + t_]; }
    for (int row = F.gw; row < MROWS; row += F.NGW) {
        CB_ROW(row, b, t, lat, xr);
        f32x4 v[4]; int myinv = invn;
#pragma unroll
        for (int j = 0; j < 4; ++j) v[j] = vn[j];
        { const int nrow = row + F.NGW; invn = -1;
          if (nrow < MROWS) { CB_ROW(nrow, b_, t_, lat_, xr_);
#pragma unroll
              for (int j = 0; j < 4; ++j) vn[j] = *(const f32x4*)(xr_ + 256 * j);
              if (F.lane < NEXP) invn = inv[((size_t)b_ * NEXP + F.lane) * TPB + t_]; } }
        if (!lat && last) continue;
        if (!last) { const int mi = lat ? b : 8;
            if (mi != mi_prev) { mi_prev = mi; const float* sh = mv + mi * 6144; const float* sc = sh + 1024;
#pragma unroll
                for (int j = 0; j < 4; ++j) { s1v[j] = *(const f32x4*)(sc + 4 * F.lane + 256 * j); s0v[j] = *(const f32x4*)(sh + 4 * F.lane + 256 * j); } } }
        unsigned long long m = __ballot(myinv >= 0);
        while (m) {
            const int e0 = __ffsll((long long)m) - 1; m &= m - 1;
            const int s0 = __builtin_amdgcn_readlane(myinv, e0);
            int s1 = -1; if (m) { const int e1 = __ffsll((long long)m) - 1; m &= m - 1; s1 = __builtin_amdgcn_readlane(myinv, e1); }
            v2u y0[4], y1[4];
#pragma unroll
            for (int j = 0; j < 4; ++j) y0[j] = *(const v2u*)(Y + (size_t)s0 * DM + 4 * F.lane + 256 * j);
            if (s1 >= 0) {
#pragma unroll
                for (int j = 0; j < 4; ++j) y1[j] = *(const v2u*)(Y + (size_t)s1 * DM + 4 * F.lane + 256 * j);
            } else {
#pragma unroll
                for (int j = 0; j < 4; ++j) y1[j] = (v2u){0u, 0u};
            }
#pragma unroll
            for (int j = 0; j < 4; ++j) { v[j][0] += bflo(y0[j].x); v[j][1] += bfhi(y0[j].x); v[j][2] += bflo(y0[j].y); v[j][3] += bfhi(y0[j].y); }
#pragma unroll
            for (int j = 0; j < 4; ++j) { v[j][0] += bflo(y1[j].x); v[j][1] += bfhi(y1[j].x); v[j][2] += bflo(y1[j].y); v[j][3] += bfhi(y1[j].y); }
        }
#pragma unroll
        for (int j = 0; j < 4; ++j) *(f32x4*)(xr + 256 * j) = v[j];
        if (!last) {
            float ss = 0.f;
#pragma unroll
            for (int j = 0; j < 4; ++j) ss += (v[j][0] * v[j][0] + v[j][1] * v[j][1]) + (v[j][2] * v[j][2] + v[j][3] * v[j][3]);
            const float rstd = rsqrtf(wave_sum(ss) * (1.f / DM) + EPSN);
#pragma unroll
            for (int j = 0; j < 4; ++j) {
                const f32x4 s1 = s1v[j] + 1.f, s0 = s0v[j];
                const f32x4 hv = (v[j] * rstd * nwv[j]) * s1 + s0;
                v2u o; o.x = pk2(hv[0], hv[1]); o.y = pk2(hv[2], hv[3]);
                *(v2u*)(H + (size_t)row * DM + 4 * F.lane + 256 * j) = o;
            }
        }
    }
#undef CB_ROW
}
typedef float f32x16 __attribute__((ext_vector_type(16)));
DI int crow32(int r, int hi) { return (r & 3) + 8 * (r >> 2) + 4 * hi; }

DI void phase_cl(const Frame& F) {
    LAS float* Am = (LAS float*)(F.lds + F.wave * 16384);
    LAS float* gcv = (LAS float*)(F.lds + LDS_XTRA + F.wave * 512);
    LAS float* btv = gcv + 64;
    const bf16* P = (const bf16*)(F.ws + WS_POST); const float* GG = (const float*)(F.ws + WS_GDNG);
    const int L = F.lane, r = L & 31, hh = L >> 5;
    for (int unit = F.gw; unit < NB * NCHUNK * 8; unit += F.NGW) {
        const int dir = unit & 1, h = (unit >> 1) & 3, bc = unit >> 3; const size_t row0 = (size_t)bc * 64;
        unsigned char* tq = F.ws + WS_TQ + (size_t)unit * 16384; float* gcb = (float*)(F.ws + WS_GCB) + (size_t)unit * 128;
        const int io = dir ? 63 - L : L;
        const float g = GG[(row0 + io) * 16 + 8 + dir * 4 + h], beta = GG[(row0 + io) * 16 + dir * 4 + h];
        float gc = g;
#pragma unroll
        for (int o = 1; o < 64; o <<= 1) { const float t = __shfl_up(gc, o); if (L >= o) gc += t; }
        gcv[L] = gc; btv[L] = beta; gcb[io] = gc; gcb[64 + io] = beta;
        bf16x8 kf[2][8], qf[2][8];
#pragma unroll
        for (int rb = 0; rb < 2; ++rb) { const int ir = 32 * rb + r, orr = dir ? 63 - ir : ir; const bf16* pr = P + (row0 + orr) * 1536 + h * 128 + 8 * hh;
#pragma unroll
            for (int s = 0; s < 8; ++s) { kf[rb][s] = *(const bf16x8*)(pr + 512 + 16 * s); qf[rb][s] = *(const bf16x8*)(pr + 16 * s); } }
        LDS_WAIT();
        LAS float* Amb = Am + hh * 256 + r; const LAS float* gch = gcv + 4 * hh; const LAS float* bth = btv + 4 * hh; const LAS float* gcr = gcv + r;
#pragma unroll
        for (int tt = 0; tt < 3; ++tt) { const int ta = tt == 1 ? 0 : 1, tb = tt == 2 ? 1 : 0;
            f32x16 x = {};
#pragma unroll
            for (int s = 0; s < 8; ++s) x = MFMA32(kf[ta][s], kf[tb][s], x);
            const float gcj = gcr[32 * tb];
#pragma unroll
            for (int q = 0; q < 16; ++q) { const int ci = 32 * ta + (q & 3) + 8 * (q >> 2); Amb[ci * 64 + 32 * tb] = bth[ci] * x[q] * __expf(fminf(gch[ci] - gcj, 0.f)); }
            asm volatile("" ::: "memory"); }
        const int sg = dir ? -1 : 1;
        bf16* qkb = (bf16*)(tq + 8192) + (dir ? (63 - 4 * hh) * 64 + (63 - r) : 4 * hh * 64 + r);
#pragma unroll
        for (int tt = 0; tt < 4; ++tt) { const int ta = tt >> 1, tb = tt & 1;
            f32x16 x = {};
            if (!(ta == 0 && tb == 1)) {
#pragma unroll
                for (int s = 0; s < 8; ++s) x = MFMA32(qf[ta][s], kf[tb][s], x);
            }
            const float gcj = gcr[32 * tb]; const int jj = 32 * tb + r;
#pragma unroll
            for (int q = 0; q < 16; ++q) { const int ci = 32 * ta + (q & 3) + 8 * (q >> 2);
                const float val = jj <= ci + 4 * hh ? x[q] * __expf(gch[ci] - gcj) : 0.f; qkb[sg * (ci * 64 + 32 * tb)] = (bf16)f2bf(val); }
            asm volatile("" ::: "memory"); }
        LDS_WAIT(); asm volatile("" ::: "memory");
        float T[64];
#pragma unroll
        for (int i = 0; i < 64; ++i) {
            f32x4 rb[16];
#pragma unroll
            for (int j4 = 0; j4 < (i + 3) / 4; ++j4) rb[j4] = *(const LAS f32x4*)(Am + i * 64 + 4 * j4);
            asm volatile("s_waitcnt lgkmcnt(0)" ::: "memory");
            float a4[4] = {(i == L) ? 1.f : 0.f, 0.f, 0.f, 0.f};
#pragma unroll
            for (int j4 = 0; j4 < (i + 3) / 4; ++j4) {
#pragma unroll
                for (int e = 0; e < 4; ++e) if (4 * j4 + e < i) a4[e] -= rb[j4][e] * T[4 * j4 + e]; }
            T[i] = (a4[0] + a4[1]) + (a4[2] + a4[3]);
        }
        bf16* tpb = (bf16*)tq + (dir ? 63 * 64 + 63 - L : L);
#pragma unroll
        for (int i = 0; i < 64; ++i) tpb[sg * (i * 64)] = (bf16)f2bf(T[i]);
        LDS_WAIT(); asm volatile("" ::: "memory");
    }
}

constexpr int SC_KR = 0, SC_KT = 17408, SC_QR = 35840, SC_VR = 53248, SC_TR = 58368, SC_QK = 67584, SC_VEC = 76800, SC_ST = 77824, SC_RT = 86528, SC_VN = 91136, SC_VS = 95744, SC_END = 100352;
DI v2u pack4(float a, float b, float c, float d) { v2u w; w.x = pk2(a, b); w.y = pk2(c, d); return w; }
DI void phase_sc(const Frame& F) {
    LAS unsigned char* S = F.lds;
    const bf16* P = (const bf16*)(F.ws + WS_POST); bf16* OD = (bf16*)(F.ws + WS_CPRE);
    const int tid = F.tid, w = F.wave, l15 = F.lane & 15, quad = F.lane >> 4;
    for (int unit = F.vcu; unit < 256; unit += F.G) {
        const int sl = unit & 3, dir = (unit >> 2) & 1, h = (unit >> 3) & 3, b = unit >> 5;
        __syncthreads();
        for (int i = tid; i < 8704 / 4; i += 512) ((LAS unsigned*)(S + SC_ST))[i] = 0u;
        f32x4 Sacc[2] = {{0.f, 0.f, 0.f, 0.f}, {0.f, 0.f, 0.f, 0.f}};
        v4u rk[2][2], rq[2][2], rv[2], rt[2], rqk[2], rvec[2];
        const int last_i = dir ? 0 : 63;
#define SC_CHUNK(n) ((n) < 4 ? (dir ? 131 - (n) : 128 + (n)) : (dir ? 131 - (n) : (n) - 4))
#define SC_LOAD(n, Q) do { const int ch_ = SC_CHUNK(n); const size_t r0_ = ((size_t)b * NCHUNK + ch_) * 64; const size_t u_ = ((((size_t)b * NCHUNK + ch_) * 4 + h) * 2 + dir); \
        _Pragma("unroll") for (int i_ = 0; i_ < 2; ++i_) { const int v_ = tid + 512 * i_, rr_ = v_ >> 4, c_ = v_ & 15; const bf16* p_ = P + (r0_ + rr_) * 1536 + h * 128 + c_ * 8; rk[Q][i_] = *(const v4u*)(p_ + 512); rq[Q][i_] = *(const v4u*)p_; } \
        if (tid < 256) rv[Q] = *(const v4u*)(P + (r0_ + (tid >> 2)) * 1536 + 1024 + h * 128 + sl * 32 + (tid & 3) * 8); \
        rt[Q] = *(const v4u*)(F.ws + WS_TQ + u_ * 16384 + (size_t)tid * 16); rqk[Q] = *(const v4u*)(F.ws + WS_TQ + u_ * 16384 + 8192 + (size_t)tid * 16); \
        if (tid < 32) rvec[Q] = *(const v4u*)((const float*)(F.ws + WS_GCB) + u_ * 128 + tid * 4); } while (0)
#define SC_WRITE(Q) do { \
        _Pragma("unroll") for (int i_ = 0; i_ < 2; ++i_) { const int v_ = tid + 512 * i_, rr_ = v_ >> 4, c_ = v_ & 15; \
            *(LAS v4u*)(S + SC_KR + rr_ * 272 + c_ * 16) = rk[Q][i_]; *(LAS v4u*)(S + SC_QR + rr_ * 272 + c_ * 16) = rq[Q][i_]; } \
        if (tid < 256) *(LAS v4u*)(S + SC_VR + (tid >> 2) * 80 + (tid & 3) * 16) = rv[Q]; \
        *(LAS v4u*)(S + SC_TR + (tid >> 3) * 144 + (tid & 7) * 16) = rt[Q]; *(LAS v4u*)(S + SC_QK + (tid >> 3) * 144 + (tid & 7) * 16) = rqk[Q]; \
        if (tid < 32) *(LAS v4u*)(S + SC_VEC + tid * 16) = rvec[Q]; } while (0)
        SC_LOAD(0, 0); VM_WAIT(); SC_WRITE(0); SC_LOAD(1, 1); LDS_WAIT(); __syncthreads();
        const LAS float* gcs = (const LAS float*)(S + SC_VEC); const LAS float* bts = gcs + 64;
        for (int n2 = 0; n2 < NCHUNK; n2 += 2) {
#pragma unroll
          for (int QS = 0; QS < 2; ++QS) { const int n = n2 + QS;
            if (n + 2 < NCHUNK) SC_LOAD(n + 2, QS);
            const size_t row0 = ((size_t)b * NCHUNK + SC_CHUNK(n)) * 64;
            const float gcl = gcs[last_i];
            const int tr = w >> 1, tc = w & 1, dvt = w & 1, tt = w >> 1;
            f32x4 ks = {0.f, 0.f, 0.f, 0.f}, os = {0.f, 0.f, 0.f, 0.f};
            { bf16x8 fa[4], fb[4], gb[4];
#pragma unroll
              for (int s = 0; s < 4; ++s) { fa[s] = *(const LAS bf16x8*)(S + SC_KR + (16 * tr + l15) * 272 + (32 * s + 8 * quad) * 2); fb[s] = *(const LAS bf16x8*)(S + SC_ST + (16 * tc + l15) * 272 + (32 * s + 8 * quad) * 2);
                  gb[s] = *(const LAS bf16x8*)(S + SC_QR + (16 * tt + l15) * 272 + (32 * s + 8 * quad) * 2); }
              __builtin_amdgcn_sched_barrier(0);
#pragma unroll
              for (int s = 0; s < 4; ++s) { ks = MFMA16(fa[s], fb[s], ks); os = MFMA16(fb[s], gb[s], os); }
              __builtin_amdgcn_sched_barrier(0); }
            { float rr[4];
#pragma unroll
              for (int jj = 0; jj < 4; ++jj) { const int tok = 16 * tr + 4 * quad + jj; const float vv = bf2f(*(const LAS unsigned short*)(S + SC_VR + tok * 80 + (16 * tc + l15) * 2));
                  rr[jj] = bts[tok] * (vv - __expf(gcs[tok]) * ks[jj]); }
              *(LAS v2u*)(S + SC_RT + (16 * tc + l15) * 144 + (16 * tr + 4 * quad) * 2) = pack4(rr[0], rr[1], rr[2], rr[3]); }
            LDS_WAIT(); __syncthreads();
            f32x4 vn = {0.f, 0.f, 0.f, 0.f};
            { bf16x8 fa[2], fb[2];
#pragma unroll
              for (int s = 0; s < 2; ++s) { fa[s] = *(const LAS bf16x8*)(S + SC_TR + (16 * tr + l15) * 144 + (32 * s + 8 * quad) * 2); fb[s] = *(const LAS bf16x8*)(S + SC_RT + (16 * tc + l15) * 144 + (32 * s + 8 * quad) * 2); }
              __builtin_amdgcn_sched_barrier(0);
#pragma unroll
              for (int s = 0; s < 2; ++s) vn = MFMA16(fa[s], fb[s], vn);
              __builtin_amdgcn_sched_barrier(0); }
            { float sc[4];
#pragma unroll
              for (int jj = 0; jj < 4; ++jj) sc[jj] = vn[jj] * __expf(gcl - gcs[16 * tr + 4 * quad + jj]);
              *(LAS v2u*)(S + SC_VN + (16 * tc + l15) * 144 + (16 * tr + 4 * quad) * 2) = pack4(vn[0], vn[1], vn[2], vn[3]);
              *(LAS v2u*)(S + SC_VS + (16 * tc + l15) * 144 + (16 * tr + 4 * quad) * 2) = pack4(sc[0], sc[1], sc[2], sc[3]); }
            LDS_WAIT(); __syncthreads();
            { const float eg = __expf(gcs[16 * tt + l15]); f32x4 oa = os * eg;
              bf16x8 fa[2], fb[2];
#pragma unroll
              for (int s = 0; s < 2; ++s) { fa[s] = *(const LAS bf16x8*)(S + SC_VN + (16 * dvt + l15) * 144 + (32 * s + 8 * quad) * 2); fb[s] = *(const LAS bf16x8*)(S + SC_QK + (16 * tt + l15) * 144 + (32 * s + 8 * quad) * 2); }
              __builtin_amdgcn_sched_barrier(0);
#pragma unroll
              for (int s = 0; s < 2; ++s) oa = MFMA16(fa[s], fb[s], oa);
              *(v2u*)(OD + ((size_t)dir * MROWS + row0 + 16 * tt + l15) * 512 + h * 128 + sl * 32 + 16 * dvt + 4 * quad) = pack4(oa[0], oa[1], oa[2], oa[3]); }
            { const float gl = __expf(gcl); bf16x8 a[2];
#pragma unroll
              for (int s = 0; s < 2; ++s) {
                  typedef short v4i16_t __attribute__((ext_vector_type(4)));
                  const LAS unsigned char* tp = S + SC_KR + (32 * s + 8 * quad + (l15 >> 2)) * 272 + (16 * w + 4 * (l15 & 3)) * 2;
                  const v4i16_t lo = __builtin_amdgcn_ds_read_tr16_b64_v4i16((LAS v4i16_t*)tp), hi = __builtin_amdgcn_ds_read_tr16_b64_v4i16((LAS v4i16_t*)(tp + 4 * 272));
                  a[s] = (bf16x8){lo[0], lo[1], lo[2], lo[3], hi[0], hi[1], hi[2], hi[3]}; }
              bf16x8 vb[2][2];
#pragma unroll
              for (int d = 0; d < 2; ++d)
#pragma unroll
                  for (int s = 0; s < 2; ++s) vb[d][s] = *(const LAS bf16x8*)(S + SC_VS + (16 * d + l15) * 144 + (32 * s + 8 * quad) * 2);
              __builtin_amdgcn_sched_barrier(0);
#pragma unroll
              for (int d = 0; d < 2; ++d) { f32x4 acc = Sacc[d] * gl;
#pragma unroll
                  for (int s = 0; s < 2; ++s) acc = MFMA16(a[s], vb[d][s], acc);
                  Sacc[d] = acc; *(LAS v2u*)(S + SC_ST + (16 * d + l15) * 272 + (16 * w + 4 * quad) * 2) = pack4(acc[0], acc[1], acc[2], acc[3]); } }
            LDS_WAIT(); __syncthreads();
            if (n + 1 < NCHUNK) SC_WRITE(1 - QS);
            LDS_WAIT(); __syncthreads();
                  }
        }
#undef SC_LOAD
#undef SC_WRITE
#undef SC_CHUNK
    }
}

template <int N, int K> DI void topk_unit(const Frame& F, const float* aff, int slot_base, int row_base, int inv_base) {
    constexpr int EPT = N >= 512 ? N / 512 : 1;
    LAS unsigned* hist = (LAS unsigned*)F.lds;
    LAS unsigned* ctl = hist + 256;
    LAS unsigned* wsum = ctl + 8;
    LAS unsigned* keys = hist + 1024;
    const int tid = F.tid; const bool act = tid * EPT < N;
    if (act) {
#pragma unroll 4
        for (int e = 0; e < EPT; ++e) keys[e * 512 + tid] = __builtin_bit_cast(unsigned, aff[tid * EPT + e]);
    }
    unsigned prefix = 0u, kk = K;
    for (int pass = 0; pass < 4; ++pass) {
        const int shift = 24 - 8 * pass; const unsigned himask = pass == 0 ? 0u : (0xffffffffu << (shift + 8));
        if (tid < 256) hist[tid] = 0u;
        __syncthreads();
        if (act) {
#pragma unroll 4
            for (int e = 0; e < EPT; ++e) { const unsigned key = keys[e * 512 + tid]; if ((key & himask) == prefix) __hip_atomic_fetch_add(&hist[(key >> shift) & 255u], 1u, __ATOMIC_RELAXED, __HIP_MEMORY_SCOPE_WORKGROUP); }
        }
        __syncthreads();
        if (F.wave == 0) {
            const int l = F.lane; const unsigned h0 = hist[4 * l], h1 = hist[4 * l + 1], h2 = hist[4 * l + 2], h3 = hist[4 * l + 3];
            const unsigned mine = h0 + h1 + h2 + h3; unsigned above = mine;
#pragma unroll
            for (int o = 1; o < 64; o <<= 1) { const unsigned t = __shfl_down(above, o); if (l + o < 64) above += t; }
            const unsigned excl = above - mine;
            if (excl < kk && kk <= above) {
                unsigned c = excl, d;
                if (kk <= c + h3) { d = 3; } else { c += h3; if (kk <= c + h2) { d = 2; } else { c += h2; if (kk <= c + h1) { d = 1; } else { c += h1; d = 0; } } }
                ctl[0] = prefix | ((unsigned)(4 * l + d) << shift); ctl[1] = kk - c;
            }
        }
        __syncthreads();
        prefix = ctl[0]; kk = ctl[1];
        __syncthreads();
    }
    const unsigned thr = prefix;
    unsigned ngt = 0, neq = 0;
    if (act) {
#pragma unroll 4
        for (int e = 0; e < EPT; ++e) { const unsigned key = keys[e * 512 + tid]; ngt += key > thr ? 1u : 0u; neq += key == thr ? 1u : 0u; }
    }
    unsigned sg = ngt, se = neq;
#pragma unroll
    for (int o = 1; o < 64; o <<= 1) { const unsigned a = __shfl_up(sg, o), b = __shfl_up(se, o); if (F.lane >= o) { sg += a; se += b; } }
    if (F.lane == 63) { wsum[F.wave] = sg; wsum[8 + F.wave] = se; }
    __syncthreads();
    unsigned og = sg - ngt, oe = se - neq, totg = 0;
#pragma unroll
    for (int ww = 0; ww < 8; ++ww) { const unsigned a = wsum[ww], b = wsum[8 + ww]; if (ww < F.wave) { og += a; oe += b; } totg += a; }
    int* idx = (int*)(F.ws + WS_IDX); float* wgt = (float*)(F.ws + WS_WGT); int* inv = (int*)(F.ws + WS_INV);
    if (act) {
#pragma unroll 2
        for (int e = 0; e < EPT; ++e) {
            const unsigned key = keys[e * 512 + tid];
            const int t = tid * EPT + e; int slot = -1;
            if (key > thr) slot = (int)(og++);
            else if (key == thr) { if (oe < kk) slot = (int)(totg + oe); ++oe; }
            if (slot >= 0) { idx[slot_base + slot] = row_base + t; wgt[slot_base + slot] = __builtin_bit_cast(float, key); }
            inv[inv_base + t] = slot >= 0 ? slot_base + slot : -1;
        }
    }
    __syncthreads();
}
DI void phase_tk(const Frame& F, int nunits) {
    const float* A = (const float*)(F.ws + WS_AFF);
    for (int u = F.bx; u < nunits; u += F.G) {
        if (u < NB * NEXP) { const int b = u >> 4, e = u & 15; topk_unit<SEQ, CAP_L>(F, A + (size_t)u * SEQ, (e * 8 + b) * CAP_L, b * TPB, (b * NEXP + e) * TPB); }
        else { const int v = u - NB * NEXP, b = v >> 4, e = v & 15; topk_unit<CTXL, CAP_C>(F, A + (size_t)NB * NEXP * SEQ + (size_t)v * CTXL, NSLOT_L + e * 256 + b * CAP_C, b * TPB + SEQ, (b * NEXP + e) * TPB + SEQ); }
    }
}
DI void phase_at(const Frame& F, int li) {
    typedef attn_body::bf16 abf;
    const bool need_ctx = li != NLAYER - 1;
    unsigned char* ws = F.ws;
    const float* LB = (const float*)(ws + WS_LAM) + li * 4;
    const bool fastA = __builtin_amdgcn_readfirstlane((int)(LB[2] <= 60.f)), fastB = __builtin_amdgcn_readfirstlane((int)(LB[3] <= 60.f));
    for (int i = 0;; ++i) {
        const int L = i * F.G + F.vcu; if (L >= 17 * 256) break;
        const int step = L >> 8, slot = L & 255, b = slot >> 5, j = slot & 31;
        int kind, head, q0, krow0, NT;
        if (step < 8) { kind = 0; head = step; q0 = j * 256; krow0 = 0; NT = TPB / 64; }
        else if (step < 16) { kind = 1; head = step - 8; q0 = j * 256; krow0 = 0; NT = TPB / 64; }
        else { if (!need_ctx || j >= 16) continue; if (j < 8) { kind = 0; head = j; } else { kind = 1; head = j - 8; } q0 = SEQ; krow0 = SEQ; NT = CTXL / 64; }
        const size_t qrow = (size_t)b * TPB + q0, krow = (size_t)b * TPB + krow0;
        int tid_u = F.tid; asm volatile("" : "+v"(tid_u));
        if (kind == 0) {
            abf* Q = (abf*)(ws + WS_YA) + qrow * 512 + head * 64;
            const abf* K = (const abf*)(ws + WS_KA) + krow * 128 + (head >> 2) * 64; const abf* V = (const abf*)(ws + WS_VA) + krow * 128 + (head >> 2) * 64;
            if (fastA) attn_body::attn_unit<8, true>(Q, 512, K, 128, V, 128, Q, 512, NT, (char*)F.lds, tid_u);
            else attn_body::attn_unit<8, false>(Q, 512, K, 128, V, 128, Q, 512, NT, (char*)F.lds, tid_u);
        } else {
            const int sh = head;
            const abf* Q = (const abf*)(ws + WS_QB) + qrow * 512 + sh * 64;
            const abf* K = (const abf*)(ws + WS_KB) + krow * 512 + sh * 64; const abf* V = (const abf*)(ws + WS_VB) + krow * 512 + (sh >> 1) * 128;
            abf* O = (abf*)(ws + WS_OB) + qrow * 1024 + sh * 128;
            if (fastB) attn_body::attn_unit128<8, true>(Q, 512, K, 512, V, 512, O, 1024, NT, (char*)F.lds, tid_u);
            else attn_body::attn_unit128<8, false>(Q, 512, K, 512, V, 512, O, 1024, NT, (char*)F.lds, tid_u);
        }
    }
}
constexpr int NPH = 19;
struct Args { const float* in[N_IN]; float* out; unsigned char* ws; int ph_lo, ph_hi, bar_region, pad; };
constexpr int CW_TMO = 0, CW_BAR = 4096;

__global__ void __launch_bounds__(512, 2) __attribute__((amdgpu_waves_per_eu(2, 2))) fwd_kernel(Args args) {
    extern __shared__ __attribute__((aligned(16))) unsigned char lds[];
    Frame F;
    F.lds = (LAS unsigned char*)lds; F.MISC = (volatile LAS unsigned*)(F.lds + MISC_OFF);
    F.tid = threadIdx.x; F.lane = F.tid & 63; F.wave = __builtin_amdgcn_readfirstlane(F.tid >> 6);
    F.G = gridDim.x; { const int bx = blockIdx.x; F.vcu = (F.G % 8 == 0) ? (bx % 8) * (F.G / 8) + bx / 8 : bx; }
    F.gw = F.vcu * 8 + F.wave; F.NGW = F.G * 8; F.bx = blockIdx.x;
    F.in.p = (kin_ptr)__builtin_amdgcn_kernarg_segment_ptr();
    F.out = args.out; F.ws = args.ws; F.ctl = (gu32*)(args.ws + WS_CTL);
    for (int u = F.tid; u < (LDS_BYTES - LDSCTL_OFF) / 4; u += 512) ((LAS unsigned*)(F.lds + LDSCTL_OFF))[u] = 0u;
    __syncthreads();
#if MK_ONE_LAUNCH
    XcdBarrier bar = xcd_barrier_post((unsigned*)(F.ctl + CW_BAR) + args.bar_region * XCD_BAR_WORDS, F.MISC + 8);
#define GRID_BAR() xcd_barrier(bar)
#else
#define GRID_BAR() do {} while (0)
#endif
    const int lo = args.ph_lo, hi = args.ph_hi;
#ifndef PROBE_MASK
#define PROBE_MASK 0
#endif
#ifndef PROBE_MULT
#define PROBE_MULT 4
#endif
    unsigned long long pr_acc = 0ull, pr_t0 = 0ull; (void)pr_t0;
#define PR_BEGIN(k) do { if ((PROBE_MASK >> (k)) & 1) pr_t0 = __builtin_amdgcn_s_memrealtime(); } while (0)
#define PR_END(k) do { if ((PROBE_MASK >> (k)) & 1) pr_acc += __builtin_amdgcn_s_memrealtime() - pr_t0; } while (0)
#ifndef ONLY_PH
#define ONLY_PH -1
#endif
#define IN(k) ((ONLY_PH < 0 || ONLY_PH == ((k) % NPH)) && lo <= (k) && (k) < hi)
#define SEAM(k) do { if (IN(k) && IN((k) + 1)) GRID_BAR(); } while (0)
    for (int li = 0; li < NLAYER; ++li) {
        const int p0 = li * NPH;
        const int lastl = li == NLAYER - 1;
#define PHASE_FRAME() Frame P = F; { int t_ = threadIdx.x; asm volatile("" : "+v"(t_)); P.tid = t_; P.lane = t_ & 63; \
        int z_ = 0, v_ = F.vcu, G_ = F.G, b_ = F.bx; asm volatile("" : "+s"(z_), "+s"(v_), "+s"(G_), "+s"(b_));     \
        P.in.p = (kin_ptr)__builtin_amdgcn_kernarg_segment_ptr() + z_; P.ws = args.ws + z_; P.out = args.out + z_; P.vcu = v_; P.G = G_; P.bx = b_; P.wave = __builtin_amdgcn_readfirstlane(P.tid >> 6); P.gw = v_ * 8 + P.wave; P.NGW = G_ * 8; P.ctl = (gu32*)(P.ws + WS_CTL); } \
        unsigned char* ws = P.ws; unsigned char* wm = ws + WS_WMIX; unsigned char* we = ws + WS_WEXP; (void)wm; (void)we;
        PR_BEGIN(0); if (IN(p0 + 0)) { PHASE_FRAME(); if (li == 0) phase_p0(P); phase_wx(P, li); } SEAM(p0 + 0); PR_END(0);
        PR_BEGIN(1); if (li == 0) { if (IN(p0 + 1)) { PHASE_FRAME(); phase_norm<0>(P, li); } SEAM(p0 + 1); } PR_END(1);
        PR_BEGIN(2); if (IN(p0 + 2)) { PHASE_FRAME();
            pg8::Gemm g{1024, 1024, 1024}; pg8::SchedMN S; S.init(ws + WS_H, 1024, wm + WM_WIN, 1024, MROWS / 256, 8, 9, P.G, P.bx);
            pg8::EpiInProj E{ws, P.in[I_GQN] + li * 64, P.in[I_GKN] + li * 64, P.in[I_DQN] + li * 64, P.in[I_DKN] + li * 64, (const float*)(ws + WS_ROPE)};
            pg8::gemm_phase<pg8::EpiInProj, pg8::SchedMN, true, true>(P.lds, g, S, E, P.tid);
        } SEAM(p0 + 2); PR_END(2);
        PR_BEGIN(3); if (IN(p0 + 3)) { PHASE_FRAME(); phase_side<0>(P, li, P.lds); phase_cv(P, li); } SEAM(p0 + 3); PR_END(3);
        PR_BEGIN(4); if (IN(p0 + 4)) { PHASE_FRAME(); phase_cl(P); } SEAM(p0 + 4); PR_END(4);
        PR_BEGIN(5); if (IN(p0 + 5)) { PHASE_FRAME(); phase_sc(P); } SEAM(p0 + 5); PR_END(5);
        PR_BEGIN(6); if (IN(p0 + 6)) { PHASE_FRAME(); phase_gf(P, li); } SEAM(p0 + 6); PR_END(6);
        PR_BEGIN(7); if (IN(p0 + 7)) { PHASE_FRAME();
            pg8::Gemm g{1024, 1024, 1024}; pg8::SchedMN S; S.init(ws + WS_H, 1024, wm + WM_WIN, 1024, MROWS / 256, 9, 0, P.G, P.bx);
            pg8::EpiInProj E{ws, P.in[I_GQN] + li * 64, P.in[I_GKN] + li * 64, P.in[I_DQN] + li * 64, P.in[I_DKN] + li * 64, (const float*)(ws + WS_ROPE)};
            pg8::gemm_phase<pg8::EpiInProj, pg8::SchedMN, true, true>(P.lds, g, S, E, P.tid);
        } SEAM(p0 + 7); PR_END(7);
        PR_BEGIN(8); if (IN(p0 + 8)) { PHASE_FRAME(); phase_at(P, li); } SEAM(p0 + 8); PR_END(8);
        PR_BEGIN(9); if (IN(p0 + 9)) { PHASE_FRAME(); phase_bf(P, li); } SEAM(p0 + 9); PR_END(9);
        PR_BEGIN(10); if (IN(p0 + 10)) { PHASE_FRAME();
            pg8::Gemm g{1024, 1024, 1024}; pg8::SchedMN S; S.init(ws + WS_H, 1024, wm + WM_WG, 1024, lastl ? NB * SEQ / 256 : MROWS / 256, 12, 0, P.G, P.bx); S.skipctx = lastl;
            pg8::EpiBf<0> E{(pg8::bf16_t*)(ws + WS_G), 3072, nullptr};
            pg8::gemm_phase<pg8::EpiBf<0>, pg8::SchedMN, true, true>(P.lds, g, S, E, P.tid);
        } SEAM(p0 + 10); PR_END(10);
        PR_BEGIN(11); if (IN(p0 + 11)) { PHASE_FRAME();
            pg8::Gemm g{512, 512, 512}; pg8::SchedMN S; S.init(ws + WS_YA, 512, wm + WM_WB, 512, lastl ? NB * SEQ / 256 : MROWS / 256, 4, 0, P.G, P.bx); S.skipctx = lastl;
            S.NZ = 3; S.a_z = 66 * MiB; S.b_z = (size_t)1024 * 512 * 2;
            pg8::EpiMergeH E{(pg8::bf16_t*)(ws + WS_MRG), 1024, (const pg8::bf16_t*)(ws + WS_G)};
            pg8::gemm_phase<pg8::EpiMergeH, pg8::SchedMN, true, true>(P.lds, g, S, E, P.tid);
        } SEAM(p0 + 11); PR_END(11);
        PR_BEGIN(12); if (IN(p0 + 12)) { PHASE_FRAME();
            pg8::Gemm g{1024, 1024, 1024}; pg8::SchedMN S; S.init(ws + WS_MRG, 1024, wm + WM_WO, 1024, lastl ? NB * SEQ / 256 : MROWS / 256, 4, 0, P.G, P.bx); S.skipctx = lastl;
            pg8::EpiBf<2> E{(pg8::bf16_t*)(ws + WS_G), 1024, nullptr};
            pg8::gemm_phase<pg8::EpiBf<2>, pg8::SchedMN, true, true>(P.lds, g, S, E, P.tid);
        } SEAM(p0 + 12); PR_END(12);
        PR_BEGIN(13); if (IN(p0 + 13)) { PHASE_FRAME(); phase_norm<1>(P, li); } SEAM(p0 + 13); PR_END(13);
        PR_BEGIN(14); if (IN(p0 + 14)) { PHASE_FRAME(); phase_side<1>(P, li, P.lds); } SEAM(p0 + 14); PR_END(14);
        PR_BEGIN(15); if (IN(p0 + 15)) { PHASE_FRAME(); phase_tk(P, lastl ? NB * NEXP : 2 * NB * NEXP); } SEAM(p0 + 15); PR_END(15);
        PR_BEGIN(16); if (IN(p0 + 16)) { PHASE_FRAME();
            pg8::Gemm g{1024, 1024, 1024}; pg8::SchedMoeG S{(const char*)(ws + WS_H), (const char*)(we + WE_GU), (size_t)2048 * 1024 * 2, 8, (lastl ? NSLOT_L / 256 : NSLOT / 256) * 8, P.G, P.vcu, (const int*)(ws + WS_IDX)};
            pg8::EpiE1 E{(pg8::bf16_t*)(ws + WS_HID)};
            pg8::gemm_phase<pg8::EpiE1, pg8::SchedMoeG, true, true>(P.lds, g, S, E, P.tid);
        } SEAM(p0 + 16); PR_END(16);
        PR_BEGIN(17); if (IN(p0 + 17)) { PHASE_FRAME();
            pg8::Gemm g{1024, 1024, 1024}; pg8::SchedMoe S{(const char*)(ws + WS_HID), (const char*)(we + WE_D), (size_t)1024 * 1024 * 2, 4, (lastl ? NSLOT_L / 256 : NSLOT / 256) * 4, P.G, P.vcu};
            pg8::EpiE2 E{(pg8::bf16_t*)(ws + WS_XIN), (const float*)(ws + WS_WGT), modv_of(P, li)};
            pg8::gemm_phase<pg8::EpiE2, pg8::SchedMoe, true, true>(P.lds, g, S, E, P.tid);
        } SEAM(p0 + 17); PR_END(17);
        PR_BEGIN(18); if (IN(p0 + 18)) { PHASE_FRAME(); phase_cb(P, li); } SEAM(p0 + 18); PR_END(18);
    }
#undef IN
#undef SEAM
    if (PROBE_MASK != 0 && blockIdx.x == 0) { const unsigned long long t1 = __builtin_amdgcn_s_memrealtime(); while (__builtin_amdgcn_s_memrealtime() - t1 < (unsigned long long)PROBE_MULT * pr_acc) __builtin_amdgcn_s_sleep(32); }
}

extern "C" void kernel_launch(void* const* d_in, const int* in_sizes, int n_in, void* d_out, int out_size, void* d_ws, size_t ws_size, hipStream_t stream) {
    static int grid = 0;
    if (grid == 0) {
        if (n_in != N_IN || in_sizes[0] != NB * SEQ * DM || out_size != NB * SEQ * DM || ws_size < WS_END) {
            fprintf(stderr, "kernel_launch: unexpected problem: n_in %d in0 %d out %d ws %zu (need %zu)\n", n_in, n_in > 0 ? in_sizes[0] : -1, out_size, ws_size, (size_t)WS_END); grid = -1; return; }
        int dev = 0, cus = 0, per_cu = 0;
        if (hipGetDevice(&dev) != hipSuccess || hipDeviceGetAttribute(&cus, hipDeviceAttributeMultiprocessorCount, dev) != hipSuccess) { grid = -1; return; }
        if (hipFuncSetAttribute((const void*)fwd_kernel, hipFuncAttributeMaxDynamicSharedMemorySize, LDS_BYTES) != hipSuccess) { fprintf(stderr, "kernel_launch: hipFuncSetAttribute failed\n"); grid = -1; return; }
        if (hipOccupancyMaxActiveBlocksPerMultiprocessor(&per_cu, (const void*)fwd_kernel, 512, LDS_BYTES) != hipSuccess || per_cu < 1) { fprintf(stderr, "kernel_launch: occupancy query says %d\n", per_cu); }
        (void)hipGetLastError();
        grid = cus;
    }
    if (grid < 0) return;
    (void)hipMemsetAsync((char*)d_ws + WS_CTL, 0, CTL_ZERO_BYTES, stream);
    Args a{};
    for (int i = 0; i < N_IN; ++i) a.in[i] = (const float*)d_in[i];
    a.out = (float*)d_out; a.ws = (unsigned char*)d_ws; a.pad = 0;
#if MK_ONE_LAUNCH
    a.ph_lo = 0; a.ph_hi = NLAYER * NPH; a.bar_region = 0;
    hipLaunchKernelGGL(fwd_kernel, dim3(grid), dim3(512), LDS_BYTES, stream, a);
#else
    for (int p = 0; p < NLAYER * NPH; ++p) { a.ph_lo = p; a.ph_hi = p + 1; a.bar_region = 0; hipLaunchKernelGGL(fwd_kernel, dim3(grid), dim3(512), LDS_BYTES, stream, a); }
#endif
}
```

```cpp
#include <hip/hip_runtime.h>
#include <hip/hip_bf16.h>
#include <cstdio>
#include <cstdint>
#include <cmath>

#ifndef MK_ONE_LAUNCH
#define MK_ONE_LAUNCH 1
#endif
#ifndef MK_CHECK
#define MK_CHECK 0
#endif

constexpr int DM = 1024, NB = 8, SEQ = 8192, CTXL = 256, TPB = SEQ + CTXL, MROWS = NB * TPB;
constexpr int NLAYER = 2, INCOLS = 4368, NPROJ = 4352, GRIDW = 64;
constexpr int NEXP = 16, FF = 1024, CAP_L = 1024, CAP_C = 32;
constexpr int NCHUNK = TPB / 64;
constexpr float EPSN = 1e-6f;
constexpr float C2Q = 0.125f * 1.4426950408889634f;

enum { I_X = 0, I_C, I_CTX, I_CCTX, I_WMOD, I_BMOD, I_N1W, I_N2W, I_WIN, I_GQN, I_GKN, I_DQN, I_DKN, I_LQ1, I_LK1, I_LQ2, I_LK2, I_SUBLN,
       I_CONVW, I_ALOG, I_DTB, I_GNW, I_WMG, I_WBR, I_WOUT, I_WRT, I_WEG, I_WEU, I_WED, N_IN };

constexpr size_t MiB = 1u << 20;
constexpr size_t WS_CTL = 0, CTL_ZERO_BYTES = 1 * MiB;
constexpr size_t WS_MODV = 1 * MiB;
constexpr size_t WS_ROPE = 1 * MiB + 512 * 1024;
constexpr size_t WS_LAM = 1 * MiB + 768 * 1024;
constexpr size_t WS_GDNG = 2 * MiB;
constexpr size_t WS_GCB = 7 * MiB;
constexpr size_t WS_AFF = 12 * MiB;
constexpr size_t WS_IDX = 17 * MiB;
constexpr size_t WS_WGT = 18 * MiB;
constexpr size_t WS_INV = 19 * MiB;
constexpr size_t WS_XC = 24 * MiB;
constexpr size_t WS_WMIX = 32 * MiB;
constexpr size_t WM_WIN = 0, WM_WG = 9 * MiB, WM_WB = 15 * MiB, WM_WO = 18 * MiB;
constexpr size_t WS_WEXP = 56 * MiB;
constexpr size_t WE_GU = 0, WE_D = 64 * MiB;
constexpr size_t WS_H = 152 * MiB;
constexpr size_t WS_S = 284 * MiB;
constexpr size_t WS_YA = WS_S, WS_YB = WS_S + 66 * MiB, WS_YG = WS_S + 132 * MiB;
constexpr size_t WS_KA = WS_S + 198 * MiB, WS_VA = WS_KA + 17 * MiB;
constexpr size_t WS_QB = WS_S + 232 * MiB, WS_KB = WS_QB + 66 * MiB, WS_VB = WS_KB + 66 * MiB;
constexpr size_t WS_OB = WS_VB + 66 * MiB;
constexpr size_t WS_TQ = WS_S;
constexpr size_t WS_CPRE = WS_S + 198 * MiB;
constexpr size_t WS_Z = WS_CPRE + 198 * MiB;
constexpr size_t WS_POST = WS_Z + 66 * MiB;
constexpr size_t WS_G = WS_S + 198 * MiB;
constexpr size_t WS_MRG = WS_G + 396 * MiB;
constexpr size_t WS_XIN = WS_S, WS_HID = WS_S + 264 * MiB;
constexpr size_t WS_END = WS_S + 728 * MiB;
static_assert(WS_POST + 198 * MiB <= WS_END && WS_MRG + 132 * MiB <= WS_END && WS_HID + 264 * MiB <= WS_END && WS_OB + 132 * MiB <= WS_END, "ws map");
static_assert(WS_END <= 1024 * MiB, "ws map exceeds 1 GiB");
constexpr int NSLOT_L = NB * NEXP * CAP_L, NSLOT_C = NB * NEXP * CAP_C, NSLOT = NSLOT_L + NSLOT_C;

constexpr int RING_BYTES = 131072, LDSCTL_OFF = RING_BYTES, MISC_OFF = LDSCTL_OFF + 320, LDS_BYTES = 147456;
constexpr int LDS_XTRA = MISC_OFF + 128;

#define GAS __attribute__((address_space(1)))
#define LAS __attribute__((address_space(3)))
typedef unsigned short bf16;
typedef unsigned v4u __attribute__((ext_vector_type(4)));
typedef unsigned v2u __attribute__((ext_vector_type(2)));
typedef float f32x4 __attribute__((ext_vector_type(4)));
typedef float f32x2 __attribute__((ext_vector_type(2)));
typedef short bf16x8 __attribute__((ext_vector_type(8)));
typedef GAS unsigned gu32;
#define RLX_AGENT __ATOMIC_RELAXED, __HIP_MEMORY_SCOPE_AGENT
#define LDS_WAIT() asm volatile("s_waitcnt lgkmcnt(0)" ::: "memory")
#define VM_WAIT() asm volatile("s_waitcnt vmcnt(0)" ::: "memory")
#define DI __device__ __forceinline__

DI unsigned f2bf(float f) { unsigned u = __builtin_bit_cast(unsigned, f); return (u + 0x7fffu + ((u >> 16) & 1u)) >> 16; }
DI unsigned pk2(float lo, float hi) { typedef __bf16 b2 __attribute__((ext_vector_type(2))); f32x2 v = {lo, hi}; b2 b = __builtin_convertvector(v, b2); return __builtin_bit_cast(unsigned, b); }
DI float bf2f(unsigned short b) { return __builtin_bit_cast(float, (unsigned)b << 16); }
DI float bflo(unsigned w) { return __builtin_bit_cast(float, w << 16); }
DI float bfhi(unsigned w) { return __builtin_bit_cast(float, w & 0xffff0000u); }
DI float sigmoidf_(float x) { return __builtin_amdgcn_rcpf(1.f + __expf(-x)); }
DI float siluf_(float x) { return x * __builtin_amdgcn_rcpf(1.f + __expf(-x)); }
DI float wave_sum(float v) {
#pragma unroll
    for (int o = 1; o < 64; o <<= 1) v += __shfl_xor(v, o);
    return v;
}
DI float sum16(float v) { v += __shfl_xor(v, 1); v += __shfl_xor(v, 2); v += __shfl_xor(v, 4); v += __shfl_xor(v, 8); return v; }
DI float reduce16(const float (&v)[16], int lane) {
    float a[8], b[4], c[2], d;
    const bool b5 = lane & 32, b4 = lane & 16, b3 = lane & 8, b2 = lane & 4;
#pragma unroll
    for (int i = 0; i < 8; ++i) { const float keep = b5 ? v[i + 8] : v[i], send = b5 ? v[i] : v[i + 8]; a[i] = keep + __shfl_xor(send, 32); }
#pragma unroll
    for (int i = 0; i < 4; ++i) { const float keep = b4 ? a[i + 4] : a[i], send = b4 ? a[i] : a[i + 4]; b[i] = keep + __shfl_xor(send, 16); }
#pragma unroll
    for (int i = 0; i < 2; ++i) { const float keep = b3 ? b[i + 2] : b[i], send = b3 ? b[i] : b[i + 2]; c[i] = keep + __shfl_xor(send, 8); }
    { const float keep = b2 ? c[1] : c[0], send = b2 ? c[0] : c[1]; d = keep + __shfl_xor(send, 4); }
    d += __shfl_xor(d, 2); d += __shfl_xor(d, 1);
    return d;
}

DI float max_b2345(float m) { m = fmaxf(m, __shfl_xor(m, 4)); m = fmaxf(m, __shfl_xor(m, 8)); m = fmaxf(m, __shfl_xor(m, 16)); m = fmaxf(m, __shfl_xor(m, 32)); return m; }
DI float sum_b2345(float s) { s += __shfl_xor(s, 4); s += __shfl_xor(s, 8); s += __shfl_xor(s, 16); s += __shfl_xor(s, 32); return s; }

#define MFMA32(a, b, c) __builtin_amdgcn_mfma_f32_32x32x16_bf16((a), (b), (c), 0, 0, 0)
#define MFMA16(a, b, c) __builtin_amdgcn_mfma_f32_16x16x32_bf16((a), (b), (c), 0, 0, 0)
#define XB_TMO      128
#define XB_XCNT(j)  (256  + 64 * (j))
#define XB_XSUB(j)  (1280 + 64 * (j))
#define XB_XGEN(j)  (2304 + 64 * (j))
#define XB_TOP      3328
#define XB_TOPGEN   3392
#define XCD_BAR_WORDS 3456
#define XB_SPIN_CAP (1u << 22)
DI unsigned xb_ld(unsigned* p)              { return __hip_atomic_load(p, __ATOMIC_RELAXED, __HIP_MEMORY_SCOPE_AGENT); }
DI unsigned xb_add(unsigned* p, unsigned v) { return __hip_atomic_fetch_add(p, v, __ATOMIC_RELAXED, __HIP_MEMORY_SCOPE_AGENT); }
DI unsigned xb_xcc_id() { return (unsigned)__builtin_amdgcn_s_getreg((3 << 11) | 20) & 0xFu; }
#define XB_SPIN(cond, bar) do { unsigned _sp = 0; while (cond) { __builtin_amdgcn_s_sleep(1); \
    if ((++_sp & 255u) == 0u) { if (xb_ld(&(bar)[XB_TMO])) break; if (_sp > XB_SPIN_CAP) { atomicAdd(&(bar)[XB_TMO], 1u); break; } } } } while (0)
struct XcdBarrier { unsigned* bar; unsigned x; volatile LAS unsigned* st; };
DI XcdBarrier xcd_barrier_post(unsigned* bar, volatile LAS unsigned* st) {
    XcdBarrier b; b.bar = bar; b.x = xb_xcc_id(); b.st = st;
    if (threadIdx.x == 0) (void)xb_add(&bar[XB_XCNT(b.x)], 1u);
    return b;
}
DI void xcd_barrier_complete(unsigned* bar, unsigned x, unsigned& nloc, unsigned& nx) {
    const unsigned G = gridDim.x * gridDim.y * gridDim.z;
    unsigned sum, cnt, mine, sp = 0u;
    for (;;) {
        sum = 0u; cnt = 0u; mine = 0u;
#pragma unroll
        for (unsigned j = 0; j < 16; ++j) { const unsigned c = xb_ld(&bar[XB_XCNT(j)]); sum += c; cnt += (c > 0u) ? 1u : 0u; mine = (j == x) ? c : mine; }
        if (sum == G) break;
        __builtin_amdgcn_s_sleep(1);
        if ((++sp & 255u) == 0u) { if (xb_ld(&bar[XB_TMO])) break; if (sp > XB_SPIN_CAP) { atomicAdd(&bar[XB_TMO], 1u); break; } }
    }
    nloc = mine > 0u ? mine : 1u; nx = cnt > 0u ? cnt : 1u;
}
DI void xcd_barrier(const XcdBarrier& b) {
    asm volatile("s_waitcnt vmcnt(0)" ::: "memory");
    __syncthreads();
    if (threadIdx.x == 0) {
        unsigned* bar = b.bar;
        __builtin_amdgcn_s_waitcnt(0);
        unsigned nloc = b.st[0], nx = b.st[1];
        if (nloc == 0u) { xcd_barrier_complete(bar, b.x, nloc, nx); b.st[0] = nloc; b.st[1] = nx; }
        const unsigned old = xb_add(&bar[XB_XSUB(b.x)], 1u);
        const unsigned gen = old / nloc;
        if (old + 1u == (gen + 1u) * nloc) {
            __builtin_amdgcn_fence(__ATOMIC_RELEASE, "agent");
            asm volatile("s_waitcnt vmcnt(0)" ::: "memory");
            const unsigned og = xb_add(&bar[XB_TOP], 1u);
            const unsigned tg = og / nx;
            if (og + 1u == (tg + 1u) * nx) xb_add(&bar[XB_TOPGEN], 1u);
            else XB_SPIN(xb_ld(&bar[XB_TOPGEN]) == tg, bar);
            __builtin_amdgcn_fence(__ATOMIC_ACQUIRE, "agent");
            xb_add(&bar[XB_XGEN(b.x)], 1u);
            asm volatile("s_waitcnt vmcnt(0)" ::: "memory");
        } else {
            XB_SPIN(xb_ld(&bar[XB_XGEN(b.x)]) == gen, bar);
            __builtin_amdgcn_fence(__ATOMIC_ACQUIRE, "agent");
            asm volatile("s_waitcnt vmcnt(0)" ::: "memory");
        }
    }
    __syncthreads();
}
namespace pg8 {
#define PG8_LAS __attribute__((address_space(3)))
typedef unsigned short bf16_t;
typedef short bf16x8 __attribute__((ext_vector_type(8)));
typedef float f32x4 __attribute__((ext_vector_type(4)));
typedef unsigned u32x4 __attribute__((ext_vector_type(4)));
constexpr int BM = 256, BK = 64, HALF = 128, HTB = HALF * BK * 2  , STAGE_BYTES = 8 * HTB, NXCD = 8, WGM = 8;

__host__ __device__ __forceinline__ int lds_byte(int r, int c) { const int st = (r >> 4) * 2 + (c >> 5), rr = r & 15, cc = c & 31, ob = rr * 64 + cc * 2; return st * 1024 + (ob ^ (((ob >> 9) & 1) << 5)); }
__host__ __device__ __forceinline__ void stage_rc(int b, int& R, int& C) { const int st = b / 1024, sb = b % 1024, swz = sb ^ (((sb >> 9) & 1) << 5); R = (st >> 1) * 16 + swz / 64; C = (st & 1) * 32 + (swz % 64) / 2; }
__host__ __device__ __forceinline__ int perm32(int rho) { const int n = rho >> 4, i = rho & 15; return 8 * (i >> 2) + 4 * n + (i & 3); }

struct Unit { int pm, pn, z; };
struct Gemm { int lda, ldb, K; unsigned* scr; };

__device__ __forceinline__ unsigned cvt_pk_bf16(float lo, float hi) { typedef __bf16 b2_t __attribute__((ext_vector_type(2))); typedef float f2_t __attribute__((ext_vector_type(2))); f2_t v = {lo, hi}; b2_t b = __builtin_convertvector(v, b2_t); return __builtin_bit_cast(unsigned, b); }
typedef float f32x2 __attribute__((ext_vector_type(2)));
template <class Epi, class Sched, bool ALIGN_EPI = false, bool SP2 = false>
__device__ __forceinline__ void gemm_phase(PG8_LAS unsigned char* lds, const Gemm g, const Sched& S, const Epi& E, const int tid  ) {
    const int wid = __builtin_amdgcn_readfirstlane(tid >> 6), lane = tid & 63, wr = wid >> 2, wc = wid & 3, fr = lane & 15, fq = lane >> 4;
    const int K = g.K, nt = K / BK;
    unsigned voffA, voffB;
    { int R, C; stage_rc(tid * 16, R, C); const int Rb = Epi::PERM ? ((R & ~31) + perm32(R & 31)) : R; voffA = (unsigned)(R * g.lda + C) * 2u; voffB = (unsigned)(Rb * g.ldb + C) * 2u; }
    const size_t pstepA = (size_t)64 * g.lda * 2, pstepB = (size_t)64 * g.ldb * 2;
    constexpr bool GATHER = Sched::GATHER;
    unsigned gA[2][2][2];
#define PG8_GOFF(u_, w_) do { if constexpr (GATHER) { _Pragma("unroll") for (int _h = 0; _h < 2; ++_h) _Pragma("unroll") for (int _i = 0; _i < 2; ++_i) { int R_, C_; stage_rc(tid * 16 + _i * 8192, R_, C_); \
        gA[w_][_h][_i] = (unsigned)S.row_of((u_).pm * BM + _h * HALF + R_) * (unsigned)(g.lda * 2) + (unsigned)(C_ * 2); } } } while (0)
    const size_t kstep = (size_t)(BK * 2);
    const size_t hstepA = (size_t)HALF * g.lda * 2, hstepB = (size_t)HALF * g.ldb * 2;
    const unsigned ldsw = (unsigned)wid * 1024u;
    const int aoff = lds_byte(wr * 64 + fr, fq * 8), boff = lds_byte(wc * 32 + fr, fq * 8);
#define PG8_SA(b, h) (((b) * 2 + (h)) * HTB)
#define PG8_SB(b, h) ((4 + (b) * 2 + (h)) * HTB)
#define PG8_STAGE2(bufoff, gbase, voff) do { _Pragma("unroll") for (int _i = 0; _i < 2; ++_i) \
        __builtin_amdgcn_global_load_lds((const unsigned*)((const char*)(gbase) + (voff)[_i]), (PG8_LAS unsigned*)(lds + (bufoff) + ldsw + _i * 8192), 16, 0, 0); } while (0)
#define PG8_STAGE1(bufoff, gbase, voff, pstep) do { _Pragma("unroll") for (int _i = 0; _i < 2; ++_i) \
        __builtin_amdgcn_global_load_lds((const unsigned*)((const char*)(gbase) + _i * (pstep) + (voff)), (PG8_LAS unsigned*)(lds + (bufoff) + ldsw + _i * 8192), 16, 0, 0); } while (0)
#define PG8_STAGE(bufoff, gbase, voffB_) PG8_STAGE1(bufoff, gbase, voffB, pstepB)
#define PG8_STAGE_A(bufoff, ptr, h, un) do { if constexpr (GATHER) { const bool _n = (un); unsigned _v[2] = {_n ? gA[1][h][0] : gA[0][h][0], _n ? gA[1][h][1] : gA[0][h][1]}; PG8_STAGE2(bufoff, ptr, _v); } \
        else { PG8_STAGE1(bufoff, (ptr) + (h) * hstepA, voffA, pstepA); } } while (0)
#define PG8_LDA(dst, b, h) do { _Pragma("unroll") for (int m = 0; m < 4; ++m) _Pragma("unroll") for (int k = 0; k < 2; ++k) dst[m][k] = *(const PG8_LAS bf16x8*)(lds + PG8_SA(b, h) + aoff + m * 2048 + k * 1024); } while (0)
#define PG8_LDB(dst, b, h) do { _Pragma("unroll") for (int n = 0; n < 2; ++n) _Pragma("unroll") for (int k = 0; k < 2; ++k) dst[n][k] = *(const PG8_LAS bf16x8*)(lds + PG8_SB(b, h) + boff + n * 2048 + k * 1024); } while (0)
#define PG8_MMA(ai, bj, At, Bt) do { __builtin_amdgcn_s_setprio(1); _Pragma("unroll") for (int m = 0; m < 4; ++m) _Pragma("unroll") for (int n = 0; n < 2; ++n) _Pragma("unroll") for (int k = 0; k < 2; ++k) \
        acc[ai][bj][m][n] = __builtin_amdgcn_mfma_f32_16x16x32_bf16(Bt[n][k], At[m][k], acc[ai][bj][m][n], 0, 0, 0); __builtin_amdgcn_s_setprio(0); } while (0)
#define PG8_WAIT_V(n) asm volatile("s_waitcnt vmcnt(" #n ")" ::: "memory")
#define PG8_WAIT_L(n) asm volatile("s_waitcnt lgkmcnt(" #n ")" ::: "memory")
#define PG8_BAR __builtin_amdgcn_s_barrier()
#define PG8_SCHED __builtin_amdgcn_sched_barrier(0)
    Unit cur, nxt; int ui = 0;
    if (!S.next(0, cur)) return;
    f32x4 acc[2][2][4][2];
#pragma unroll
    for (int a = 0; a < 2; ++a)
#pragma unroll
        for (int b = 0; b < 2; ++b)
#pragma unroll
            for (int m = 0; m < 4; ++m)
#pragma unroll
                for (int n = 0; n < 2; ++n) acc[a][b][m][n] = (f32x4){0.f, 0.f, 0.f, 0.f};
    bf16x8 At[4][2], B0[2][2], B1[2][2];
    const char* cA = S.a_ptr(cur); const char* cB = S.b_ptr(cur);
    S.a_ready(cur); PG8_GOFF(cur, 0);
    if constexpr (SP2) {
        PG8_STAGE(PG8_SB(0, 0), cB, voffB); PG8_STAGE(PG8_SB(0, 1), cB + hstepB, voffB); PG8_STAGE_A(PG8_SA(0, 0), cA, 0, false); PG8_STAGE_A(PG8_SA(0, 1), cA, 1, false);
        if (wr == 1) PG8_BAR;
        PG8_WAIT_V(2); PG8_BAR;
        PG8_STAGE(PG8_SB(1, 0), cB + kstep, voffB); PG8_STAGE_A(PG8_SA(1, 0), cA + kstep, 0, false); PG8_STAGE(PG8_SB(1, 1), cB + hstepB + kstep, voffB);
        PG8_WAIT_V(6); PG8_BAR;
    } else {
        PG8_STAGE(PG8_SB(0, 0), cB, voffB); PG8_STAGE1(PG8_SA(0, 0), cA, voffA, pstepA); PG8_STAGE(PG8_SB(0, 1), cB + hstepB, voffB); PG8_STAGE1(PG8_SA(0, 1), cA + hstepA, voffA, pstepA);
        if (wr == 1) PG8_BAR;
        PG8_WAIT_V(4); PG8_BAR;
        PG8_STAGE(PG8_SB(1, 0), cB + kstep, voffB); PG8_STAGE1(PG8_SA(1, 0), cA + kstep, voffA, pstepA); PG8_STAGE(PG8_SB(1, 1), cB + hstepB + kstep, voffB);
        PG8_WAIT_V(6); PG8_BAR;
    }
    for (;;) {
        const bool has_next = S.next(ui + 1, nxt); if (has_next) PG8_GOFF(nxt, 1);
        const char* nA = has_next ? S.a_ptr(nxt) : cA; const char* nB = has_next ? S.b_ptr(nxt) : cB;
        for (int t = 0; t < nt; t += 2) {
            const bool last = (t == nt - 2);
            const char* a1 = cA + (size_t)(t + 1) * kstep;
            const char* a2 = last ? nA : cA + (size_t)(t + 2) * kstep; const char* b2 = last ? nB : cB + (size_t)(t + 2) * kstep;
            const char* a3 = a2 + kstep; const char* b3 = b2 + kstep;
            if (last && has_next) S.a_ready(nxt);
            if constexpr (SP2) {
            PG8_LDB(B0, 0, 0); PG8_LDB(B1, 0, 1); PG8_SCHED; PG8_LDA(At, 0, 0); PG8_STAGE_A(PG8_SA(1, 1), a1, 1, false);
            PG8_WAIT_V(8); PG8_WAIT_L(0); PG8_BAR; PG8_MMA(0, 0, At, B0); PG8_MMA(0, 1, At, B1); PG8_BAR; PG8_SCHED;
            PG8_LDA(At, 0, 1); PG8_STAGE(PG8_SB(0, 0), b2, voffB); PG8_STAGE(PG8_SB(0, 1), b2 + hstepB, voffB); PG8_STAGE_A(PG8_SA(0, 0), a2, 0, last && has_next);
            PG8_WAIT_V(8); PG8_WAIT_L(0); PG8_BAR; PG8_MMA(1, 0, At, B0); PG8_MMA(1, 1, At, B1); PG8_BAR; PG8_SCHED;
            PG8_LDB(B0, 1, 0); PG8_LDB(B1, 1, 1); PG8_SCHED; PG8_LDA(At, 1, 0); PG8_STAGE_A(PG8_SA(0, 1), a2, 1, last && has_next);
            PG8_WAIT_V(8); PG8_WAIT_L(0); PG8_BAR; PG8_MMA(0, 0, At, B0); PG8_MMA(0, 1, At, B1); PG8_BAR; PG8_SCHED;
            PG8_LDA(At, 1, 1); PG8_STAGE(PG8_SB(1, 0), b3, voffB); PG8_STAGE(PG8_SB(1, 1), b3 + hstepB, voffB); PG8_STAGE_A(PG8_SA(1, 0), a3, 0, last && has_next);
            PG8_WAIT_V(8); PG8_WAIT_L(0); PG8_BAR; PG8_MMA(1, 0, At, B0); PG8_MMA(1, 1, At, B1); PG8_BAR; PG8_SCHED;
            } else {
            PG8_LDB(B0, 0, 0); PG8_SCHED; PG8_LDA(At, 0, 0); PG8_STAGE1(PG8_SA(1, 1), a1 + hstepA, voffA, pstepA);
            PG8_WAIT_L(8); PG8_BAR; PG8_WAIT_L(0); PG8_MMA(0, 0, At, B0); PG8_BAR; PG8_SCHED;
            PG8_LDB(B1, 0, 1); PG8_STAGE(PG8_SB(0, 0), b2, voffB);
            PG8_BAR; PG8_WAIT_L(0); PG8_MMA(0, 1, At, B1); PG8_BAR;
            PG8_LDA(At, 0, 1); PG8_STAGE1(PG8_SA(0, 0), a2, voffA, pstepA);
            PG8_BAR; PG8_WAIT_L(0); PG8_MMA(1, 0, At, B0); PG8_BAR; PG8_SCHED;
            PG8_STAGE(PG8_SB(0, 1), b2 + hstepB, voffB);
            PG8_WAIT_V(6); PG8_BAR; PG8_MMA(1, 1, At, B1); PG8_BAR;
            PG8_LDB(B0, 1, 0); PG8_SCHED; PG8_LDA(At, 1, 0); PG8_STAGE1(PG8_SA(0, 1), a2 + hstepA, voffA, pstepA);
            PG8_WAIT_L(8); PG8_BAR; PG8_WAIT_L(0); PG8_MMA(0, 0, At, B0); PG8_BAR; PG8_SCHED;
            PG8_LDB(B1, 1, 1); PG8_STAGE(PG8_SB(1, 0), b3, voffB);
            PG8_BAR; PG8_WAIT_L(0); PG8_MMA(0, 1, At, B1); PG8_BAR;
            PG8_LDA(At, 1, 1); PG8_STAGE1(PG8_SA(1, 0), a3, voffA, pstepA);
            PG8_BAR; PG8_WAIT_L(0); PG8_MMA(1, 0, At, B0); PG8_BAR; PG8_SCHED;
            PG8_STAGE(PG8_SB(1, 1), b3 + hstepB, voffB);
            PG8_WAIT_V(6); PG8_BAR; PG8_MMA(1, 1, At, B1); PG8_BAR;
            }
        }
        if constexpr (ALIGN_EPI) { if (wr == 0) PG8_BAR; }
        bool keep = false;
        if constexpr (!Epi::AFTER_DRAIN) { if constexpr (Epi::INPLACE) keep = E.inplace(acc, cur, wr, wc, fr, fq); else E(acc, cur, wr, wc, fr, fq); S.done(cur); }
        if (!has_next) break;
        if (!keep)
#pragma unroll
        for (int a = 0; a < 2; ++a)
#pragma unroll
            for (int b = 0; b < 2; ++b)
#pragma unroll
                for (int m = 0; m < 4; ++m)
#pragma unroll
                    for (int n = 0; n < 2; ++n) acc[a][b][m][n] = (f32x4){0.f, 0.f, 0.f, 0.f};
        cur = nxt; cA = nA; cB = nB; ++ui;
        if constexpr (GATHER) { _Pragma("unroll") for (int _h = 0; _h < 2; ++_h) _Pragma("unroll") for (int _i = 0; _i < 2; ++_i) gA[0][_h][_i] = gA[1][_h][_i]; }
        if constexpr (ALIGN_EPI) { if (wr == 1) PG8_BAR; }
    }
    PG8_WAIT_V(0);
    if constexpr (!ALIGN_EPI) { if (wr == 0) PG8_BAR; }
    PG8_BAR;
    if constexpr (Epi::AFTER_DRAIN) { E.fused(acc, cur, wr, wc, fr, fq, lds, wid, lane); S.done(cur); }
#undef PG8_SA
#undef PG8_SB
#undef PG8_STAGE
#undef PG8_STAGE_A
#undef PG8_GOFF
#undef PG8_LDA
#undef PG8_LDB
#undef PG8_MMA
#undef PG8_WAIT_V
#undef PG8_WAIT_L
#undef PG8_BAR
#undef PG8_SCHED
}
}
namespace pg8 {
struct SchedMN {
    static constexpr bool GATHER = false; DI int row_of(int r) const { return r; }
    const char* A; const char* B; size_t a_tile, b_tile, a_z, b_z;
    int nM, nN, nwg, G, c, NZ, pn0, skipctx;
    DI void init(const void* A_, size_t lda, const void* B_, size_t ldb, int nM_, int nN_, int pn0_, int G_, int c_) {
        A = (const char*)A_; B = (const char*)B_; a_tile = 256 * lda * 2; b_tile = 256 * ldb * 2; a_z = 0; b_z = 0; nM = nM_; nN = nN_; nwg = nM * nN; G = G_; c = c_; NZ = 1; pn0 = pn0_; skipctx = 0; }
    DI bool next(int i, Unit& u) const {
        const int ti = i / NZ; u.z = i - ti * NZ;
        const long L = (long)ti * G + c; if (L >= nwg) return false;
        int wgid = (int)L; { const int q = nwg / NXCD, r = nwg % NXCD, xcd = wgid % NXCD, off = wgid / NXCD; wgid = (xcd < r ? xcd * (q + 1) : r * (q + 1) + (xcd - r) * q) + off; }
        const int nig = WGM * nN, gid = wgid / nig, fm = gid * WGM, gsz = (nM - fm) < WGM ? (nM - fm) : WGM;
        u.pm = fm + ((wgid % nig) % gsz); u.pn = pn0 + (wgid % nig) / gsz; if (skipctx) u.pm += u.pm >> 5; return true;
    }
    DI const char* a_ptr(const Unit& u) const { return A + (size_t)u.pm * a_tile + (size_t)u.z * a_z; }
    DI const char* b_ptr(const Unit& u) const { return B + (size_t)u.pn * b_tile + (size_t)u.z * b_z; }
    DI void a_ready(const Unit&) const {}
    DI void done(const Unit&) const {}
};
struct SchedMoe {
    static constexpr bool GATHER = false; DI int row_of(int r) const { return r; }
    const char* A; const char* B; size_t b_exp; int nN, ntot, G, c;
    DI bool next(int i, Unit& u) const { const long L = (long)i * G + c; if (L >= ntot) return false; u.pm = (int)(L / nN); u.pn = (int)(L % nN); u.z = u.pm < 512 ? (u.pm >> 5) : (u.pm - 512); return true; }
    DI const char* a_ptr(const Unit& u) const { return A + (size_t)u.pm * (256 * 1024 * 2); }
    DI const char* b_ptr(const Unit& u) const { return B + (size_t)u.z * b_exp + (size_t)u.pn * (256 * 1024 * 2); }
    DI void a_ready(const Unit&) const {}
    DI void done(const Unit&) const {}
};

struct SchedMoeG {
    static constexpr bool GATHER = true;
    const char* A; const char* B; size_t b_exp; int nN, ntot, G, c; const int* idx;
    DI int row_of(int r) const { return idx[r]; }
    DI bool next(int i, Unit& u) const { const long L = (long)i * G + c; if (L >= ntot) return false; u.pm = (int)(L / nN); u.pn = (int)(L % nN); u.z = u.pm < 512 ? (u.pm >> 5) : (u.pm - 512); return true; }
    DI const char* a_ptr(const Unit&) const { return A; }
    DI const char* b_ptr(const Unit& u) const { return B + (size_t)u.z * b_exp + (size_t)u.pn * (256 * 1024 * 2); }
    DI void a_ready(const Unit&) const {}
    DI void done(const Unit&) const {}
};

struct EpiInProj {
    static constexpr bool PERM = false, AFTER_DRAIN = false, INPLACE = false;
    unsigned char* ws; const float *gqn, *gkn, *dqn, *dkn; const float* rope;
    DI void operator()(const f32x4 (&acc)[2][2][4][2], const Unit& u, int wr, int wc, int fr, int fq) const {
        const int pn = u.pn;
        bf16_t* dst; int pitch, col0; const float* nw = nullptr; float scale = 1.f;
        if (pn < 2)       { dst = (bf16_t*)(ws + WS_YA); pitch = 512; col0 = (pn * 4 + wc) * 64; nw = gqn; scale = C2Q; }
        else if (pn == 2) { if (wc < 2) { dst = (bf16_t*)(ws + WS_KA); pitch = 128; col0 = wc * 64; nw = gkn; } else { dst = (bf16_t*)(ws + WS_VA); pitch = 128; col0 = (wc - 2) * 64; } }
        else if (pn < 5)  { dst = (bf16_t*)(ws + WS_QB); pitch = 512; col0 = ((pn - 3) * 4 + wc) * 64; nw = dqn; scale = C2Q; }
        else if (pn < 7)  { dst = (bf16_t*)(ws + WS_KB); pitch = 512; col0 = ((pn - 5) * 4 + wc) * 64; nw = dkn; }
        else if (pn < 9)  { dst = (bf16_t*)(ws + WS_VB); pitch = 512; col0 = (pn - 7) * 256 + wc * 64; }
        else if (pn < 15) { dst = (bf16_t*)(ws + WS_CPRE); pitch = 1536; col0 = (pn - 9) * 256 + wc * 64; }
        else              { dst = (bf16_t*)(ws + WS_Z); pitch = 512; col0 = (pn - 15) * 256 + wc * 64; }
        f32x4 w4[2][2];
        if (nw) {
#pragma unroll
            for (int bj = 0; bj < 2; ++bj)
#pragma unroll
                for (int n = 0; n < 2; ++n) w4[bj][n] = *(const f32x4*)(nw + 32 * bj + 16 * n + 4 * fq);
        }
#pragma unroll
        for (int aim = 0; aim < 4; ++aim) { const int ai = aim >> 1, mb = (aim & 1) * 2;
            f32x4 rt[4][2][2];
            if (nw) {
#pragma unroll
                for (int m = mb; m < mb + 2; ++m) { const int row = u.pm * BM + ai * HALF + wr * 64 + m * 16 + fr, t = row % TPB, tc = t < SEQ ? t : 0;
#pragma unroll
                    for (int bj = 0; bj < 2; ++bj) { const int pos = bj == 0 ? (tc >> 6) : (tc & 63);
                        rt[m][bj][0] = *(const f32x4*)(rope + (pos * 16 + 4 * fq) * 2); rt[m][bj][1] = *(const f32x4*)(rope + (pos * 16 + 4 * fq) * 2 + 4); } }
            }
#pragma unroll
            for (int m = mb; m < mb + 2; ++m) {
                const int row = u.pm * BM + ai * HALF + wr * 64 + m * 16 + fr;
                f32x4 v[2][2];
#pragma unroll
                for (int bj = 0; bj < 2; ++bj)
#pragma unroll
                    for (int n = 0; n < 2; ++n) v[bj][n] = acc[ai][bj][m][n];
                if (nw) {
                    float ss = 0.f;
#pragma unroll
                    for (int bj = 0; bj < 2; ++bj)
#pragma unroll
                        for (int n = 0; n < 2; ++n) ss += (v[bj][n][0] * v[bj][n][0] + v[bj][n][1] * v[bj][n][1]) + (v[bj][n][2] * v[bj][n][2] + v[bj][n][3] * v[bj][n][3]);
                    ss += __shfl_xor(ss, 16); ss += __shfl_xor(ss, 32);
                    const float rstd = rsqrtf(ss * (1.f / 64.f) + EPSN);
#pragma unroll
                    for (int bj = 0; bj < 2; ++bj)
#pragma unroll
                        for (int n = 0; n < 2; ++n) v[bj][n] = v[bj][n] * rstd * w4[bj][n];
                    const int t = row % TPB;
                    if (t < SEQ) {
#pragma unroll
                        for (int bj = 0; bj < 2; ++bj) {
                            const f32x4 cs0 = rt[m][bj][0], cs1 = rt[m][bj][1];
                            const float c[4] = {cs0[0], cs0[2], cs1[0], cs1[2]}, s[4] = {cs0[1], cs0[3], cs1[1], cs1[3]};
#pragma unroll
                            for (int e = 0; e < 4; ++e) { const float x1 = v[bj][0][e], x2 = v[bj][1][e]; v[bj][0][e] = x1 * c[e] - x2 * s[e]; v[bj][1][e] = x2 * c[e] + x1 * s[e]; }
                        }
                    }
                }
                bf16_t* rp = dst + (size_t)row * pitch + col0 + 4 * fq;
#pragma unroll
                for (int bj = 0; bj < 2; ++bj)
#pragma unroll
                    for (int n = 0; n < 2; ++n) { const f32x4 o = v[bj][n] * scale; v2u w; w.x = cvt_pk_bf16(o[0], o[1]); w.y = cvt_pk_bf16(o[2], o[3]); *(v2u*)(rp + 32 * bj + 16 * n) = w; }
            }
        }
    }
};

template <int MODE> struct EpiBf {
    static constexpr bool PERM = true, AFTER_DRAIN = false, INPLACE = false;
    bf16_t* O; int ldc; const bf16_t* Gt;
    DI void operator()(const f32x4 (&acc)[2][2][4][2], const Unit& u, int wr, int wc, int fr, int fq) const {
        const int row0 = u.pm * BM + wr * 64 + fr, col0 = u.pn * BM + wc * 32 + 8 * fq;
#pragma unroll
        for (int ai = 0; ai < 2; ++ai) {
            u32x4 gv[4][2], pv[4][2];
            if (MODE == 1) {
#pragma unroll
                for (int m = 0; m < 4; ++m)
#pragma unroll
                    for (int bj = 0; bj < 2; ++bj) { const size_t row = (size_t)(row0 + ai * HALF + m * 16);
                        gv[m][bj] = *(const u32x4*)(Gt + row * 3072 + u.z * 1024 + col0 + bj * HALF);
                        pv[m][bj] = (u32x4){0u, 0u, 0u, 0u}; if (u.z > 0) pv[m][bj] = *(const u32x4*)(O + row * ldc + col0 + bj * HALF); }
            }
#pragma unroll
            for (int m = 0; m < 4; ++m) { const size_t row = (size_t)(row0 + ai * HALF + m * 16);
#pragma unroll
                for (int bj = 0; bj < 2; ++bj) { f32x4 v0 = acc[ai][bj][m][0], v1 = acc[ai][bj][m][1]; bf16_t* op = O + row * ldc + col0 + bj * HALF;
                    if (MODE == 0) {
                        unsigned lo = 0u, hi = 0u;
#pragma unroll
                        for (int e = 0; e < 4; ++e) { lo = __builtin_amdgcn_cvt_pk_u8_f32(sigmoidf_(v0[e]) * 255.f, e, lo); hi = __builtin_amdgcn_cvt_pk_u8_f32(sigmoidf_(v1[e]) * 255.f, e, hi); }
                        v2u w8; w8.x = lo; w8.y = hi; *(v2u*)((unsigned char*)O + row * 3072 + col0 + bj * HALF) = w8;
                        continue;
                    } else if (MODE == 1) {
                        const u32x4 g = gv[m][bj], p = pv[m][bj];
                        v0[0] = v0[0] * bflo(g.x) + bflo(p.x); v0[1] = v0[1] * bfhi(g.x) + bfhi(p.x); v0[2] = v0[2] * bflo(g.y) + bflo(p.y); v0[3] = v0[3] * bfhi(g.y) + bfhi(p.y);
                        v1[0] = v1[0] * bflo(g.z) + bflo(p.z); v1[1] = v1[1] * bfhi(g.z) + bfhi(p.z); v1[2] = v1[2] * bflo(g.w) + bflo(p.w); v1[3] = v1[3] * bfhi(g.w) + bfhi(p.w);
                    }
                    u32x4 w; w.x = cvt_pk_bf16(v0[0], v0[1]); w.y = cvt_pk_bf16(v0[2], v0[3]); w.z = cvt_pk_bf16(v1[0], v1[1]); w.w = cvt_pk_bf16(v1[2], v1[3]);
                    *(u32x4*)op = w; } }
        }
    }
};

struct EpiMergeH {
    static constexpr bool PERM = true, AFTER_DRAIN = false, INPLACE = true;
    bf16_t* O; int ldc; const bf16_t* Gt;
    DI bool inplace(f32x4 (&acc)[2][2][4][2], const Unit& u, int wr, int wc, int fr, int fq) const {
        const int row0 = u.pm * BM + wr * 64 + fr, col0 = u.pn * BM + wc * 32 + 8 * fq, z = u.z;
        const unsigned char* G8 = (const unsigned char*)Gt;
#define MH_G(w_, k_) fmaxf((float)(((w_) >> (8 * (k_))) & 0xffu) * (1.f / 255.f), 1e-4f)
        if (z < 2) {
#pragma unroll
            for (int ai = 0; ai < 2; ++ai) {
                v2u ga[4][2], gb[4][2];
#pragma unroll
                for (int m = 0; m < 4; ++m)
#pragma unroll
                    for (int bj = 0; bj < 2; ++bj) { const unsigned char* gp = G8 + (size_t)(row0 + ai * HALF + m * 16) * 3072 + z * 1024 + col0 + bj * HALF; ga[m][bj] = *(const v2u*)gp; gb[m][bj] = *(const v2u*)(gp + 1024); }
#pragma unroll
                for (int m = 0; m < 4; ++m)
#pragma unroll
                    for (int bj = 0; bj < 2; ++bj) { const v2u a = ga[m][bj], b = gb[m][bj];
#pragma unroll
                        for (int k = 0; k < 4; ++k) { acc[ai][bj][m][0][k] *= MH_G(a.x, k) * __builtin_amdgcn_rcpf(MH_G(b.x, k)); acc[ai][bj][m][1][k] *= MH_G(a.y, k) * __builtin_amdgcn_rcpf(MH_G(b.y, k)); } }
            }
            return true;
        }
#pragma unroll
        for (int ai = 0; ai < 2; ++ai) {
            v2u ga[4][2];
#pragma unroll
            for (int m = 0; m < 4; ++m)
#pragma unroll
                for (int bj = 0; bj < 2; ++bj) ga[m][bj] = *(const v2u*)(G8 + (size_t)(row0 + ai * HALF + m * 16) * 3072 + 2 * 1024 + col0 + bj * HALF);
#pragma unroll
            for (int m = 0; m < 4; ++m)
#pragma unroll
                for (int bj = 0; bj < 2; ++bj) { const v2u a = ga[m][bj]; const f32x4 v0 = acc[ai][bj][m][0], v1 = acc[ai][bj][m][1];
                    u32x4 w; w.x = cvt_pk_bf16(v0[0] * MH_G(a.x, 0), v0[1] * MH_G(a.x, 1)); w.y = cvt_pk_bf16(v0[2] * MH_G(a.x, 2), v0[3] * MH_G(a.x, 3));
                    w.z = cvt_pk_bf16(v1[0] * MH_G(a.y, 0), v1[1] * MH_G(a.y, 1)); w.w = cvt_pk_bf16(v1[2] * MH_G(a.y, 2), v1[3] * MH_G(a.y, 3));
                    *(u32x4*)(O + (size_t)(row0 + ai * HALF + m * 16) * ldc + col0 + bj * HALF) = w; }
        }
        return false;
#undef MH_G
    }
};

struct EpiE1 {
    static constexpr bool PERM = true, AFTER_DRAIN = false, INPLACE = false;
    bf16_t* H;
    DI void operator()(const f32x4 (&acc)[2][2][4][2], const Unit& u, int wr, int wc, int fr, int fq) const {
        const int row0 = u.pm * BM + wr * 64 + fr, col0 = u.pn * HALF + wc * 32 + 8 * fq;
#pragma unroll
        for (int ai = 0; ai < 2; ++ai)
#pragma unroll
            for (int m = 0; m < 4; ++m) { const size_t row = (size_t)(row0 + ai * HALF + m * 16);
                f32x4 g0 = acc[ai][0][m][0], g1 = acc[ai][0][m][1]; const f32x4 u0 = acc[ai][1][m][0], u1 = acc[ai][1][m][1];
#pragma unroll
                for (int e = 0; e < 4; ++e) { g0[e] = siluf_(g0[e]) * u0[e]; g1[e] = siluf_(g1[e]) * u1[e]; }
                u32x4 w; w.x = cvt_pk_bf16(g0[0], g0[1]); w.y = cvt_pk_bf16(g0[2], g0[3]); w.z = cvt_pk_bf16(g1[0], g1[1]); w.w = cvt_pk_bf16(g1[2], g1[3]);
                *(u32x4*)(H + row * FF + col0) = w; }
    }
};
struct EpiE2 {
    static constexpr bool PERM = true, AFTER_DRAIN = false, INPLACE = false;
    bf16_t* Y; const float* wgt; const float* modv;
    DI void operator()(const f32x4 (&acc)[2][2][4][2], const Unit& u, int wr, int wc, int fr, int fq) const {
        const int row0 = u.pm * BM + wr * 64 + fr, col0 = u.pn * BM + wc * 32 + 8 * fq;
        const int mi = u.pm < NSLOT_L / 256 ? ((u.pm >> 2) & 7) : 8; const float* g2 = modv + mi * 6144 + 5120 + col0;
        f32x4 ga[2], gb[2]; float tw[2][4];
#pragma unroll
        for (int bj = 0; bj < 2; ++bj) { ga[bj] = *(const f32x4*)(g2 + bj * HALF); gb[bj] = *(const f32x4*)(g2 + bj * HALF + 4); }
#pragma unroll
        for (int ai = 0; ai < 2; ++ai)
#pragma unroll
            for (int m = 0; m < 4; ++m) tw[ai][m] = wgt[row0 + ai * HALF + m * 16];
#pragma unroll
        for (int ai = 0; ai < 2; ++ai)
#pragma unroll
            for (int m = 0; m < 4; ++m) { const int row = row0 + ai * HALF + m * 16;
#pragma unroll
                for (int bj = 0; bj < 2; ++bj) { const int c = col0 + bj * HALF;
                    const f32x4 v0 = acc[ai][bj][m][0] * ga[bj] * tw[ai][m], v1 = acc[ai][bj][m][1] * gb[bj] * tw[ai][m];
                    u32x4 w; w.x = cvt_pk_bf16(v0[0], v0[1]); w.y = cvt_pk_bf16(v0[2], v0[3]); w.z = cvt_pk_bf16(v1[0], v1[1]); w.w = cvt_pk_bf16(v1[2], v1[3]);
                    *(u32x4*)(Y + (size_t)row * DM + c) = w; } }
    }
};
}
namespace attn_body {
using bf16=__hip_bfloat16;
using bf16x8=__attribute__((ext_vector_type(8)))short;
using s16x4=__attribute__((ext_vector_type(4)))short;
using f32x16=__attribute__((ext_vector_type(16)))float;
using u32x4=__attribute__((ext_vector_type(4)))unsigned;
constexpr int D=64;
constexpr int NW=8,QBLK=32,QB=QBLK*NW,KVBLK=64;
constexpr int ATTN_UNIT_ROWS=QB;
__device__ __forceinline__ int crow(int r,int hi){return (r&3)+8*(r>>2)+4*hi;}
#define SBAR() __builtin_amdgcn_sched_barrier(0)
constexpr int NSLOT=3, SLOTB=8192;
constexpr int LDS_K=0, LDS_V=NSLOT*SLOTB, LDS_WS=2*NSLOT*SLOTB, LDS_OST=LDS_WS+NW*64*4, LDS_BYTES=LDS_OST+NW*4096;
__device__ __forceinline__ void glds16(const void*gsrc,unsigned lds_dst){unsigned keep;
  asm volatile("s_mov_b32 %0, m0\n\ts_mov_b32 m0, %2\n\ts_nop 0\n\tglobal_load_lds_dwordx4 %1, off\n\ts_mov_b32 m0, %0":"=&s"(keep):"v"(gsrc),"s"(lds_dst):"memory");}
__device__ __forceinline__ float max3f(float a,float b,float c){float r;asm("v_max3_f32 %0, %1, %2, %3":"=v"(r):"v"(a),"v"(b),"v"(c));return r;}
__device__ __forceinline__ float max2f(float a,float b){float r;asm("v_max_f32_e32 %0, %1, %2":"=v"(r):"v"(a),"v"(b));return r;}
__device__ __forceinline__ float fadd_s(float a,float b){float r;asm("v_add_f32_e32 %0, %1, %2":"=v"(r):"v"(a),"v"(b));return r;}
__device__ __forceinline__ float fsub_s(float a,float b){float r;asm("v_sub_f32_e32 %0, %1, %2":"=v"(r):"v"(a),"v"(b));return r;}
typedef float f32x2_t __attribute__((ext_vector_type(2))); typedef __bf16 bf16x2_t __attribute__((ext_vector_type(2)));
__device__ __forceinline__ unsigned cvtpk_s(float lo,float hi){f32x2_t v={lo,hi};bf16x2_t b=__builtin_convertvector(v,bf16x2_t);return __builtin_bit_cast(unsigned,b);}
#define WAIT_BAR(N) asm volatile("s_waitcnt vmcnt(" #N ") lgkmcnt(0)\n\ts_barrier":::"memory")

__device__ __forceinline__ void qkt(f32x16&p0,f32x16&p1,const char*Kslot,const bf16x8*qr,const f32x16&negm,int r32,int hi){
  const char*kb=Kslot+hi*1024+r32*16;
  #pragma unroll
  for(int d0=0;d0<4;++d0){
    const bf16x8 b0=*reinterpret_cast<const bf16x8*>(kb+d0*2048);
    const bf16x8 b1=*reinterpret_cast<const bf16x8*>(kb+d0*2048+512);
    if(d0==0){p0=__builtin_amdgcn_mfma_f32_32x32x16_bf16(b0,qr[0],negm,0,0,0);p1=__builtin_amdgcn_mfma_f32_32x32x16_bf16(b1,qr[0],negm,0,0,0);}
    else{p0=__builtin_amdgcn_mfma_f32_32x32x16_bf16(b0,qr[d0],p0,0,0,0);p1=__builtin_amdgcn_mfma_f32_32x32x16_bf16(b1,qr[d0],p1,0,0,0);}}
}
typedef __attribute__((address_space(3))) const char* lds_cptr;
typedef short v4i16_t __attribute__((ext_vector_type(4)));
__device__ __forceinline__ void kload8(bf16x8*kf,lds_cptr kp){
  kf[0]=*(const __attribute__((address_space(3))) bf16x8*)(kp);      kf[1]=*(const __attribute__((address_space(3))) bf16x8*)(kp+512);
  kf[2]=*(const __attribute__((address_space(3))) bf16x8*)(kp+2048); kf[3]=*(const __attribute__((address_space(3))) bf16x8*)(kp+2560);
  kf[4]=*(const __attribute__((address_space(3))) bf16x8*)(kp+4096); kf[5]=*(const __attribute__((address_space(3))) bf16x8*)(kp+4608);
  kf[6]=*(const __attribute__((address_space(3))) bf16x8*)(kp+6144); kf[7]=*(const __attribute__((address_space(3))) bf16x8*)(kp+6656);
}
__device__ __forceinline__ void kload2(bf16x8*kf,lds_cptr kp,int j){ kf[2*j]=*(const __attribute__((address_space(3))) bf16x8*)(kp+j*2048); kf[2*j+1]=*(const __attribute__((address_space(3))) bf16x8*)(kp+j*2048+512); }
__device__ __forceinline__ s16x4 vtr(lds_cptr p){ return __builtin_bit_cast(s16x4,__builtin_amdgcn_ds_read_tr16_b64_v4i16((__attribute__((address_space(3))) v4i16_t*)p)); }
__device__ __forceinline__ float rowmax(const f32x16&p0,const f32x16&p1){
  float a=max3f(p0[0],p0[1],p1[0]),b=max3f(p0[2],p0[3],p1[1]);a=max3f(a,p1[2],p1[3]);
  #pragma unroll
  for(int r=4;r<16;r+=4){a=max3f(a,p0[r],p0[r+1]);b=max3f(b,p0[r+2],p0[r+3]);a=max3f(a,p1[r],p1[r+1]);b=max3f(b,p1[r+2],p1[r+3]);}
  const float m=max2f(a,b);
  auto rr=__builtin_amdgcn_permlane32_swap(__float_as_uint(m),__float_as_uint(m),false,false);
  return max2f(__uint_as_float(rr[0]),__uint_as_float(rr[1]));
}
__device__ __forceinline__ void pv(f32x16*o,int vb,bf16x8 pa0,bf16x8 pa1,bf16x8 pa2,bf16x8 pa3){
  #pragma unroll
  for(int d0=0;d0<2;++d0){s16x4 lo[4],hi[4];
    #pragma unroll
    for(int ks=0;ks<4;++ks){
      asm volatile("ds_read_b64_tr_b16 %0,%1 offset:%c2":"=&v"(lo[ks]):"v"(vb),"i"(d0*4096+ks*1024):"memory");
      asm volatile("ds_read_b64_tr_b16 %0,%1 offset:%c2":"=&v"(hi[ks]):"v"(vb),"i"(d0*4096+ks*1024+512):"memory");}
    asm volatile("s_waitcnt lgkmcnt(0)":::"memory");SBAR();
    #define PK(k) (bf16x8){lo[k][0],lo[k][1],lo[k][2],lo[k][3],hi[k][0],hi[k][1],hi[k][2],hi[k][3]}
    o[d0]=__builtin_amdgcn_mfma_f32_32x32x16_bf16(pa0,PK(0),o[d0],0,0,0);
    o[d0]=__builtin_amdgcn_mfma_f32_32x32x16_bf16(pa1,PK(1),o[d0],0,0,0);
    o[d0]=__builtin_amdgcn_mfma_f32_32x32x16_bf16(pa2,PK(2),o[d0],0,0,0);
    o[d0]=__builtin_amdgcn_mfma_f32_32x32x16_bf16(pa3,PK(3),o[d0],0,0,0);
    #undef PK
  }
}

#ifndef ATTN_STORE16
#define ATTN_STORE16(p,v) (*(u32x4*)(p)=(v))
#endif
template<int THRL,bool NOMAX> __device__ __forceinline__ void attn_unit(const bf16*Qu,int QP,const bf16*__restrict__ Kh,int KP,const bf16*__restrict__ Vh,int VP,bf16*Ou,int OP,int NT,char*shm,const int tid){
  const int lane=tid&63,r32=lane&31,hi=lane>>5; const int wid=__builtin_amdgcn_readfirstlane(tid>>6);
  const bf16*Qw=Qu+(long)(wid*QBLK)*QP;
  const unsigned lds0=(unsigned)(uintptr_t)shm;
  float*wsf=(float*)(shm+LDS_WS)+wid*64;
  const bf16*ksrc=Kh+(long)lane*KP+wid*8;
  const bf16*vsrc=Vh+(long)(16*(wid&3)+(lane>>2))*VP+(wid>>2)*32+(lane&3)*8;
  const unsigned kdst=lds0+LDS_K+wid*1024, vdst=lds0+LDS_V+wid*1024;
  #define DMA_K(t,slot) glds16(ksrc+(long)(t)*KVBLK*KP,(unsigned)__builtin_amdgcn_readfirstlane(kdst+(slot)))
  #define DMA_V(t,slot) glds16(vsrc+(long)(t)*KVBLK*VP,(unsigned)__builtin_amdgcn_readfirstlane(vdst+(slot)))
  const int vb0=(int)(lds0+LDS_V)+((lane>>4)&1)*32+(lane&3)*8+(4*hi+((lane&15)>>2))*64;
  const char*Kbase=shm+LDS_K; bf16x8 kf[8];
  const lds_cptr shm3=(lds_cptr)shm; const lds_cptr kp0=shm3+LDS_K+hi*1024+r32*16; const lds_cptr vp0=shm3+LDS_V+((lane>>4)&1)*32+(lane&3)*8+(4*hi+((lane&15)>>2))*64;
  DMA_K(0,0);DMA_V(0,0);DMA_K(1,SLOTB);
  bf16x8 qr[4];
  #pragma unroll
  for(int d0=0;d0<4;++d0)qr[d0]=*reinterpret_cast<const bf16x8*>(&Qw[(long)r32*QP+d0*16+hi*8]);
  float mhat=0.f,l_reg=0.f;f32x16 o[2];o[0]=f32x16{};o[1]=f32x16{};f32x16 negm=f32x16{};asm volatile("":"+v"(negm));
  #define CMASK(P0,P1,t) do{}while(0)
  bool resc=false;
  #define START(P0,P1) do{ resc=false; if constexpr(!NOMAX){ const float rm=rowmax(P0,P1); \
    { const float dl=rm; mhat=fadd_s(mhat,dl); \
      _Pragma("unroll") for(int r=0;r<16;++r){P0[r]=fsub_s(P0[r],dl);P1[r]=fsub_s(P1[r],dl);} \
      _Pragma("unroll") for(int r=0;r<16;++r)negm[r]=-mhat; asm volatile("":"+v"(negm)); } } \
    _Pragma("unroll") for(int r=0;r<16;++r)P0[r]=__builtin_amdgcn_exp2f(P0[r]); }while(0)
  #define RESC() do{ if(resc){ asm volatile("s_waitcnt lgkmcnt(0)":::"memory"); \
      _Pragma("unroll") for(int d_=0;d_<2;++d_) _Pragma("unroll") for(int r=0;r<16;++r)o[d_][r]*=wsf[crow(r,hi)]; } }while(0)
  f32x16 pA0,pA1,pB0,pB1;
  int sl_prev=0,sl_cur=0,sl_next=SLOTB;
  #define ROT() do{sl_prev=sl_cur;sl_cur=sl_next;sl_next=(sl_next==(NSLOT-1)*SLOTB)?0:sl_next+SLOTB;}while(0)
  DMA_K(2,2*SLOTB);
  WAIT_BAR(3);
  qkt(pA0,pA1,Kbase,qr,negm,r32,hi);asm volatile("s_nop 15\n\ts_nop 7":"+v"(pA0),"+v"(pA1));CMASK(pA0,pA1,0);
  START(pA0,pA1);
  _Pragma("unroll") for(int r=0;r<16;++r)pA1[r]=__builtin_amdgcn_exp2f(pA1[r]);
  WAIT_BAR(0);
  DMA_K(3,0);DMA_V(1,SLOTB);
  ROT();
  kload8(kf,kp0+sl_cur);
  WAIT_BAR(2);
  s16x4 vlo[8],vhi[8]; u32x4 pw0,pw1,pw2,pw3;
  #define PKW(P,B) cvtpk_s(P[B],P[B+1])
  #define PAF(k) __builtin_bit_cast(bf16x8,pw##k)
  #define VFR(i) (bf16x8){vlo[i][0],vlo[i][1],vlo[i][2],vlo[i][3],vhi[i][0],vhi[i][1],vhi[i][2],vhi[i][3]}
  #define PIN(x) asm volatile("":"+v"(x))
  #define MX3(a,b,c) __builtin_fmaxf(__builtin_fmaxf((a),(b)),(c))
  #define GAPA(MF,A0,A1,A2,A3,W0,W1,PW) do{ MF; sacc+=A0; sacc+=A1; sacc+=A2; sacc+=A3; PIN(sacc); W0; W1; PIN(PW); SBAR(); }while(0)
  #define EX(v) __builtin_amdgcn_exp2f(v)
  #define GAPB(MF,X,B) do{ MF; X[B]=EX(X[B]); X[B+1]=EX(X[B+1]); X[B+2]=EX(X[B+2]); X[B+3]=EX(X[B+3]); PIN(X); SBAR(); }while(0)
  #define VRD(i) do{ vlo[i]=vtr(vp_+(((i)>>2)*4096+((i)&3)*1024)); vhi[i]=vtr(vp_+(((i)>>2)*4096+((i)&3)*1024+512)); }while(0)
  #define KRD(G,j) do{ if(G){ kload2(kf,kp0+sl_next,j); SBAR(); } }while(0)
  #define NEGM_OP (NOMAX?f32x16{}:negm)
  #define STEP(C0,C1,P0,P1,t,GK,GV,GL) do{ SBAR(); \
    const lds_cptr vp_=vp0+sl_prev; \
    VRD(0); SBAR(); float sacc=(P0[0]+P0[1]); \
    GAPA(C0=__builtin_amdgcn_mfma_f32_32x32x16_bf16(kf[0],qr[0],NEGM_OP,0,0,0), P0[2],P0[3],P0[4],P0[5],     pw0[0]=PKW(P0,0), pw0[1]=PKW(P0,2), pw0); \
    VRD(4); SBAR(); GAPA(C1=__builtin_amdgcn_mfma_f32_32x32x16_bf16(kf[1],qr[0],NEGM_OP,0,0,0), P0[6],P0[7],P0[8],P0[9],     pw0[2]=PKW(P0,4), pw0[3]=PKW(P0,6), pw0); \
    VRD(1); SBAR(); GAPA(C0=__builtin_amdgcn_mfma_f32_32x32x16_bf16(kf[2],qr[1],C0,0,0,0),   P0[10],P0[11],P0[12],P0[13], pw1[0]=PKW(P0,8), pw1[1]=PKW(P0,10), pw1); \
    VRD(5); SBAR(); GAPA(C1=__builtin_amdgcn_mfma_f32_32x32x16_bf16(kf[3],qr[1],C1,0,0,0),   P0[14],P0[15],P1[0],P1[1],   pw1[2]=PKW(P0,12),pw1[3]=PKW(P0,14), pw1); \
    VRD(2); SBAR(); GAPA(C0=__builtin_amdgcn_mfma_f32_32x32x16_bf16(kf[4],qr[2],C0,0,0,0),   P1[2],P1[3],P1[4],P1[5],     pw2[0]=PKW(P1,0), pw2[1]=PKW(P1,2), pw2); \
    VRD(6); SBAR(); GAPA(C1=__builtin_amdgcn_mfma_f32_32x32x16_bf16(kf[5],qr[2],C1,0,0,0),   P1[6],P1[7],P1[8],P1[9],     pw2[2]=PKW(P1,4), pw2[3]=PKW(P1,6), pw2); \
    VRD(3); SBAR(); GAPA(C0=__builtin_amdgcn_mfma_f32_32x32x16_bf16(kf[6],qr[3],C0,0,0,0),   P1[10],P1[11],P1[12],P1[13], pw3[0]=PKW(P1,8), pw3[1]=PKW(P1,10), pw3); \
    VRD(7); SBAR(); GAPA(C1=__builtin_amdgcn_mfma_f32_32x32x16_bf16(kf[7],qr[3],C1,0,0,0),   P1[14],P1[15],0.f,0.f,       pw3[2]=PKW(P1,12),pw3[3]=PKW(P1,14), pw3); \
    l_reg+=sacc; \
    if(GK){DMA_K((t)+3,sl_cur);} if(GV){DMA_V((t)+1,sl_next);} \
    if constexpr(!NOMAX) \
    { float a=MX3(C0[0],C0[1],C1[0]),b=MX3(C0[2],C0[3],C1[1]); a=MX3(a,C1[2],C1[3]); \
      _Pragma("unroll") for(int r=4;r<16;r+=4){a=MX3(a,C0[r],C0[r+1]);b=MX3(b,C0[r+2],C0[r+3]);a=MX3(a,C1[r],C1[r+1]);b=MX3(b,C1[r+2],C1[r+3]);} \
      float rm=__builtin_fmaxf(a,b); { auto rr=__builtin_amdgcn_permlane32_swap(__float_as_uint(rm),__float_as_uint(rm),false,false); rm=__builtin_fmaxf(__uint_as_float(rr[0]),__uint_as_float(rr[1])); } \
      resc=false; \
      if(__builtin_expect(__any(rm>(float)THRL),0)){ const float dl=__builtin_fmaxf(rm,0.f); mhat+=dl; \
        _Pragma("unroll") for(int r=0;r<16;++r){C0[r]-=dl;C1[r]-=dl;} \
        _Pragma("unroll") for(int r=0;r<16;++r)negm[r]=-mhat; asm volatile("":"+v"(negm)); \
        const float f=__builtin_amdgcn_exp2f(-dl); l_reg*=f; if(hi==0)wsf[r32]=f; resc=true; } } \
    SBAR(); \
    GAPB(o[0]=__builtin_amdgcn_mfma_f32_32x32x16_bf16(PAF(0),VFR(0),o[0],0,0,0), C0,0); \
    GAPB(o[1]=__builtin_amdgcn_mfma_f32_32x32x16_bf16(PAF(0),VFR(4),o[1],0,0,0), C0,4); \
    KRD(GL,0); GAPB(o[0]=__builtin_amdgcn_mfma_f32_32x32x16_bf16(PAF(1),VFR(1),o[0],0,0,0), C0,8); \
    KRD(GL,1); GAPB(o[1]=__builtin_amdgcn_mfma_f32_32x32x16_bf16(PAF(1),VFR(5),o[1],0,0,0), C0,12); \
    KRD(GL,2); GAPB(o[0]=__builtin_amdgcn_mfma_f32_32x32x16_bf16(PAF(2),VFR(2),o[0],0,0,0), C1,0); \
    KRD(GL,3); GAPB(o[1]=__builtin_amdgcn_mfma_f32_32x32x16_bf16(PAF(2),VFR(6),o[1],0,0,0), C1,4); \
    GAPB(o[0]=__builtin_amdgcn_mfma_f32_32x32x16_bf16(PAF(3),VFR(3),o[0],0,0,0), C1,8); \
    GAPB(o[1]=__builtin_amdgcn_mfma_f32_32x32x16_bf16(PAF(3),VFR(7),o[1],0,0,0), C1,12); \
    }while(0)
  int t=1;
  for(;t+5<NT;t+=2){
    STEP(pB0,pB1,pA0,pA1,t,true,true,true);     WAIT_BAR(2); RESC(); ROT();
    STEP(pA0,pA1,pB0,pB1,t+1,true,true,true);   WAIT_BAR(2); RESC(); ROT();
  }
  #define ENDW(tt) do{ if((tt)+3<NT){WAIT_BAR(2);} else if((tt)+2<NT){WAIT_BAR(1);} else {WAIT_BAR(0);} }while(0)
  for(;t+1<NT;t+=2){
    STEP(pB0,pB1,pA0,pA1,t,(t+3<NT),(t+1<NT),(t+1<NT));       ENDW(t);   RESC(); ROT();
    STEP(pA0,pA1,pB0,pB1,t+1,(t+4<NT),(t+2<NT),(t+2<NT));     ENDW(t+1); RESC(); ROT();
  }
  STEP(pB0,pB1,pA0,pA1,NT-1,false,false,false); RESC();
  { float sacc=pB0[0]+pB0[1]; _Pragma("unroll") for(int r=2;r<16;++r)sacc+=pB0[r]; _Pragma("unroll") for(int r=0;r<16;++r)sacc+=pB1[r]; l_reg+=sacc;
    pw0=(u32x4){PKW(pB0,0),PKW(pB0,2),PKW(pB0,4),PKW(pB0,6)};pw1=(u32x4){PKW(pB0,8),PKW(pB0,10),PKW(pB0,12),PKW(pB0,14)};pw2=(u32x4){PKW(pB1,0),PKW(pB1,2),PKW(pB1,4),PKW(pB1,6)};pw3=(u32x4){PKW(pB1,8),PKW(pB1,10),PKW(pB1,12),PKW(pB1,14)};
    SBAR(); pv(o,vb0+sl_cur,PAF(0),PAF(1),PAF(2),PAF(3)); }
  #undef PKW
  #undef PAF
  #undef VFR
  #undef PIN
  #undef MX3
  #undef GAPA
  #undef GAPB
  #undef EX
  #undef VRD
  #undef KRD
  #undef STEP
  #undef ENDW
  #ifdef NEGM_OP
  #undef NEGM_OP
  #endif
  {auto rr=__builtin_amdgcn_permlane32_swap(__float_as_uint(l_reg),__float_as_uint(l_reg),false,false);l_reg=__uint_as_float(rr[0])+__uint_as_float(rr[1]);}
  if(hi==0)wsf[32+r32]=l_reg;asm volatile("s_waitcnt lgkmcnt(0)":::"memory");
  float rli[16];
  #pragma unroll
  for(int r=0;r<16;++r)rli[r]=__builtin_amdgcn_rcpf(wsf[32+crow(r,hi)]);
  bf16*Ow=Ou+(long)(wid*QBLK)*OP;
  { bf16*stg=(bf16*)(shm+LDS_OST)+wid*2048;
    #pragma unroll
    for(int r=0;r<16;++r){const int orow=crow(r,hi);
      #pragma unroll
      for(int d0=0;d0<2;++d0)stg[orow*64+d0*32+r32]=__float2bfloat16(o[d0][r]*rli[r]);}
    asm volatile("s_waitcnt lgkmcnt(0)":::"memory");
    #pragma unroll
    for(int i=0;i<4;++i){const int row=i*8+(lane>>3),ch=lane&7; const u32x4 v=*(const u32x4*)(stg+row*64+ch*8); ATTN_STORE16(Ow+(long)row*OP+ch*8,v);} }
  asm volatile("s_waitcnt lgkmcnt(0)\n\ts_barrier":::"memory");
  #undef DMA_K
  #undef DMA_V
  #undef CMASK
  #undef START
  #undef RESC
  #undef ROT
}
constexpr int LDS_WS128=LDS_V+NSLOT*2*SLOTB, LDS_OST128=LDS_WS128+NW*64*4, LDS_BYTES128=LDS_OST128+NW*4096;
template<int THRL,bool NOMAX> __device__ __forceinline__ void attn_unit128(const bf16*Qu,int QP,const bf16*__restrict__ Kh,int KP,const bf16*__restrict__ Vh,int VP,bf16*Ou,int OP,int NT,char*shm,const int tid){
  const int lane=tid&63,r32=lane&31,hi=lane>>5; const int wid=__builtin_amdgcn_readfirstlane(tid>>6);
  const bf16*Qw=Qu+(long)(wid*QBLK)*QP;
  const unsigned lds0=(unsigned)(uintptr_t)shm;
  float*wsf=(float*)(shm+LDS_WS128)+wid*64;
  const bf16*ksrc=Kh+(long)lane*KP+wid*8;
  const bf16*vsrc=Vh+(long)(16*(wid&3)+(lane>>2))*VP+(wid>>2)*32+(lane&3)*8;
  const unsigned kdst=lds0+LDS_K+wid*1024, vdst=lds0+LDS_V+wid*1024;
  #define DMA_K(t,slot) glds16(ksrc+(long)(t)*KVBLK*KP,(unsigned)__builtin_amdgcn_readfirstlane(kdst+(slot)))
  #define DMA_V(t,slot) do{ glds16(vsrc+(long)(t)*KVBLK*VP,(unsigned)__builtin_amdgcn_readfirstlane(vdst+2*(slot))); glds16(vsrc+64+(long)(t)*KVBLK*VP,(unsigned)__builtin_amdgcn_readfirstlane(vdst+2*(slot)+8192)); }while(0)
  const int vb0=(int)(lds0+LDS_V)+((lane>>4)&1)*32+(lane&3)*8+(4*hi+((lane&15)>>2))*64;
  const char*Kbase=shm+LDS_K; bf16x8 kf[8];
  const lds_cptr shm3=(lds_cptr)shm; const lds_cptr kp0=shm3+LDS_K+hi*1024+r32*16; const lds_cptr vp0=shm3+LDS_V+((lane>>4)&1)*32+(lane&3)*8+(4*hi+((lane&15)>>2))*64;
  DMA_K(0,0);DMA_V(0,0);DMA_K(1,SLOTB);
  bf16x8 qr[4];
  #pragma unroll
  for(int d0=0;d0<4;++d0)qr[d0]=*reinterpret_cast<const bf16x8*>(&Qw[(long)r32*QP+d0*16+hi*8]);
  float mhat=0.f,l_reg=0.f;f32x16 o[4];o[0]=f32x16{};o[1]=f32x16{};o[2]=f32x16{};o[3]=f32x16{};const f32x16 zero16=f32x16{};
  #define CMASK(P0,P1,t) do{}while(0)
  bool resc=false;
  #define START(P0,P1) do{ resc=false; if constexpr(!NOMAX){ const float rm=rowmax(P0,P1); \
    { const float dl=rm; mhat=fadd_s(mhat,dl); \
      _Pragma("unroll") for(int r=0;r<16;++r){P0[r]=fsub_s(P0[r],dl);P1[r]=fsub_s(P1[r],dl);} } } \
    _Pragma("unroll") for(int r=0;r<16;++r)P0[r]=__builtin_amdgcn_exp2f(P0[r]); }while(0)
  #define RESC() do{ if(resc){ asm volatile("s_waitcnt lgkmcnt(0)":::"memory"); \
      _Pragma("unroll") for(int d_=0;d_<4;++d_) _Pragma("unroll") for(int r=0;r<16;++r)o[d_][r]*=wsf[crow(r,hi)]; } }while(0)
  f32x16 pA0,pA1,pB0,pB1;
  int sl_prev=0,sl_cur=0,sl_next=SLOTB;
  #define ROT() do{sl_prev=sl_cur;sl_cur=sl_next;sl_next=(sl_next==(NSLOT-1)*SLOTB)?0:sl_next+SLOTB;}while(0)
  DMA_K(2,2*SLOTB);
  WAIT_BAR(3);
  qkt(pA0,pA1,Kbase,qr,zero16,r32,hi);asm volatile("s_nop 15\n\ts_nop 7":"+v"(pA0),"+v"(pA1));CMASK(pA0,pA1,0);
  START(pA0,pA1);
  _Pragma("unroll") for(int r=0;r<16;++r)pA1[r]=__builtin_amdgcn_exp2f(pA1[r]);
  WAIT_BAR(0);
  DMA_K(3,0);DMA_V(1,SLOTB);
  ROT();
  kload8(kf,kp0+sl_cur);
  WAIT_BAR(3);
  s16x4 vlo[8],vhi[8]; u32x4 pw0,pw1,pw2,pw3;
  #define PKW(P,B) cvtpk_s(P[B],P[B+1])
  #define PAF(k) __builtin_bit_cast(bf16x8,pw##k)
  #define VFR(i) (bf16x8){vlo[i][0],vlo[i][1],vlo[i][2],vlo[i][3],vhi[i][0],vhi[i][1],vhi[i][2],vhi[i][3]}
  #define PIN(x) asm volatile("":"+v"(x))
  #define MX3(a,b,c) __builtin_fmaxf(__builtin_fmaxf((a),(b)),(c))
  #define GAPA(MF,A0,A1,A2,A3,W0,W1,PW) do{ MF; sacc+=A0; sacc+=A1; sacc+=A2; sacc+=A3; PIN(sacc); W0; W1; PIN(PW); SBAR(); }while(0)
  #define EX(v) __builtin_amdgcn_exp2f(v)
  #define GAPB(MF,X,B) do{ MF; if constexpr(NOMAX){ X[B]=EX(X[B]); X[B+1]=EX(X[B+1]); } else { X[B]=EX(X[B]-mhat); X[B+1]=EX(X[B+1]-mhat); } PIN(X); SBAR(); }while(0)
  #define VRD(i) do{ vlo[i]=vtr(vp_+(((i)>>2)*4096+((i)&3)*1024)); vhi[i]=vtr(vp_+(((i)>>2)*4096+((i)&3)*1024+512)); }while(0)
  #define VRD2(i) do{ vlo[i]=vtr(vp_+((((i)>>2)+2)*4096+((i)&3)*1024)); vhi[i]=vtr(vp_+((((i)>>2)+2)*4096+((i)&3)*1024+512)); SBAR(); }while(0)
  #define KRD(G,j) do{ if(G){ kload2(kf,kp0+sl_next,j); SBAR(); } }while(0)
  #define MF32(a,b,c) __builtin_amdgcn_mfma_f32_32x32x16_bf16(a,b,c,0,0,0)
  #define STEP(C0,C1,P0,P1,t,GK,GV,GL) do{ SBAR(); \
    const lds_cptr vp_=vp0+2*sl_prev; \
    VRD(0); SBAR(); float sacc=(P0[0]+P0[1]); \
    GAPA(C0=MF32(kf[0],qr[0],zero16), P0[2],P0[3],P0[4],P0[5],     pw0[0]=PKW(P0,0), pw0[1]=PKW(P0,2), pw0); \
    VRD(4); SBAR(); GAPA(C1=MF32(kf[1],qr[0],zero16), P0[6],P0[7],P0[8],P0[9],     pw0[2]=PKW(P0,4), pw0[3]=PKW(P0,6), pw0); \
    VRD(1); SBAR(); GAPA(C0=MF32(kf[2],qr[1],C0),   P0[10],P0[11],P0[12],P0[13], pw1[0]=PKW(P0,8), pw1[1]=PKW(P0,10), pw1); \
    VRD(5); SBAR(); GAPA(C1=MF32(kf[3],qr[1],C1),   P0[14],P0[15],P1[0],P1[1],   pw1[2]=PKW(P0,12),pw1[3]=PKW(P0,14), pw1); \
    VRD(2); SBAR(); GAPA(C0=MF32(kf[4],qr[2],C0),   P1[2],P1[3],P1[4],P1[5],     pw2[0]=PKW(P1,0), pw2[1]=PKW(P1,2), pw2); \
    VRD(6); SBAR(); GAPA(C1=MF32(kf[5],qr[2],C1),   P1[6],P1[7],P1[8],P1[9],     pw2[2]=PKW(P1,4), pw2[3]=PKW(P1,6), pw2); \
    VRD(3); SBAR(); GAPA(C0=MF32(kf[6],qr[3],C0),   P1[10],P1[11],P1[12],P1[13], pw3[0]=PKW(P1,8), pw3[1]=PKW(P1,10), pw3); \
    VRD(7); SBAR(); GAPA(C1=MF32(kf[7],qr[3],C1),   P1[14],P1[15],0.f,0.f,       pw3[2]=PKW(P1,12),pw3[3]=PKW(P1,14), pw3); \
    l_reg+=sacc; \
    if(GK){DMA_K((t)+3,sl_cur);} if(GV){DMA_V((t)+1,sl_next);} \
    if constexpr(!NOMAX) \
    { float a=MX3(C0[0],C0[1],C1[0]),b=MX3(C0[2],C0[3],C1[1]); a=MX3(a,C1[2],C1[3]); \
      _Pragma("unroll") for(int r=4;r<16;r+=4){a=MX3(a,C0[r],C0[r+1]);b=MX3(b,C0[r+2],C0[r+3]);a=MX3(a,C1[r],C1[r+1]);b=MX3(b,C1[r+2],C1[r+3]);} \
      float rm=__builtin_fmaxf(a,b); { auto rr=__builtin_amdgcn_permlane32_swap(__float_as_uint(rm),__float_as_uint(rm),false,false); rm=__builtin_fmaxf(__uint_as_float(rr[0]),__uint_as_float(rr[1])); } \
      rm-=mhat; resc=false;                                 \
      if(__builtin_expect(__any(rm>(float)THRL),0)){ const float dl=__builtin_fmaxf(rm,0.f); mhat+=dl; \
        const float f=__builtin_amdgcn_exp2f(-dl); l_reg*=f; if(hi==0)wsf[r32]=f; resc=true; } } \
    SBAR(); \
    GAPB(o[0]=MF32(PAF(0),VFR(0),o[0]), C0,0);  VRD2(0); \
    GAPB(o[1]=MF32(PAF(0),VFR(4),o[1]), C0,2);  VRD2(4); \
    KRD(GL,0); GAPB(o[0]=MF32(PAF(1),VFR(1),o[0]), C0,4);  VRD2(1); \
    KRD(GL,1); GAPB(o[1]=MF32(PAF(1),VFR(5),o[1]), C0,6);  VRD2(5); \
    KRD(GL,2); GAPB(o[0]=MF32(PAF(2),VFR(2),o[0]), C0,8);  VRD2(2); \
    KRD(GL,3); GAPB(o[1]=MF32(PAF(2),VFR(6),o[1]), C0,10); VRD2(6); \
    GAPB(o[0]=MF32(PAF(3),VFR(3),o[0]), C0,12); VRD2(3); \
    GAPB(o[1]=MF32(PAF(3),VFR(7),o[1]), C0,14); VRD2(7); \
    GAPB(o[2]=MF32(PAF(0),VFR(0),o[2]), C1,0); \
    GAPB(o[3]=MF32(PAF(0),VFR(4),o[3]), C1,2); \
    GAPB(o[2]=MF32(PAF(1),VFR(1),o[2]), C1,4); \
    GAPB(o[3]=MF32(PAF(1),VFR(5),o[3]), C1,6); \
    GAPB(o[2]=MF32(PAF(2),VFR(2),o[2]), C1,8); \
    GAPB(o[3]=MF32(PAF(2),VFR(6),o[3]), C1,10); \
    GAPB(o[2]=MF32(PAF(3),VFR(3),o[2]), C1,12); \
    GAPB(o[3]=MF32(PAF(3),VFR(7),o[3]), C1,14); \
    }while(0)
  int t=1;
  for(;t+5<NT;t+=2){
    STEP(pB0,pB1,pA0,pA1,t,true,true,true);     WAIT_BAR(3); RESC(); ROT();
    STEP(pA0,pA1,pB0,pB1,t+1,true,true,true);   WAIT_BAR(3); RESC(); ROT();
  }
  #define ENDW(tt) do{ if((tt)+3<NT){WAIT_BAR(3);} else if((tt)+2<NT){WAIT_BAR(2);} else {WAIT_BAR(0);} }while(0)
  for(;t+1<NT;t+=2){
    STEP(pB0,pB1,pA0,pA1,t,(t+3<NT),(t+1<NT),(t+1<NT));       ENDW(t);   RESC(); ROT();
    STEP(pA0,pA1,pB0,pB1,t+1,(t+4<NT),(t+2<NT),(t+2<NT));     ENDW(t+1); RESC(); ROT();
  }
  STEP(pB0,pB1,pA0,pA1,NT-1,false,false,false); RESC();
  { float sacc=pB0[0]+pB0[1]; _Pragma("unroll") for(int r=2;r<16;++r)sacc+=pB0[r]; _Pragma("unroll") for(int r=0;r<16;++r)sacc+=pB1[r]; l_reg+=sacc;
    pw0=(u32x4){PKW(pB0,0),PKW(pB0,2),PKW(pB0,4),PKW(pB0,6)};pw1=(u32x4){PKW(pB0,8),PKW(pB0,10),PKW(pB0,12),PKW(pB0,14)};pw2=(u32x4){PKW(pB1,0),PKW(pB1,2),PKW(pB1,4),PKW(pB1,6)};pw3=(u32x4){PKW(pB1,8),PKW(pB1,10),PKW(pB1,12),PKW(pB1,14)};
    SBAR(); pv(o,vb0+2*sl_cur,PAF(0),PAF(1),PAF(2),PAF(3)); pv(o+2,vb0+2*sl_cur+8192,PAF(0),PAF(1),PAF(2),PAF(3)); }
  #undef PKW
  #undef PAF
  #undef VFR
  #undef PIN
  #undef MX3
  #undef GAPA
  #undef GAPB
  #undef EX
  #undef VRD
  #undef VRD2
  #undef MF32
  #undef KRD
  #undef STEP
  #undef ENDW
  {auto rr=__builtin_amdgcn_permlane32_swap(__float_as_uint(l_reg),__float_as_uint(l_reg),false,false);l_reg=__uint_as_float(rr[0])+__uint_as_float(rr[1]);}
  if(hi==0)wsf[32+r32]=l_reg;asm volatile("s_waitcnt lgkmcnt(0)":::"memory");
  float rli[16];
  #pragma unroll
  for(int r=0;r<16;++r)rli[r]=__builtin_amdgcn_rcpf(wsf[32+crow(r,hi)]);
  bf16*Ow=Ou+(long)(wid*QBLK)*OP;
  { bf16*stg=(bf16*)(shm+LDS_OST128)+wid*2048;
    #pragma unroll
    for(int hb=0;hb<2;++hb){
      #pragma unroll
      for(int r=0;r<16;++r){const int orow=crow(r,hi);
        #pragma unroll
        for(int d0=0;d0<2;++d0)stg[orow*64+d0*32+r32]=__float2bfloat16(o[2*hb+d0][r]*rli[r]);}
      asm volatile("s_waitcnt lgkmcnt(0)":::"memory");
      #pragma unroll
      for(int i=0;i<4;++i){const int row=i*8+(lane>>3),ch=lane&7; const u32x4 v=*(const u32x4*)(stg+row*64+ch*8); ATTN_STORE16(Ow+(long)row*OP+hb*64+ch*8,v);}
      asm volatile("s_waitcnt lgkmcnt(0)":::"memory"); } }
  asm volatile("s_waitcnt lgkmcnt(0)\n\ts_barrier":::"memory");
  #undef DMA_K
  #undef DMA_V
  #undef CMASK
  #undef START
  #undef RESC
  #undef ROT
}
constexpr int ATTN_LDS_BYTES=LDS_BYTES128;
#undef SBAR
#undef WAIT_BAR
}
typedef const float* const __attribute__((address_space(4)))* kin_ptr;
struct InTab { kin_ptr p; DI const float* operator[](int i) const { return (const float*)(const GAS float*)p[i]; } };
struct Frame {
    LAS unsigned char* lds; volatile LAS unsigned* MISC; gu32* ctl;
    int tid, lane, wave, vcu, G, gw, NGW, bx;
    InTab in; float* out; unsigned char* ws;
};
DI const float* modv_of(const Frame& F, int li) { return (const float*)(F.ws + WS_MODV) + (size_t)li * 9 * 6144; }
DI const float* lat_x(const Frame& F, int li) { return li == 0 ? F.in[I_X] : F.out; }
DI const float* ctx_x(const Frame& F, int li) { return li == 0 ? F.in[I_CTX] : (const float*)(F.ws + WS_XC); }

DI void phase_p0(const Frame& F) {
    LAS float* act = (LAS float*)F.lds;
    LAS float* part = (LAS float*)(F.lds + 36864);
    bool loaded = false;
    for (int u = F.bx; u < NLAYER * 96; u += F.G) {
        const int li = u / 96, n0 = (u % 96) * 64;
        if (!loaded) {
            for (int i = F.tid; i < 9 * 1024; i += 512) { const int m = i >> 10, k = i & 1023; const float c = m < 8 ? F.in[I_C][m * 1024 + k] : F.in[I_CCTX][k]; act[i] = siluf_(c); }
            loaded = true;
        }
        __syncthreads();
        float acc[9];
#pragma unroll
        for (int m = 0; m < 9; ++m) acc[m] = 0.f;
        const float* W = F.in[I_WMOD] + (size_t)li * 1024 * 6144 + n0 + F.lane;
        const int k0 = F.wave * 128;
        for (int k = k0; k < k0 + 128; k += 4) {
            float wv[4];
#pragma unroll
            for (int e = 0; e < 4; ++e) wv[e] = W[(size_t)(k + e) * 6144];
#pragma unroll
            for (int m = 0; m < 9; ++m) { const f32x4 a = *(const LAS f32x4*)(act + m * 1024 + k); acc[m] += a[0] * wv[0] + a[1] * wv[1] + a[2] * wv[2] + a[3] * wv[3]; }
        }
#pragma unroll
        for (int m = 0; m < 9; ++m) part[(F.wave * 9 + m) * 64 + F.lane] = acc[m];
        __syncthreads();
        for (int i = F.tid; i < 9 * 64; i += 512) { const int m = i >> 6, l = i & 63; float s = 0.f;
#pragma unroll
            for (int w = 0; w < 8; ++w) s += part[(w * 9 + m) * 64 + l];
            ((float*)(F.ws + WS_MODV))[((size_t)li * 9 + m) * 6144 + n0 + l] = s + F.in[I_BMOD][li * 6144 + n0 + l]; }
        __syncthreads();
    }
    if (F.bx == F.G - 1) {
        float* rope = (float*)(F.ws + WS_ROPE);
        for (int i = F.tid; i < 128 * 16; i += 512) { const int pos = i >> 4, f = i & 15; const float inv = powf(10000.f, -(float)(2 * f) / 32.f); const float ang = (float)pos * inv; float s, c; sincosf(ang, &s, &c); rope[2 * i] = c; rope[2 * i + 1] = s; }
        if (F.wave < NLAYER) {
            const int li = F.wave; const int l = F.lane;
            const float a = wave_sum(F.in[I_LQ1][li * 64 + l] * F.in[I_LK1][li * 64 + l]), b = wave_sum(F.in[I_LQ2][li * 64 + l] * F.in[I_LK2][li * 64 + l]);
            const float lam_init = 0.8f - 0.6f * expf(-0.3f * (float)li);
            if (l == 0) { float* L = (float*)(F.ws + WS_LAM) + li * 4; L[0] = expf(a) - expf(b) + lam_init; L[1] = 1.f - lam_init; }
            float mq = fabsf(F.in[I_GQN][li * 64 + l]), mk = fabsf(F.in[I_GKN][li * 64 + l]), dq = fabsf(F.in[I_DQN][li * 64 + l]), dk = fabsf(F.in[I_DKN][li * 64 + l]);
#pragma unroll
            for (int o = 1; o < 64; o <<= 1) { mq = fmaxf(mq, __shfl_xor(mq, o)); mk = fmaxf(mk, __shfl_xor(mk, o)); dq = fmaxf(dq, __shfl_xor(dq, o)); dk = fmaxf(dk, __shfl_xor(dk, o)); }
            if (l == 0) { float* L = (float*)(F.ws + WS_LAM) + li * 4; L[2] = 64.f * mq * mk * C2Q; L[3] = 64.f * dq * dk * C2Q; }
        }
    }
    { const f32x4* s = (const f32x4*)F.in[I_CTX]; f32x4* d = (f32x4*)(F.ws + WS_XC); const int n4 = NB * CTXL * DM / 4;
      for (int i = F.bx * 512 + F.tid; i < n4; i += F.G * 512) d[i] = s[i]; }
}

DI void transpose_item(const float* W, int ldw, int k0, int n0, bf16* WT, int ldd, int drow0, LAS float* scr, int lane) {
    float tv[32];
    const float* wp = W + (size_t)(k0 + (lane >> 5)) * ldw + n0 + (lane & 31);
#pragma unroll
    for (int i = 0; i < 32; ++i) tv[i] = wp[(size_t)(2 * i) * ldw];
    __builtin_amdgcn_sched_barrier(0);
#pragma unroll
    for (int i = 0; i < 32; ++i) scr[(2 * i + (lane >> 5)) * 33 + (lane & 31)] = tv[i];
    LDS_WAIT(); asm volatile("" ::: "memory");
    const int c = lane & 7;
#pragma unroll
    for (int j = 0; j < 4; ++j) { const int n = (lane >> 3) + 8 * j; const LAS float* s = scr + (8 * c) * 33 + n;
        v4u o; o.x = pk2(s[0 * 33], s[1 * 33]); o.y = pk2(s[2 * 33], s[3 * 33]); o.z = pk2(s[4 * 33], s[5 * 33]); o.w = pk2(s[6 * 33], s[7 * 33]);
        *(v4u*)(WT + (size_t)(drow0 + n) * ldd + k0 + 8 * c) = o; }
    LDS_WAIT(); asm volatile("" ::: "memory");
}
constexpr int WX_IN = 16 * 136, WX_G = 3 * 16 * 32, WX_B = 3 * 8 * 32, WX_O = 16 * 32, WX_E = 16 * 16 * 32, WX_NITEMS = WX_IN + WX_G + WX_B + WX_O + 3 * WX_E;
DI void wx_item(const Frame& F, int li, int it, LAS float* scr) {
    unsigned char* wm = F.ws + WS_WMIX; unsigned char* we = F.ws + WS_WEXP;
    int r = it;
    if (r < WX_IN) { const int kb = r / 136, nb = r % 136, n0 = nb * 32, pn = n0 >> 8, wi = n0 & 255, wc = wi >> 6, bj = (wi >> 5) & 1;
        transpose_item(F.in[I_WIN] + (size_t)li * 1024 * INCOLS, INCOLS, kb * 64, n0, (bf16*)(wm + WM_WIN), 1024, pn * 256 + bj * 128 + wc * 32, scr, F.lane); return; } r -= WX_IN;
    if (r < WX_G) { const int i = r / 512, q = r % 512, kb = q / 32, nb = q % 32;
        transpose_item(F.in[I_WMG] + ((size_t)li * 3 + i) * 1024 * 1024, 1024, kb * 64, nb * 32, (bf16*)(wm + WM_WG), 1024, i * 1024 + nb * 32, scr, F.lane); return; } r -= WX_G;
    if (r < WX_B) { const int i = r / 256, q = r % 256, kb = q / 32, nb = q % 32;
        transpose_item(F.in[I_WBR] + ((size_t)li * 3 + i) * 512 * 1024, 1024, kb * 64, nb * 32, (bf16*)(wm + WM_WB) + (size_t)i * 1024 * 512, 512, nb * 32, scr, F.lane); return; } r -= WX_B;
    if (r < WX_O) { const int kb = r / 32, nb = r % 32;
        transpose_item(F.in[I_WOUT] + (size_t)li * 1024 * 1024, 1024, kb * 64, nb * 32, (bf16*)(wm + WM_WO), 1024, nb * 32, scr, F.lane); return; } r -= WX_O;
    { const int which = r / WX_E, q = r % WX_E, e = q / 512, q2 = q % 512, kb = q2 / 32, nb = q2 % 32, n0 = nb * 32;
      const size_t eo = ((size_t)li * NEXP + e) * 1024 * 1024;
      if (which == 0)      transpose_item(F.in[I_WEG] + eo, 1024, kb * 64, n0, (bf16*)(we + WE_GU) + (size_t)e * 2048 * 1024, 1024, (n0 >> 7) * 256 + (n0 & 127), scr, F.lane);
      else if (which == 1) transpose_item(F.in[I_WEU] + eo, 1024, kb * 64, n0, (bf16*)(we + WE_GU) + (size_t)e * 2048 * 1024, 1024, (n0 >> 7) * 256 + 128 + (n0 & 127), scr, F.lane);
      else                 transpose_item(F.in[I_WED] + eo, 1024, kb * 64, n0, (bf16*)(we + WE_D) + (size_t)e * 1024 * 1024, 1024, n0, scr, F.lane); }
}
constexpr int WX_EARLY = WX_IN + WX_G + WX_B + WX_O;
DI void wx_item_e(const Frame& F, int li, int r, LAS float* scr) {
    unsigned char* we = F.ws + WS_WEXP;
    const int which = r / WX_E, q = r % WX_E, e = q / 512, q2 = q % 512, kb = q2 / 32, nb = q2 % 32, n0 = nb * 32;
    const size_t eo = ((size_t)li * NEXP + e) * 1024 * 1024;
    const float* src = (which == 0 ? F.in[I_WEG] : which == 1 ? F.in[I_WEU] : F.in[I_WED]) + eo;
    bf16* dst = which == 2 ? (bf16*)(we + WE_D) + (size_t)e * 1024 * 1024 : (bf16*)(we + WE_GU) + (size_t)e * 2048 * 1024;
    const int drow0 = which == 2 ? n0 : (n0 >> 7) * 256 + (which == 1 ? 128 : 0) + (n0 & 127);
    transpose_item(src, 1024, kb * 64, n0, dst, 1024, drow0, scr, F.lane);
}
DI void phase_wx(const Frame& F, int li) {
    LAS float* scr = (LAS float*)(F.lds + F.wave * 16384);
    for (int it = F.gw; it < WX_EARLY; it += F.NGW) wx_item(F, li, it, scr);
}

template <int WHICH> DI void phase_norm(const Frame& F, int li) {
    const float* nw = F.in[WHICH == 0 ? I_N1W : I_N2W] + li * 1024; const float* mv = modv_of(F, li);
    const float* xl = lat_x(F, li); const float* xc = ctx_x(F, li);
    const bf16* YO = (const bf16*)(F.ws + WS_G);
    bf16* H = (bf16*)(F.ws + WS_H);
    f32x4 nwv[4];
#pragma unroll
    for (int j = 0; j < 4; ++j) nwv[j] = *(const f32x4*)(nw + 4 * F.lane + 256 * j);
    const float* g1b = mv + 2048 + 4 * F.lane;
#define NORM_ROWPTR(row_, b_, t_, lat_, xr_) const int b_ = (row_) / TPB, t_ = (row_) - b_ * TPB; const bool lat_ = t_ < SEQ; \
        const float* xr_ = (lat_ ? xl + ((size_t)b_ * SEQ + t_) * DM : xc + ((size_t)b_ * CTXL + (t_ - SEQ)) * DM) + 4 * F.lane;
    f32x4 s1v[4], s0v[4], g1v[4]; int mi_prev = -1;
    f32x4 vn[4]; v2u yn[4];
    if (F.gw < MROWS) { NORM_ROWPTR(F.gw, b_, t_, lat_, xr_);
#pragma unroll
        for (int j = 0; j < 4; ++j) { vn[j] = *(const f32x4*)(xr_ + 256 * j); if (WHICH == 1) yn[j] = *(const v2u*)(YO + (size_t)F.gw * DM + 4 * F.lane + 256 * j); } }
    for (int row = F.gw; row < MROWS; row += F.NGW) {
        const int b = row / TPB, t = row - b * TPB; const bool lat = t < SEQ; const int mi = lat ? b : 8;
        const float* sh = mv + mi * 6144 + (WHICH == 0 ? 0 : 3072); const float* sc = sh + 1024;
        f32x4 v[4]; v2u y[4];
#pragma unroll
        for (int j = 0; j < 4; ++j) { v[j] = vn[j]; if (WHICH == 1) y[j] = yn[j]; }
        { const int nrow = row + F.NGW;
          if (nrow < MROWS) { NORM_ROWPTR(nrow, b_, t_, lat_, xr_);
#pragma unroll
              for (int j = 0; j < 4; ++j) { vn[j] = *(const f32x4*)(xr_ + 256 * j); if (WHICH == 1) yn[j] = *(const v2u*)(YO + (size_t)nrow * DM + 4 * F.lane + 256 * j); } } }
        if (mi != mi_prev) { mi_prev = mi;
#pragma unroll
            for (int j = 0; j < 4; ++j) { s1v[j] = *(const f32x4*)(sc + 4 * F.lane + 256 * j); s0v[j] = *(const f32x4*)(sh + 4 * F.lane + 256 * j); if (WHICH == 1) g1v[j] = *(const f32x4*)(g1b + mi * 6144 + 256 * j); } }
        float ss = 0.f;
        if (WHICH == 1) {
            float* xo = (lat ? F.out + ((size_t)b * SEQ + t) * DM : (float*)(F.ws + WS_XC) + ((size_t)b * CTXL + (t - SEQ)) * DM) + 4 * F.lane;
#pragma unroll
            for (int j = 0; j < 4; ++j) { const f32x4 g1 = g1v[j];
                v[j][0] += g1[0] * bflo(y[j].x); v[j][1] += g1[1] * bfhi(y[j].x); v[j][2] += g1[2] * bflo(y[j].y); v[j][3] += g1[3] * bfhi(y[j].y);
                *(f32x4*)(xo + 256 * j) = v[j]; }
        }
#pragma unroll
        for (int j = 0; j < 4; ++j) ss += (v[j][0] * v[j][0] + v[j][1] * v[j][1]) + (v[j][2] * v[j][2] + v[j][3] * v[j][3]);
        const float rstd = rsqrtf(wave_sum(ss) * (1.f / DM) + EPSN);
#pragma unroll
        for (int j = 0; j < 4; ++j) {
            const f32x4 s1 = s1v[j] + 1.f, s0 = s0v[j];
            v[j] = (v[j] * rstd * nwv[j]) * s1 + s0;
            v2u o; o.x = pk2(v[j][0], v[j][1]); o.y = pk2(v[j][2], v[j][3]);
            *(v2u*)(H + (size_t)row * DM + 4 * F.lane + 256 * j) = o;
        }
    }
#undef NORM_ROWPTR
}

template <int WHICH> DI void phase_side(const Frame& F, int li, LAS unsigned char* lds_w) {
    LAS bf16* wh = (LAS bf16*)lds_w; LAS bf16* wlo = wh + 16 * 1032;
    { const float* W = WHICH == 0 ? F.in[I_WIN] + (size_t)li * 1024 * INCOLS + NPROJ : F.in[I_WRT] + (size_t)li * 1024 * 16; const int ldw = WHICH == 0 ? INCOLS : 16;
      for (int i = F.tid; i < 16384; i += 512) { const int k = i >> 4, j = i & 15; const float w = W[(size_t)k * ldw + j]; const unsigned hi = f2bf(w); const float rem = w - bf2f((unsigned short)hi);
          wh[j * 1032 + k] = (bf16)hi; wlo[j * 1032 + k] = (bf16)f2bf(rem); } }
    __syncthreads();
    const bf16* H = (const bf16*)(F.ws + WS_H);
    const int r = F.lane & 15, q = F.lane >> 4, e = r;
    const float dtb = (WHICH == 0 && e >= 8) ? F.in[I_DTB][li * 8 + (e - 8)] : 0.f, nal = (WHICH == 0 && e >= 8) ? -__expf(F.in[I_ALOG][li * 8 + (e - 8)]) : 0.f;
    const int nfull = (MROWS / 16) / F.NGW * F.NGW, ntail = MROWS - nfull * 16;
#define SIDE_HP(u_) (H + (size_t)((u_) < nfull ? (u_) * 16 + r : nfull * 16 + ((u_) - nfull)) * DM + 8 * q)
    bf16x8 fa[2][16];
    if (F.gw < nfull + ntail) { const bf16* hp0 = SIDE_HP(F.gw);
#pragma unroll
        for (int s2 = 0; s2 < 16; ++s2) fa[0][s2] = *(const bf16x8*)(hp0 + 32 * s2); }
    for (int u = F.gw; u < nfull + ntail; u += F.NGW) {
        const bool full = u < nfull; const int row0 = full ? u * 16 : nfull * 16 + (u - nfull);
        const bf16* hp = SIDE_HP(u);
        f32x4 acc = {0.f, 0.f, 0.f, 0.f};
#pragma unroll
        for (int hb = 0; hb < 2; ++hb) {
            if (hb == 0) {
#pragma unroll
                for (int s2 = 0; s2 < 16; ++s2) fa[1][s2] = *(const bf16x8*)(hp + 32 * (16 + s2));
            } else if (u + F.NGW < nfull + ntail) { const bf16* hpn = SIDE_HP(u + F.NGW);
#pragma unroll
                for (int s2 = 0; s2 < 16; ++s2) fa[0][s2] = *(const bf16x8*)(hpn + 32 * s2);
            }
            __builtin_amdgcn_sched_barrier(0);
#pragma unroll
            for (int s2 = 0; s2 < 16; ++s2) { const int sk = 16 * hb + s2;
                const bf16x8 bh = *(const LAS bf16x8*)(wh + r * 1032 + 32 * sk + 8 * q), bl = *(const LAS bf16x8*)(wlo + r * 1032 + 32 * sk + 8 * q);
                acc = MFMA16(fa[hb][s2], bh, acc); acc = MFMA16(fa[hb][s2], bl, acc); }
            __builtin_amdgcn_sched_barrier(0);
        }
#pragma unroll
        for (int jj = 0; jj < 4; ++jj) {
            const bool wr = full || (q == 0 && jj == 0); const int row = full ? row0 + 4 * q + jj : row0; const float val = acc[jj];
            if (WHICH == 0) { float o;
                if (e < 8) o = sigmoidf_(val);
                else { const float xx = val + dtb; const float ex = __expf(xx); const float sp = xx > 15.f ? xx : (xx < -15.f ? ex : __logf(1.f + ex)); o = nal * sp; }
                if (wr) ((float*)(F.ws + WS_GDNG))[(size_t)row * 16 + e] = o;
            } else {
                float m = val; m = fmaxf(m, __shfl_xor(m, 1)); m = fmaxf(m, __shfl_xor(m, 2)); m = fmaxf(m, __shfl_xor(m, 4)); m = fmaxf(m, __shfl_xor(m, 8));
                const float ex = __expf(val - m); const float p = ex / sum16(ex);
                const int b = row / TPB, t = row - b * TPB; float* A = (float*)(F.ws + WS_AFF);
                if (wr) { if (t < SEQ) A[((size_t)b * 16 + e) * SEQ + t] = p; else A[(size_t)NB * 16 * SEQ + ((size_t)b * 16 + e) * CTXL + (t - SEQ)] = p; }
            }
        }
    }
#undef SIDE_HP
}

DI void phase_cv(const Frame& F, int li) {
    const bf16* P = (const bf16*)(F.ws + WS_CPRE); bf16* O = (bf16*)(F.ws + WS_POST);
    const float* cw = F.in[I_CONVW] + (size_t)li * 3 * 1536;
    float w[3][3][8];
#pragma unroll
    for (int tp = 0; tp < 3; ++tp)
#pragma unroll
        for (int g = 0; g < 3; ++g) { const f32x4 a = *(const f32x4*)(cw + tp * 1536 + g * 512 + 8 * F.lane), b = *(const f32x4*)(cw + tp * 1536 + g * 512 + 8 * F.lane + 4);
#pragma unroll
            for (int e = 0; e < 4; ++e) { w[tp][g][e] = a[e]; w[tp][g][4 + e] = b[e]; } }
#define CV_LOAD(dst, row_) do { const int t_ = (row_) % TPB; const bool hp_ = (t_ != 0) && (t_ != SEQ), hn_ = (t_ != SEQ - 1) && (t_ != TPB - 1); \
        _Pragma("unroll") for (int g = 0; g < 3; ++g) _Pragma("unroll") for (int tp = 0; tp < 3; ++tp) { const bool ok = tp == 1 || (tp == 0 ? hp_ : hn_); dst[g][tp] = (v4u){0u, 0u, 0u, 0u}; \
            if (ok) dst[g][tp] = *(const v4u*)(P + (size_t)((row_) + tp - 1) * 1536 + g * 512 + 8 * F.lane); } } while (0)
    v4u xnx[3][3];
    if (F.gw < MROWS) CV_LOAD(xnx, F.gw);
    for (int row = F.gw; row < MROWS; row += F.NGW) {
        v4u xin[3][3];
#pragma unroll
        for (int g = 0; g < 3; ++g)
#pragma unroll
            for (int tp = 0; tp < 3; ++tp) xin[g][tp] = xnx[g][tp];
        if (row + F.NGW < MROWS) CV_LOAD(xnx, row + F.NGW);
#pragma unroll
        for (int g = 0; g < 3; ++g) {
            float a[8];
#pragma unroll
            for (int e = 0; e < 8; ++e) a[e] = 0.f;
#pragma unroll
            for (int tp = 0; tp < 3; ++tp) { const v4u x = xin[g][tp];
                a[0] += w[tp][g][0] * bflo(x.x); a[1] += w[tp][g][1] * bfhi(x.x); a[2] += w[tp][g][2] * bflo(x.y); a[3] += w[tp][g][3] * bfhi(x.y);
                a[4] += w[tp][g][4] * bflo(x.z); a[5] += w[tp][g][5] * bfhi(x.z); a[6] += w[tp][g][6] * bflo(x.w); a[7] += w[tp][g][7] * bfhi(x.w);
            }
            float ss = 0.f;
#pragma unroll
            for (int e = 0; e < 8; ++e) { a[e] = siluf_(a[e]); ss += a[e] * a[e]; }
            if (g < 2) { ss = sum16(ss); const float r = rsqrtf(ss + EPSN) * (g == 0 ? 0.08838834764831845f : 1.f);
#pragma unroll
                for (int e = 0; e < 8; ++e) a[e] *= r; }
            v4u o; o.x = pk2(a[0], a[1]); o.y = pk2(a[2], a[3]); o.z = pk2(a[4], a[5]); o.w = pk2(a[6], a[7]);
            *(v4u*)(O + (size_t)row * 1536 + g * 512 + 8 * F.lane) = o;
        }
    }
#undef CV_LOAD
}

DI void phase_gf(const Frame& F, int li) {
    const bf16* O0 = (const bf16*)(F.ws + WS_CPRE); const bf16* O1 = O0 + (size_t)MROWS * 512; const bf16* Z = (const bf16*)(F.ws + WS_Z); bf16* Y = (bf16*)(F.ws + WS_YG);
    const float* gw = F.in[I_GNW] + li * 128 + 8 * (F.lane & 15);
    const f32x4 w0 = *(const f32x4*)gw, w1 = *(const f32x4*)(gw + 4);
    v4u na = {0u, 0u, 0u, 0u}, nb = na, nz = na;
    if (F.gw < MROWS) { const size_t o = (size_t)F.gw * 512 + 8 * F.lane; na = *(const v4u*)(O0 + o); nb = *(const v4u*)(O1 + o); nz = *(const v4u*)(Z + o); }
    for (int row = F.gw; row < MROWS; row += F.NGW) {
        const size_t o = (size_t)row * 512 + 8 * F.lane;
        const v4u a = na, b = nb, z = nz;
        if (row + F.NGW < MROWS) { const size_t o2 = (size_t)(row + F.NGW) * 512 + 8 * F.lane; na = *(const v4u*)(O0 + o2); nb = *(const v4u*)(O1 + o2); nz = *(const v4u*)(Z + o2); }
        float v[8] = {bflo(a.x) + bflo(b.x), bfhi(a.x) + bfhi(b.x), bflo(a.y) + bflo(b.y), bfhi(a.y) + bfhi(b.y), bflo(a.z) + bflo(b.z), bfhi(a.z) + bfhi(b.z), bflo(a.w) + bflo(b.w), bfhi(a.w) + bfhi(b.w)};
        const float zz[8] = {bflo(z.x), bfhi(z.x), bflo(z.y), bfhi(z.y), bflo(z.z), bfhi(z.z), bflo(z.w), bfhi(z.w)};
        float ss = 0.f;
#pragma unroll
        for (int e = 0; e < 8; ++e) ss += v[e] * v[e];
        const float r = rsqrtf(sum16(ss) * (1.f / 128.f) + EPSN);
#pragma unroll
        for (int e = 0; e < 8; ++e) v[e] = v[e] * r * (e < 4 ? w0[e] : w1[e - 4]) * siluf_(zz[e]);
        v4u ov; ov.x = pk2(v[0], v[1]); ov.y = pk2(v[2], v[3]); ov.z = pk2(v[4], v[5]); ov.w = pk2(v[6], v[7]);
        *(v4u*)(Y + o) = ov;
    }
}

DI void phase_bf(const Frame& F, int li) {
    const bf16* OB = (const bf16*)(F.ws + WS_OB); bf16* Y = (bf16*)(F.ws + WS_YB);
    const float lam = ((const float*)(F.ws + WS_LAM))[li * 4], oml = ((const float*)(F.ws + WS_LAM))[li * 4 + 1];
    const float* sw = F.in[I_SUBLN] + li * 128 + 8 * (F.lane & 15);
    const f32x4 w0 = *(const f32x4*)sw, w1 = *(const f32x4*)(sw + 4);
    const int h = F.lane >> 4, e0 = (F.lane & 15) * 8;
    v4u na = {0u, 0u, 0u, 0u}, nb = na;
    if (F.gw < MROWS) { const bf16* p = OB + (size_t)F.gw * 1024 + h * 256 + e0; na = *(const v4u*)p; nb = *(const v4u*)(p + 128); }
    for (int row = F.gw; row < MROWS; row += F.NGW) {
        const v4u a = na, b = nb;
        if (row + F.NGW < MROWS) { const bf16* p = OB + (size_t)(row + F.NGW) * 1024 + h * 256 + e0; na = *(const v4u*)p; nb = *(const v4u*)(p + 128); }
        float v[8] = {bflo(a.x) - lam * bflo(b.x), bfhi(a.x) - lam * bfhi(b.x), bflo(a.y) - lam * bflo(b.y), bfhi(a.y) - lam * bfhi(b.y),
                      bflo(a.z) - lam * bflo(b.z), bfhi(a.z) - lam * bfhi(b.z), bflo(a.w) - lam * bflo(b.w), bfhi(a.w) - lam * bfhi(b.w)};
        float ss = 0.f;
#pragma unroll
        for (int e = 0; e < 8; ++e) ss += v[e] * v[e];
        const float r = rsqrtf(sum16(ss) * (1.f / 128.f) + EPSN) * oml;
#pragma unroll
        for (int e = 0; e < 8; ++e) v[e] = v[e] * r * (e < 4 ? w0[e] : w1[e - 4]);
        v4u ov; ov.x = pk2(v[0], v[1]); ov.y = pk2(v[2], v[3]); ov.z = pk2(v[4], v[5]); ov.w = pk2(v[6], v[7]);
        *(v4u*)(Y + (size_t)row * 512 + 8 * F.lane) = ov;
    }
}

DI void phase_ga(const Frame& F, int nslot) {
    const int* idx = (const int*)(F.ws + WS_IDX); const bf16* H = (const bf16*)(F.ws + WS_H); bf16* X = (bf16*)(F.ws + WS_XIN);
    for (int r0 = F.gw; r0 < nslot; r0 += 4 * F.NGW) {
        v4u a[4], b[4]; int src[4];
#pragma unroll
        for (int u = 0; u < 4; ++u) { const int r = r0 + u * F.NGW; src[u] = r < nslot ? __builtin_amdgcn_readfirstlane(idx[r]) : 0; }
#pragma unroll
        for (int u = 0; u < 4; ++u) { a[u] = *(const v4u*)(H + (size_t)src[u] * DM + 8 * F.lane); b[u] = *(const v4u*)(H + (size_t)src[u] * DM + 512 + 8 * F.lane); }
#pragma unroll
        for (int u = 0; u < 4; ++u) { const int r = r0 + u * F.NGW; if (r < nslot) { *(v4u*)(X + (size_t)r * DM + 8 * F.lane) = a[u]; *(v4u*)(X + (size_t)r * DM + 512 + 8 * F.lane) = b[u]; } }
    }
}

DI void phase_cb(const Frame& F, int li) {
    const int* inv = (const int*)(F.ws + WS_INV); const bf16* Y = (const bf16*)(F.ws + WS_XIN);
    const bool last = li == NLAYER - 1;
#define CB_ROW(row_, b_, t_, lat_, xr_) const int b_ = (row_) / TPB, t_ = (row_) - b_ * TPB; const bool lat_ = t_ < SEQ; \
        float* xr_ = (lat_ ? F.out + ((size_t)b_ * SEQ + t_) * DM : (float*)(F.ws + WS_XC) + ((size_t)b_ * CTXL + (t_ - SEQ)) * DM) + 4 * F.lane;
    const float* nw = F.in[I_N1W] + (last ? 0 : (li + 1) * 1024); const float* mv = modv_of(F, last ? li : li + 1);
    bf16* H = (bf16*)(F.ws + WS_H);
    f32x4 nwv[4], s1v[4], s0v[4]; int mi_prev = -1;
    if (!last) {
#pragma unroll
        for (int j = 0; j < 4; ++j) nwv[j] = *(const f32x4*)(nw + 4 * F.lane + 256 * j); }
    f32x4 vn[4]; int invn = -1;
    if (F.gw < MROWS) { CB_ROW(F.gw, b_, t_, lat_, xr_);
#pragma unroll
        for (int j = 0; j < 4; ++j) vn[j] = *(const f32x4*)(xr_ + 256 * j);
        if (F.lane < NEXP) invn = inv[((size_t)b_ * NEXP + F.lane) * TPB + t_]; }
    for (int row = F.gw; row < MROWS; row += F.NGW) {
        CB_ROW(row, b, t, lat, xr);
        f32x4 v[4]; int myinv = invn;
#pragma unroll
        for (int j = 0; j < 4; ++j) v[j] = vn[j];
        { const int nrow = row + F.NGW; invn = -1;
          if (nrow < MROWS) { CB_ROW(nrow, b_, t_, lat_, xr_);
#pragma unroll
              for (int j = 0; j < 4; ++j) vn[j] = *(const f32x4*)(xr_ + 256 * j);
              if (F.lane < NEXP) invn = inv[((size_t)b_ * NEXP + F.lane) * TPB + t_]; } }
        if (!lat && last) continue;
        if (!last) { const int mi = lat ? b : 8;
            if (mi != mi_prev) { mi_prev = mi; const float* sh = mv + mi * 6144; const float* sc = sh + 1024;
#pragma unroll
                for (int j = 0; j < 4; ++j) { s1v[j] = *(const f32x4*)(sc + 4 * F.lane + 256 * j); s0v[j] = *(const f32x4*)(sh + 4 * F.lane + 256 * j); } } }
        unsigned long long m = __ballot(myinv >= 0);
        while (m) {
            const int e0 = __ffsll((long long)m) - 1; m &= m - 1;
            const int s0 = __builtin_amdgcn_readlane(myinv, e0);
            int s1 = -1; if (m) { const int e1 = __ffsll((long long)m) - 1; m &= m - 1; s1 = __builtin_amdgcn_readlane(myinv, e1); }
            v2u y0[4], y1[4];
#pragma unroll
            for (int j = 0; j < 4; ++j) y0[j] = *(const v2u*)(Y + (size_t)s0 * DM + 4 * F.lane + 256 * j);
            if (s1 >= 0) {
#pragma unroll
                for (int j = 0; j < 4; ++j) y1[j] = *(const v2u*)(Y + (size_t)s1 * DM + 4 * F.lane + 256 * j);
            } else {
#pragma unroll
                for (int j = 0; j < 4; ++j) y1[j] = (v2u){0u, 0u};
            }
#pragma unroll
            for (int j = 0; j < 4; ++j) { v[j][0] += bflo(y0[j].x); v[j][1] += bfhi(y0[j].x); v[j][2] += bflo(y0[j].y); v[j][3] += bfhi(y0[j].y); }
#pragma unroll
            for (int j = 0; j < 4; ++j) { v[j][0] += bflo(y1[j].x); v[j][1] += bfhi(y1[j].x); v[j][2] += bflo(y1[j].y); v[j][3] += bfhi(y1[j].y); }
        }
#pragma unroll
        for (int j = 0; j < 4; ++j) *(f32x4*)(xr + 256 * j) = v[j];
        if (!last) {
            float ss = 0.f;
#pragma unroll
            for (int j = 0; j < 4; ++j) ss += (v[j][0] * v[j][0] + v[j][1] * v[j][1]) + (v[j][2] * v[j][2] + v[j][3] * v[j][3]);
            const float rstd = rsqrtf(wave_sum(ss) * (1.f / DM) + EPSN);
#pragma unroll
            for (int j = 0; j < 4; ++j) {
                const f32x4 s1 = s1v[j] + 1.f, s0 = s0v[j];
                const f32x4 hv = (v[j] * rstd * nwv[j]) * s1 + s0;
                v2u o; o.x = pk2(hv[0], hv[1]); o.y = pk2(hv[2], hv[3]);
                *(v2u*)(H + (size_t)row * DM + 4 * F.lane + 256 * j) = o;
            }
        }
    }
#undef CB_ROW
}
typedef float f32x16 __attribute__((ext_vector_type(16)));
DI int crow32(int r, int hi) { return (r & 3) + 8 * (r >> 2) + 4 * hi; }

DI void phase_cl(const Frame& F) {
    LAS float* Am = (LAS float*)(F.lds + F.wave * 16384);
    LAS float* gcv = (LAS float*)(F.lds + LDS_XTRA + F.wave * 512);
    LAS float* btv = gcv + 64;
    const bf16* P = (const bf16*)(F.ws + WS_POST); const float* GG = (const float*)(F.ws + WS_GDNG);
    const int L = F.lane, r = L & 31, hh = L >> 5;
    for (int unit = F.gw; unit < NB * NCHUNK * 8; unit += F.NGW) {
        const int dir = unit & 1, h = (unit >> 1) & 3, bc = unit >> 3; const size_t row0 = (size_t)bc * 64;
        unsigned char* tq = F.ws + WS_TQ + (size_t)unit * 16384; float* gcb = (float*)(F.ws + WS_GCB) + (size_t)unit * 128;
        const int io = dir ? 63 - L : L;
        const float g = GG[(row0 + io) * 16 + 8 + dir * 4 + h], beta = GG[(row0 + io) * 16 + dir * 4 + h];
        float gc = g;
#pragma unroll
        for (int o = 1; o < 64; o <<= 1) { const float t = __shfl_up(gc, o); if (L >= o) gc += t; }
        gcv[L] = gc; btv[L] = beta; gcb[io] = gc; gcb[64 + io] = beta;
        bf16x8 kf[2][8], qf[2][8];
#pragma unroll
        for (int rb = 0; rb < 2; ++rb) { const int ir = 32 * rb + r, orr = dir ? 63 - ir : ir; const bf16* pr = P + (row0 + orr) * 1536 + h * 128 + 8 * hh;
#pragma unroll
            for (int s = 0; s < 8; ++s) { kf[rb][s] = *(const bf16x8*)(pr + 512 + 16 * s); qf[rb][s] = *(const bf16x8*)(pr + 16 * s); } }
        LDS_WAIT();
        LAS float* Amb = Am + hh * 256 + r; const LAS float* gch = gcv + 4 * hh; const LAS float* bth = btv + 4 * hh; const LAS float* gcr = gcv + r;
#pragma unroll
        for (int tt = 0; tt < 3; ++tt) { const int ta = tt == 1 ? 0 : 1, tb = tt == 2 ? 1 : 0;
            f32x16 x = {};
#pragma unroll
            for (int s = 0; s < 8; ++s) x = MFMA32(kf[ta][s], kf[tb][s], x);
            const float gcj = gcr[32 * tb];
#pragma unroll
            for (int q = 0; q < 16; ++q) { const int ci = 32 * ta + (q & 3) + 8 * (q >> 2); Amb[ci * 64 + 32 * tb] = bth[ci] * x[q] * __expf(fminf(gch[ci] - gcj, 0.f)); }
            asm volatile("" ::: "memory"); }
        const int sg = dir ? -1 : 1;
        bf16* qkb = (bf16*)(tq + 8192) + (dir ? (63 - 4 * hh) * 64 + (63 - r) : 4 * hh * 64 + r);
#pragma unroll
        for (int tt = 0; tt < 4; ++tt) { const int ta = tt >> 1, tb = tt & 1;
            f32x16 x = {};
            if (!(ta == 0 && tb == 1)) {
#pragma unroll
                for (int s = 0; s < 8; ++s) x = MFMA32(qf[ta][s], kf[tb][s], x);
            }
            const float gcj = gcr[32 * tb]; const int jj = 32 * tb + r;
#pragma unroll
            for (int q = 0; q < 16; ++q) { const int ci = 32 * ta + (q & 3) + 8 * (q >> 2);
                const float val = jj <= ci + 4 * hh ? x[q] * __expf(gch[ci] - gcj) : 0.f; qkb[sg * (ci * 64 + 32 * tb)] = (bf16)f2bf(val); }
            asm volatile("" ::: "memory"); }
        LDS_WAIT(); asm volatile("" ::: "memory");
        float T[64];
#pragma unroll
        for (int i = 0; i < 64; ++i) {
            f32x4 rb[16];
#pragma unroll
            for (int j4 = 0; j4 < (i + 3) / 4; ++j4) rb[j4] = *(const LAS f32x4*)(Am + i * 64 + 4 * j4);
            asm volatile("s_waitcnt lgkmcnt(0)" ::: "memory");
            float a4[4] = {(i == L) ? 1.f : 0.f, 0.f, 0.f, 0.f};
#pragma unroll
            for (int j4 = 0; j4 < (i + 3) / 4; ++j4) {
#pragma unroll
                for (int e = 0; e < 4; ++e) if (4 * j4 + e < i) a4[e] -= rb[j4][e] * T[4 * j4 + e]; }
            T[i] = (a4[0] + a4[1]) + (a4[2] + a4[3]);
        }
        bf16* tpb = (bf16*)tq + (dir ? 63 * 64 + 63 - L : L);
#pragma unroll
        for (int i = 0; i < 64; ++i) tpb[sg * (i * 64)] = (bf16)f2bf(T[i]);
        LDS_WAIT(); asm volatile("" ::: "memory");
    }
}

constexpr int SC_KR = 0, SC_KT = 17408, SC_QR = 35840, SC_VR = 53248, SC_TR = 58368, SC_QK = 67584, SC_VEC = 76800, SC_ST = 77824, SC_RT = 86528, SC_VN = 91136, SC_VS = 95744, SC_END = 100352;
DI v2u pack4(float a, float b, float c, float d) { v2u w; w.x = pk2(a, b); w.y = pk2(c, d); return w; }
DI void phase_sc(const Frame& F) {
    LAS unsigned char* S = F.lds;
    const bf16* P = (const bf16*)(F.ws + WS_POST); bf16* OD = (bf16*)(F.ws + WS_CPRE);
    const int tid = F.tid, w = F.wave, l15 = F.lane & 15, quad = F.lane >> 4;
    for (int unit = F.vcu; unit < 256; unit += F.G) {
        const int sl = unit & 3, dir = (unit >> 2) & 1, h = (unit >> 3) & 3, b = unit >> 5;
        __syncthreads();
        for (int i = tid; i < 8704 / 4; i += 512) ((LAS unsigned*)(S + SC_ST))[i] = 0u;
        f32x4 Sacc[2] = {{0.f, 0.f, 0.f, 0.f}, {0.f, 0.f, 0.f, 0.f}};
        v4u rk[2][2], rq[2][2], rv[2], rt[2], rqk[2], rvec[2];
        const int last_i = dir ? 0 : 63;
#define SC_CHUNK(n) ((n) < 4 ? (dir ? 131 - (n) : 128 + (n)) : (dir ? 131 - (n) : (n) - 4))
#define SC_LOAD(n, Q) do { const int ch_ = SC_CHUNK(n); const size_t r0_ = ((size_t)b * NCHUNK + ch_) * 64; const size_t u_ = ((((size_t)b * NCHUNK + ch_) * 4 + h) * 2 + dir); \
        _Pragma("unroll") for (int i_ = 0; i_ < 2; ++i_) { const int v_ = tid + 512 * i_, rr_ = v_ >> 4, c_ = v_ & 15; const bf16* p_ = P + (r0_ + rr_) * 1536 + h * 128 + c_ * 8; rk[Q][i_] = *(const v4u*)(p_ + 512); rq[Q][i_] = *(const v4u*)p_; } \
        if (tid < 256) rv[Q] = *(const v4u*)(P + (r0_ + (tid >> 2)) * 1536 + 1024 + h * 128 + sl * 32 + (tid & 3) * 8); \
        rt[Q] = *(const v4u*)(F.ws + WS_TQ + u_ * 16384 + (size_t)tid * 16); rqk[Q] = *(const v4u*)(F.ws + WS_TQ + u_ * 16384 + 8192 + (size_t)tid * 16); \
        if (tid < 32) rvec[Q] = *(const v4u*)((const float*)(F.ws + WS_GCB) + u_ * 128 + tid * 4); } while (0)
#define SC_WRITE(Q) do { \
        _Pragma("unroll") for (int i_ = 0; i_ < 2; ++i_) { const int v_ = tid + 512 * i_, rr_ = v_ >> 4, c_ = v_ & 15; \
            *(LAS v4u*)(S + SC_KR + rr_ * 272 + c_ * 16) = rk[Q][i_]; *(LAS v4u*)(S + SC_QR + rr_ * 272 + c_ * 16) = rq[Q][i_]; } \
        if (tid < 256) *(LAS v4u*)(S + SC_VR + (tid >> 2) * 80 + (tid & 3) * 16) = rv[Q]; \
        *(LAS v4u*)(S + SC_TR + (tid >> 3) * 144 + (tid & 7) * 16) = rt[Q]; *(LAS v4u*)(S + SC_QK + (tid >> 3) * 144 + (tid & 7) * 16) = rqk[Q]; \
        if (tid < 32) *(LAS v4u*)(S + SC_VEC + tid * 16) = rvec[Q]; } while (0)
        SC_LOAD(0, 0); VM_WAIT(); SC_WRITE(0); SC_LOAD(1, 1); LDS_WAIT(); __syncthreads();
        const LAS float* gcs = (const LAS float*)(S + SC_VEC); const LAS float* bts = gcs + 64;
        for (int n2 = 0; n2 < NCHUNK; n2 += 2) {
#pragma unroll
          for (int QS = 0; QS < 2; ++QS) { const int n = n2 + QS;
            if (n + 2 < NCHUNK) SC_LOAD(n + 2, QS);
            const size_t row0 = ((size_t)b * NCHUNK + SC_CHUNK(n)) * 64;
            const float gcl = gcs[last_i];
            const int tr = w >> 1, tc = w & 1, dvt = w & 1, tt = w >> 1;
            f32x4 ks = {0.f, 0.f, 0.f, 0.f}, os = {0.f, 0.f, 0.f, 0.f};
            { bf16x8 fa[4], fb[4], gb[4];
#pragma unroll
              for (int s = 0; s < 4; ++s) { fa[s] = *(const LAS bf16x8*)(S + SC_KR + (16 * tr + l15) * 272 + (32 * s + 8 * quad) * 2); fb[s] = *(const LAS bf16x8*)(S + SC_ST + (16 * tc + l15) * 272 + (32 * s + 8 * quad) * 2);
                  gb[s] = *(const LAS bf16x8*)(S + SC_QR + (16 * tt + l15) * 272 + (32 * s + 8 * quad) * 2); }
              __builtin_amdgcn_sched_barrier(0);
#pragma unroll
              for (int s = 0; s < 4; ++s) { ks = MFMA16(fa[s], fb[s], ks); os = MFMA16(fb[s], gb[s], os); }
              __builtin_amdgcn_sched_barrier(0); }
            { float rr[4];
#pragma unroll
              for (int jj = 0; jj < 4; ++jj) { const int tok = 16 * tr + 4 * quad + jj; const float vv = bf2f(*(const LAS unsigned short*)(S + SC_VR + tok * 80 + (16 * tc + l15) * 2));
                  rr[jj] = bts[tok] * (vv - __expf(gcs[tok]) * ks[jj]); }
              *(LAS v2u*)(S + SC_RT + (16 * tc + l15) * 144 + (16 * tr + 4 * quad) * 2) = pack4(rr[0], rr[1], rr[2], rr[3]); }
            LDS_WAIT(); __syncthreads();
            f32x4 vn = {0.f, 0.f, 0.f, 0.f};
            { bf16x8 fa[2], fb[2];
#pragma unroll
              for (int s = 0; s < 2; ++s) { fa[s] = *(const LAS bf16x8*)(S + SC_TR + (16 * tr + l15) * 144 + (32 * s + 8 * quad) * 2); fb[s] = *(const LAS bf16x8*)(S + SC_RT + (16 * tc + l15) * 144 + (32 * s + 8 * quad) * 2); }
              __builtin_amdgcn_sched_barrier(0);
#pragma unroll
              for (int s = 0; s < 2; ++s) vn = MFMA16(fa[s], fb[s], vn);
              __builtin_amdgcn_sched_barrier(0); }
            { float sc[4];
#pragma unroll
              for (int jj = 0; jj < 4; ++jj) sc[jj] = vn[jj] * __expf(gcl - gcs[16 * tr + 4 * quad + jj]);
              *(LAS v2u*)(S + SC_VN + (16 * tc + l15) * 144 + (16 * tr + 4 * quad) * 2) = pack4(vn[0], vn[1], vn[2], vn[3]);
              *(LAS v2u*)(S + SC_VS + (16 * tc + l15) * 144 + (16 * tr + 4 * quad) * 2) = pack4(sc[0], sc[1], sc[2], sc[3]); }
            LDS_WAIT(); __syncthreads();
            { const float eg = __expf(gcs[16 * tt + l15]); f32x4 oa = os * eg;
              bf16x8 fa[2], fb[2];
#pragma unroll
              for (int s = 0; s < 2; ++s) { fa[s] = *(const LAS bf16x8*)(S + SC_VN + (16 * dvt + l15) * 144 + (32 * s + 8 * quad) * 2); fb[s] = *(const LAS bf16x8*)(S + SC_QK + (16 * tt + l15) * 144 + (32 * s + 8 * quad) * 2); }
              __builtin_amdgcn_sched_barrier(0);
#pragma unroll
              for (int s = 0; s < 2; ++s) oa = MFMA16(fa[s], fb[s], oa);
              *(v2u*)(OD + ((size_t)dir * MROWS + row0 + 16 * tt + l15) * 512 + h * 128 + sl * 32 + 16 * dvt + 4 * quad) = pack4(oa[0], oa[1], oa[2], oa[3]); }
            { const float gl = __expf(gcl); bf16x8 a[2];
#pragma unroll
              for (int s = 0; s < 2; ++s) {
                  typedef short v4i16_t __attribute__((ext_vector_type(4)));
                  const LAS unsigned char* tp = S + SC_KR + (32 * s + 8 * quad + (l15 >> 2)) * 272 + (16 * w + 4 * (l15 & 3)) * 2;
                  const v4i16_t lo = __builtin_amdgcn_ds_read_tr16_b64_v4i16((LAS v4i16_t*)tp), hi = __builtin_amdgcn_ds_read_tr16_b64_v4i16((LAS v4i16_t*)(tp + 4 * 272));
                  a[s] = (bf16x8){lo[0], lo[1], lo[2], lo[3], hi[0], hi[1], hi[2], hi[3]}; }
              bf16x8 vb[2][2];
#pragma unroll
              for (int d = 0; d < 2; ++d)
#pragma unroll
                  for (int s = 0; s < 2; ++s) vb[d][s] = *(const LAS bf16x8*)(S + SC_VS + (16 * d + l15) * 144 + (32 * s + 8 * quad) * 2);
              __builtin_amdgcn_sched_barrier(0);
#pragma unroll
              for (int d = 0; d < 2; ++d) { f32x4 acc = Sacc[d] * gl;
#pragma unroll
                  for (int s = 0; s < 2; ++s) acc = MFMA16(a[s], vb[d][s], acc);
                  Sacc[d] = acc; *(LAS v2u*)(S + SC_ST + (16 * d + l15) * 272 + (16 * w + 4 * quad) * 2) = pack4(acc[0], acc[1], acc[2], acc[3]); } }
            LDS_WAIT(); __syncthreads();
            if (n + 1 < NCHUNK) SC_WRITE(1 - QS);
            LDS_WAIT(); __syncthreads();
                  }
        }
#undef SC_LOAD
#undef SC_WRITE
#undef SC_CHUNK
    }
}

template <int N, int K> DI void topk_unit(const Frame& F, const float* aff, int slot_base, int row_base, int inv_base) {
    constexpr int EPT = N >= 512 ? N / 512 : 1;
    LAS unsigned* hist = (LAS unsigned*)F.lds;
    LAS unsigned* ctl = hist + 256;
    LAS unsigned* wsum = ctl + 8;
    LAS unsigned* keys = hist + 1024;
    const int tid = F.tid; const bool act = tid * EPT < N;
    if (act) {
#pragma unroll 4
        for (int e = 0; e < EPT; ++e) keys[e * 512 + tid] = __builtin_bit_cast(unsigned, aff[tid * EPT + e]);
    }
    unsigned prefix = 0u, kk = K;
    for (int pass = 0; pass < 4; ++pass) {
        const int shift = 24 - 8 * pass; const unsigned himask = pass == 0 ? 0u : (0xffffffffu << (shift + 8));
        if (tid < 256) hist[tid] = 0u;
        __syncthreads();
        if (act) {
#pragma unroll 4
            for (int e = 0; e < EPT; ++e) { const unsigned key = keys[e * 512 + tid]; if ((key & himask) == prefix) __hip_atomic_fetch_add(&hist[(key >> shift) & 255u], 1u, __ATOMIC_RELAXED, __HIP_MEMORY_SCOPE_WORKGROUP); }
        }
        __syncthreads();
        if (F.wave == 0) {
            const int l = F.lane; const unsigned h0 = hist[4 * l], h1 = hist[4 * l + 1], h2 = hist[4 * l + 2], h3 = hist[4 * l + 3];
            const unsigned mine = h0 + h1 + h2 + h3; unsigned above = mine;
#pragma unroll
            for (int o = 1; o < 64; o <<= 1) { const unsigned t = __shfl_down(above, o); if (l + o < 64) above += t; }
            const unsigned excl = above - mine;
            if (excl < kk && kk <= above) {
                unsigned c = excl, d;
                if (kk <= c + h3) { d = 3; } else { c += h3; if (kk <= c + h2) { d = 2; } else { c += h2; if (kk <= c + h1) { d = 1; } else { c += h1; d = 0; } } }
                ctl[0] = prefix | ((unsigned)(4 * l + d) << shift); ctl[1] = kk - c;
            }
        }
        __syncthreads();
        prefix = ctl[0]; kk = ctl[1];
        __syncthreads();
    }
    const unsigned thr = prefix;
    unsigned ngt = 0, neq = 0;
    if (act) {
#pragma unroll 4
        for (int e = 0; e < EPT; ++e) { const unsigned key = keys[e * 512 + tid]; ngt += key > thr ? 1u : 0u; neq += key == thr ? 1u : 0u; }
    }
    unsigned sg = ngt, se = neq;
#pragma unroll
    for (int o = 1; o < 64; o <<= 1) { const unsigned a = __shfl_up(sg, o), b = __shfl_up(se, o); if (F.lane >= o) { sg += a; se += b; } }
    if (F.lane == 63) { wsum[F.wave] = sg; wsum[8 + F.wave] = se; }
    __syncthreads();
    unsigned og = sg - ngt, oe = se - neq, totg = 0;
#pragma unroll
    for (int ww = 0; ww < 8; ++ww) { const unsigned a = wsum[ww], b = wsum[8 + ww]; if (ww < F.wave) { og += a; oe += b; } totg += a; }
    int* idx = (int*)(F.ws + WS_IDX); float* wgt = (float*)(F.ws + WS_WGT); int* inv = (int*)(F.ws + WS_INV);
    if (act) {
#pragma unroll 2
        for (int e = 0; e < EPT; ++e) {
            const unsigned key = keys[e * 512 + tid];
            const int t = tid * EPT + e; int slot = -1;
            if (key > thr) slot = (int)(og++);
            else if (key == thr) { if (oe < kk) slot = (int)(totg + oe); ++oe; }
            if (slot >= 0) { idx[slot_base + slot] = row_base + t; wgt[slot_base + slot] = __builtin_bit_cast(float, key); }
            inv[inv_base + t] = slot >= 0 ? slot_base + slot : -1;
        }
    }
    __syncthreads();
}
DI void phase_tk(const Frame& F, int nunits) {
    const float* A = (const float*)(F.ws + WS_AFF);
    for (int u = F.bx; u < nunits; u += F.G) {
        if (u < NB * NEXP) { const int b = u >> 4, e = u & 15; topk_unit<SEQ, CAP_L>(F, A + (size_t)u * SEQ, (e * 8 + b) * CAP_L, b * TPB, (b * NEXP + e) * TPB); }
        else { const int v = u - NB * NEXP, b = v >> 4, e = v & 15; topk_unit<CTXL, CAP_C>(F, A + (size_t)NB * NEXP * SEQ + (size_t)v * CTXL, NSLOT_L + e * 256 + b * CAP_C, b * TPB + SEQ, (b * NEXP + e) * TPB + SEQ); }
    }
}
DI void phase_at(const Frame& F, int li) {
    typedef attn_body::bf16 abf;
    const bool need_ctx = li != NLAYER - 1;
    unsigned char* ws = F.ws;
    const float* LB = (const float*)(ws + WS_LAM) + li * 4;
    const bool fastA = __builtin_amdgcn_readfirstlane((int)(LB[2] <= 60.f)), fastB = __builtin_amdgcn_readfirstlane((int)(LB[3] <= 60.f));
    for (int i = 0;; ++i) {
        const int L = i * F.G + F.vcu; if (L >= 17 * 256) break;
        if (WX_EARLY + i * F.NGW < WX_NITEMS) {
            const int it = WX_EARLY + i * F.NGW + F.gw;
            int z0 = 0; asm volatile("" : "+s"(z0));
            Frame W = F; W.in.p = F.in.p + z0; W.ws = F.ws + z0; { int ln = F.lane; asm volatile("" : "+v"(ln)); W.lane = ln; }
            if (it < WX_NITEMS) wx_item_e(W, li + z0, it - WX_EARLY, (LAS float*)(F.lds + F.wave * 16384));
            __syncthreads();
        }
        const int step = L >> 8, slot = L & 255, b = slot >> 5, j = slot & 31;
        int kind, head, q0, krow0, NT;
        if (step < 8) { kind = 0; head = step; q0 = j * 256; krow0 = 0; NT = TPB / 64; }
        else if (step < 16) { kind = 1; head = step - 8; q0 = j * 256; krow0 = 0; NT = TPB / 64; }
        else { if (!need_ctx || j >= 16) continue; if (j < 8) { kind = 0; head = j; } else { kind = 1; head = j - 8; } q0 = SEQ; krow0 = SEQ; NT = CTXL / 64; }
        const size_t qrow = (size_t)b * TPB + q0, krow = (size_t)b * TPB + krow0;
        int tid_u = F.tid; asm volatile("" : "+v"(tid_u));
        if (kind == 0) {
            abf* Q = (abf*)(ws + WS_YA) + qrow * 512 + head * 64;
            const abf* K = (const abf*)(ws + WS_KA) + krow * 128 + (head >> 2) * 64; const abf* V = (const abf*)(ws + WS_VA) + krow * 128 + (head >> 2) * 64;
            if (fastA) attn_body::attn_unit<8, true>(Q, 512, K, 128, V, 128, Q, 512, NT, (char*)F.lds, tid_u);
            else attn_body::attn_unit<8, false>(Q, 512, K, 128, V, 128, Q, 512, NT, (char*)F.lds, tid_u);
        } else {
            const int sh = head;
            const abf* Q = (const abf*)(ws + WS_QB) + qrow * 512 + sh * 64;
            const abf* K = (const abf*)(ws + WS_KB) + krow * 512 + sh * 64; const abf* V = (const abf*)(ws + WS_VB) + krow * 512 + (sh >> 1) * 128;
            abf* O = (abf*)(ws + WS_OB) + qrow * 1024 + sh * 128;
            if (fastB) attn_body::attn_unit128<8, true>(Q, 512, K, 512, V, 512, O, 1024, NT, (char*)F.lds, tid_u);
            else attn_body::attn_unit128<8, false>(Q, 512, K, 512, V, 512, O, 1024, NT, (char*)F.lds, tid_u);
        }
    }
}
constexpr int NPH = 19;
struct Args { const float* in[N_IN]; float* out; unsigned char* ws; int ph_lo, ph_hi, bar_region, pad; };
constexpr int CW_TMO = 0, CW_BAR = 4096;

__global__ void __launch_bounds__(512, 2) __attribute__((amdgpu_waves_per_eu(2, 2))) fwd_kernel(Args args) {
    extern __shared__ __attribute__((aligned(16))) unsigned char lds[];
    Frame F;
    F.lds = (LAS unsigned char*)lds; F.MISC = (volatile LAS unsigned*)(F.lds + MISC_OFF);
    F.tid = threadIdx.x; F.lane = F.tid & 63; F.wave = __builtin_amdgcn_readfirstlane(F.tid >> 6);
    F.G = gridDim.x; { const int bx = blockIdx.x; F.vcu = (F.G % 8 == 0) ? (bx % 8) * (F.G / 8) + bx / 8 : bx; }
    F.gw = F.vcu * 8 + F.wave; F.NGW = F.G * 8; F.bx = blockIdx.x;
    F.in.p = (kin_ptr)__builtin_amdgcn_kernarg_segment_ptr();
    F.out = args.out; F.ws = args.ws; F.ctl = (gu32*)(args.ws + WS_CTL);
    for (int u = F.tid; u < (LDS_BYTES - LDSCTL_OFF) / 4; u += 512) ((LAS unsigned*)(F.lds + LDSCTL_OFF))[u] = 0u;
    __syncthreads();
#if MK_ONE_LAUNCH
    XcdBarrier bar = xcd_barrier_post((unsigned*)(F.ctl + CW_BAR) + args.bar_region * XCD_BAR_WORDS, F.MISC + 8);
#define GRID_BAR() xcd_barrier(bar)
#else
#define GRID_BAR() do {} while (0)
#endif
    const int lo = args.ph_lo, hi = args.ph_hi;
#ifndef PROBE_MASK
#define PROBE_MASK 0
#endif
#ifndef PROBE_MULT
#define PROBE_MULT 4
#endif
    unsigned long long pr_acc = 0ull, pr_t0 = 0ull; (void)pr_t0;
#define PR_BEGIN(k) do { if ((PROBE_MASK >> (k)) & 1) pr_t0 = __builtin_amdgcn_s_memrealtime(); } while (0)
#define PR_END(k) do { if ((PROBE_MASK >> (k)) & 1) pr_acc += __builtin_amdgcn_s_memrealtime() - pr_t0; } while (0)
#ifndef ONLY_PH
#define ONLY_PH -1
#endif
#define IN(k) ((ONLY_PH < 0 || ONLY_PH == ((k) % NPH)) && lo <= (k) && (k) < hi)
#define SEAM(k) do { if (IN(k) && IN((k) + 1)) GRID_BAR(); } while (0)
    for (int li = 0; li < NLAYER; ++li) {
        const int p0 = li * NPH;
        const int lastl = li == NLAYER - 1;
#define PHASE_FRAME() Frame P = F; { int t_ = threadIdx.x; asm volatile("" : "+v"(t_)); P.tid = t_; P.lane = t_ & 63; \
        int z_ = 0, v_ = F.vcu, G_ = F.G, b_ = F.bx; asm volatile("" : "+s"(z_), "+s"(v_), "+s"(G_), "+s"(b_));     \
        P.in.p = (kin_ptr)__builtin_amdgcn_kernarg_segment_ptr() + z_; P.ws = args.ws + z_; P.out = args.out + z_; P.vcu = v_; P.G = G_; P.bx = b_; P.wave = __builtin_amdgcn_readfirstlane(P.tid >> 6); P.gw = v_ * 8 + P.wave; P.NGW = G_ * 8; P.ctl = (gu32*)(P.ws + WS_CTL); } \
        unsigned char* ws = P.ws; unsigned char* wm = ws + WS_WMIX; unsigned char* we = ws + WS_WEXP; (void)wm; (void)we;
        PR_BEGIN(0); if (IN(p0 + 0)) { PHASE_FRAME(); if (li == 0) phase_p0(P); phase_wx(P, li); } SEAM(p0 + 0); PR_END(0);
        PR_BEGIN(1); if (li == 0) { if (IN(p0 + 1)) { PHASE_FRAME(); phase_norm<0>(P, li); } SEAM(p0 + 1); } PR_END(1);
        PR_BEGIN(2); if (IN(p0 + 2)) { PHASE_FRAME();
            pg8::Gemm g{1024, 1024, 1024}; pg8::SchedMN S; S.init(ws + WS_H, 1024, wm + WM_WIN, 1024, MROWS / 256, 8, 9, P.G, P.bx);
            pg8::EpiInProj E{ws, P.in[I_GQN] + li * 64, P.in[I_GKN] + li * 64, P.in[I_DQN] + li * 64, P.in[I_DKN] + li * 64, (const float*)(ws + WS_ROPE)};
            pg8::gemm_phase<pg8::EpiInProj, pg8::SchedMN, true, true>(P.lds, g, S, E, P.tid);
        } SEAM(p0 + 2); PR_END(2);
        PR_BEGIN(3); if (IN(p0 + 3)) { PHASE_FRAME(); phase_side<0>(P, li, P.lds); phase_cv(P, li); } SEAM(p0 + 3); PR_END(3);
        PR_BEGIN(4); if (IN(p0 + 4)) { PHASE_FRAME(); phase_cl(P); } SEAM(p0 + 4); PR_END(4);
        PR_BEGIN(5); if (IN(p0 + 5)) { PHASE_FRAME(); phase_sc(P); } SEAM(p0 + 5); PR_END(5);
        PR_BEGIN(6); if (IN(p0 + 6)) { PHASE_FRAME(); phase_gf(P, li); } SEAM(p0 + 6); PR_END(6);
        PR_BEGIN(7); if (IN(p0 + 7)) { PHASE_FRAME();
            pg8::Gemm g{1024, 1024, 1024}; pg8::SchedMN S; S.init(ws + WS_H, 1024, wm + WM_WIN, 1024, MROWS / 256, 9, 0, P.G, P.bx);
            pg8::EpiInProj E{ws, P.in[I_GQN] + li * 64, P.in[I_GKN] + li * 64, P.in[I_DQN] + li * 64, P.in[I_DKN] + li * 64, (const float*)(ws + WS_ROPE)};
            pg8::gemm_phase<pg8::EpiInProj, pg8::SchedMN, true, true>(P.lds, g, S, E, P.tid);
        } SEAM(p0 + 7); PR_END(7);
        PR_BEGIN(8); if (IN(p0 + 8)) { PHASE_FRAME(); phase_at(P, li); } SEAM(p0 + 8); PR_END(8);
        PR_BEGIN(9); if (IN(p0 + 9)) { PHASE_FRAME(); phase_bf(P, li); } SEAM(p0 + 9); PR_END(9);
        PR_BEGIN(10); if (IN(p0 + 10)) { PHASE_FRAME();
            pg8::Gemm g{1024, 1024, 1024}; pg8::SchedMN S; S.init(ws + WS_H, 1024, wm + WM_WG, 1024, lastl ? NB * SEQ / 256 : MROWS / 256, 12, 0, P.G, P.bx); S.skipctx = lastl;
            pg8::EpiBf<0> E{(pg8::bf16_t*)(ws + WS_G), 3072, nullptr};
            pg8::gemm_phase<pg8::EpiBf<0>, pg8::SchedMN, true, true>(P.lds, g, S, E, P.tid);
        } SEAM(p0 + 10); PR_END(10);
        PR_BEGIN(11); if (IN(p0 + 11)) { PHASE_FRAME();
            pg8::Gemm g{512, 512, 512}; pg8::SchedMN S; S.init(ws + WS_YA, 512, wm + WM_WB, 512, lastl ? NB * SEQ / 256 : MROWS / 256, 4, 0, P.G, P.bx); S.skipctx = lastl;
            S.NZ = 3; S.a_z = 66 * MiB; S.b_z = (size_t)1024 * 512 * 2;
            pg8::EpiMergeH E{(pg8::bf16_t*)(ws + WS_MRG), 1024, (const pg8::bf16_t*)(ws + WS_G)};
            pg8::gemm_phase<pg8::EpiMergeH, pg8::SchedMN, true, true>(P.lds, g, S, E, P.tid);
        } SEAM(p0 + 11); PR_END(11);
        PR_BEGIN(12); if (IN(p0 + 12)) { PHASE_FRAME();
            pg8::Gemm g{1024, 1024, 1024}; pg8::SchedMN S; S.init(ws + WS_MRG, 1024, wm + WM_WO, 1024, lastl ? NB * SEQ / 256 : MROWS / 256, 4, 0, P.G, P.bx); S.skipctx = lastl;
            pg8::EpiBf<2> E{(pg8::bf16_t*)(ws + WS_G), 1024, nullptr};
            pg8::gemm_phase<pg8::EpiBf<2>, pg8::SchedMN, true, true>(P.lds, g, S, E, P.tid);
        } SEAM(p0 + 12); PR_END(12);
        PR_BEGIN(13); if (IN(p0 + 13)) { PHASE_FRAME(); phase_norm<1>(P, li); } SEAM(p0 + 13); PR_END(13);
        PR_BEGIN(14); if (IN(p0 + 14)) { PHASE_FRAME(); phase_side<1>(P, li, P.lds); } SEAM(p0 + 14); PR_END(14);
        PR_BEGIN(15); if (IN(p0 + 15)) { PHASE_FRAME(); phase_tk(P, lastl ? NB * NEXP : 2 * NB * NEXP); } SEAM(p0 + 15); PR_END(15);
        PR_BEGIN(16); if (IN(p0 + 16)) { PHASE_FRAME();
            pg8::Gemm g{1024, 1024, 1024}; pg8::SchedMoeG S{(const char*)(ws + WS_H), (const char*)(we + WE_GU), (size_t)2048 * 1024 * 2, 8, (lastl ? NSLOT_L / 256 : NSLOT / 256) * 8, P.G, P.vcu, (const int*)(ws + WS_IDX)};
            pg8::EpiE1 E{(pg8::bf16_t*)(ws + WS_HID)};
            pg8::gemm_phase<pg8::EpiE1, pg8::SchedMoeG, true, true>(P.lds, g, S, E, P.tid);
        } SEAM(p0 + 16); PR_END(16);
        PR_BEGIN(17); if (IN(p0 + 17)) { PHASE_FRAME();
            pg8::Gemm g{1024, 1024, 1024}; pg8::SchedMoe S{(const char*)(ws + WS_HID), (const char*)(we + WE_D), (size_t)1024 * 1024 * 2, 4, (lastl ? NSLOT_L / 256 : NSLOT / 256) * 4, P.G, P.vcu};
            pg8::EpiE2 E{(pg8::bf16_t*)(ws + WS_XIN), (const float*)(ws + WS_WGT), modv_of(P, li)};
            pg8::gemm_phase<pg8::EpiE2, pg8::SchedMoe, true, true>(P.lds, g, S, E, P.tid);
        } SEAM(p0 + 17); PR_END(17);
        PR_BEGIN(18); if (IN(p0 + 18)) { PHASE_FRAME(); phase_cb(P, li); } SEAM(p0 + 18); PR_END(18);
    }
#undef IN
#undef SEAM
    if (PROBE_MASK != 0 && blockIdx.x == 0) { const unsigned long long t1 = __builtin_amdgcn_s_memrealtime(); while (__builtin_amdgcn_s_memrealtime() - t1 < (unsigned long long)PROBE_MULT * pr_acc) __builtin_amdgcn_s_sleep(32); }
}

extern "C" void kernel_launch(void* const* d_in, const int* in_sizes, int n_in, void* d_out, int out_size, void* d_ws, size_t ws_size, hipStream_t stream) {
    static int grid = 0;
    if (grid == 0) {
        if (n_in != N_IN || in_sizes[0] != NB * SEQ * DM || out_size != NB * SEQ * DM || ws_size < WS_END) {
            fprintf(stderr, "kernel_launch: unexpected problem: n_in %d in0 %d out %d ws %zu (need %zu)\n", n_in, n_in > 0 ? in_sizes[0] : -1, out_size, ws_size, (size_t)WS_END); grid = -1; return; }
        int dev = 0, cus = 0, per_cu = 0;
        if (hipGetDevice(&dev) != hipSuccess || hipDeviceGetAttribute(&cus, hipDeviceAttributeMultiprocessorCount, dev) != hipSuccess) { grid = -1; return; }
        if (hipFuncSetAttribute((const void*)fwd_kernel, hipFuncAttributeMaxDynamicSharedMemorySize, LDS_BYTES) != hipSuccess) { fprintf(stderr, "kernel_launch: hipFuncSetAttribute failed\n"); grid = -1; return; }
        if (hipOccupancyMaxActiveBlocksPerMultiprocessor(&per_cu, (const void*)fwd_kernel, 512, LDS_BYTES) != hipSuccess || per_cu < 1) { fprintf(stderr, "kernel_launch: occupancy query says %d\n", per_cu); }
        (void)hipGetLastError();
        grid = cus;
    }
    if (grid < 0) return;
    (void)hipMemsetAsync((char*)d_ws + WS_CTL, 0, CTL_ZERO_BYTES, stream);
    Args a{};
    for (int i = 0; i < N_IN; ++i) a.in[i] = (const float*)d_in[i];
    a.out = (float*)d_out; a.ws = (unsigned char*)d_ws; a.pad = 0;
#if MK_ONE_LAUNCH
    a.ph_lo = 0; a.ph_hi = NLAYER * NPH; a.bar_region = 0;
    hipLaunchKernelGGL(fwd_kernel, dim3(grid), dim3(512), LDS_BYTES, stream, a);
#else
    for (int p = 0; p < NLAYER * NPH; ++p) { a.ph_lo = p; a.ph_hi = p + 1; a.bar_region = 0; hipLaunchKernelGGL(fwd_kernel, dim3(grid), dim3(512), LDS_BYTES, stream, a); }
#endif
}
```
